# Optimizing an MI355X kernel written in HIP

```python
import math
import jax, jax.numpy as jnp
from jax import lax
import numpy as np

D_MODEL = 1024
BATCH = 16
SEQ = 4096
DEPTH = 4

MEM_LEN = 256
N_EVEN = (DEPTH + 1) // 2
N_ODD = DEPTH // 2
EPS = 1e-6
ROPE_THETA = 10000.0
Q_BLOCK = 128

D_FF = 2816
CONV_DIM = 512
CONV_WIDTH = 31
MLA_HEADS = 8
Q_LORA = 256
KV_LORA = 128
QK_NOPE = 64
QK_ROPE = 32
V_HEAD = 64
MLA_OUT = MLA_HEADS * V_HEAD
EVEN_IN = 2 * CONV_DIM + Q_LORA + KV_LORA + QK_ROPE
EVEN_MIX = CONV_DIM + MLA_OUT
RET_HEADS = 4
RET_QK = 256
RET_V = 512
RET_CHUNK = 128
ODD_MIX = RET_HEADS * RET_V
ODD_IN = 2 * RET_HEADS * RET_QK + 2 * ODD_MIX
X_HEADS = 4
X_HEAD_DIM = D_MODEL // X_HEADS

kernel_name = 'hybrid_conv_mla_retention_trunk'


def rms_norm(x, g):
    xf = x.astype(jnp.float32)
    y = xf * lax.rsqrt(jnp.mean(xf * xf, axis=-1, keepdims=True) + EPS)
    return (y * g.astype(jnp.float32)).astype(x.dtype)


def layer_norm(x, g, b):
    xf = x.astype(jnp.float32)
    mu = jnp.mean(xf, axis=-1, keepdims=True)
    xc = xf - mu
    var = jnp.mean(xc * xc, axis=-1, keepdims=True)
    return (xc * lax.rsqrt(var + EPS) * g.astype(jnp.float32) + b.astype(jnp.float32)).astype(x.dtype)


def rope_tables(positions, dim):
    inv = ROPE_THETA ** (-jnp.arange(0, dim, 2, dtype=jnp.float32) / dim)
    ang = positions.astype(jnp.float32)[..., None] * inv
    return jnp.cos(ang), jnp.sin(ang)


def apply_rope(x, cos, sin):
    x1, x2 = jnp.split(x, 2, axis=-1)
    c = cos[:, :, None, :].astype(x.dtype)
    s = sin[:, :, None, :].astype(x.dtype)
    return jnp.concatenate([x1 * c - x2 * s, x1 * s + x2 * c], axis=-1)


def swiglu(h, w_gate, w_up, w_down):
    return (jax.nn.silu(h @ w_gate) * (h @ w_up)) @ w_down


def causal_depthwise_conv(a, w, b):
    y = lax.conv_general_dilated(
        a, w[:, None, :].astype(a.dtype), window_strides=(1,),
        padding=[(CONV_WIDTH - 1, 0)], dimension_numbers=('NWC', 'WIO', 'NWC'),
        feature_group_count=a.shape[-1])
    return y + b.astype(a.dtype)


def causal_block_attention(q, k, v, scale):
    B, S, H, Dq = q.shape
    nb = S // Q_BLOCK
    kf = k.astype(jnp.float32)
    vf = v.astype(jnp.float32)
    qb = q.astype(jnp.float32).reshape(B, nb, Q_BLOCK, H, Dq).transpose(1, 0, 2, 3, 4)
    kpos = jnp.arange(S)

    def one_block(args):
        qi, i = args
        s = jnp.einsum('bqhd,bkhd->bhqk', qi, kf) * scale
        qpos = i * Q_BLOCK + jnp.arange(Q_BLOCK)
        s = jnp.where(kpos[None, :] <= qpos[:, None], s, -jnp.inf)
        p = jax.nn.softmax(s, axis=-1)
        return jnp.einsum('bhqk,bkhd->bqhd', p, vf)

    out = lax.map(one_block, (qb, jnp.arange(nb)))
    return out.transpose(1, 0, 2, 3, 4).reshape(B, S, H, v.shape[-1]).astype(v.dtype)


def mla_heads(z_q, z_kv, z_kr, cos, sin, q_a_norm, w_q_b, kv_a_norm, w_kv_b,
              q_nope_norm, k_nope_norm, q_rope_norm, k_rope_norm):
    B, S, _ = z_q.shape
    q = (rms_norm(z_q, q_a_norm) @ w_q_b).reshape(B, S, MLA_HEADS, QK_NOPE + QK_ROPE)
    kv = (rms_norm(z_kv, kv_a_norm) @ w_kv_b).reshape(B, S, MLA_HEADS, QK_NOPE + V_HEAD)
    q_nope, q_rope = jnp.split(q, [QK_NOPE], axis=-1)
    k_nope, v = jnp.split(kv, [QK_NOPE], axis=-1)
    q_nope = rms_norm(q_nope, q_nope_norm)
    k_nope = rms_norm(k_nope, k_nope_norm)
    q_rope = apply_rope(rms_norm(q_rope, q_rope_norm), cos, sin)
    k_rope = apply_rope(rms_norm(z_kr[:, :, None, :], k_rope_norm), cos, sin)
    qf = jnp.concatenate([q_nope, q_rope], axis=-1)
    kf = jnp.concatenate([k_nope, jnp.broadcast_to(k_rope, (B, S, MLA_HEADS, QK_ROPE))], axis=-1)
    o = causal_block_attention(qf, kf, v, (QK_NOPE + QK_ROPE) ** -0.5)
    return o.reshape(B, S, MLA_OUT)


def conv_mla_mixer(h, cos_m, sin_m, w_in, conv_w, conv_b, conv_ln_g, conv_ln_b,
                   q_a_norm, w_q_b, kv_a_norm, w_kv_b, q_nope_norm, k_nope_norm,
                   q_rope_norm, k_rope_norm, w_out):
    z = h @ w_in
    z_val, z_gate, z_q, z_kv, z_kr = jnp.split(
        z, [CONV_DIM, 2 * CONV_DIM, 2 * CONV_DIM + Q_LORA, 2 * CONV_DIM + Q_LORA + KV_LORA], axis=-1)
    a = z_val * jax.nn.sigmoid(z_gate)
    a = jax.nn.silu(layer_norm(causal_depthwise_conv(a, conv_w, conv_b), conv_ln_g, conv_ln_b))
    m = mla_heads(z_q, z_kv, z_kr, cos_m, sin_m, q_a_norm, w_q_b, kv_a_norm, w_kv_b,
                  q_nope_norm, k_nope_norm, q_rope_norm, k_rope_norm)
    return jnp.concatenate([a, m], axis=-1) @ w_out


def retention_chunkwise(q, k, v):
    B, S, H, Dk = q.shape
    Dv = v.shape[-1]
    n = S // RET_CHUNK
    log_g = jnp.log1p(-jnp.exp2(-5.0 - jnp.arange(H, dtype=jnp.float32)))
    idx = jnp.arange(RET_CHUNK, dtype=jnp.float32)
    diff = idx[:, None] - idx[None, :]
    decay = jnp.where(diff >= 0, jnp.exp(log_g[:, None, None] * jnp.maximum(diff, 0.0)), 0.0)
    xi = jnp.exp(log_g[:, None] * (idx + 1.0))[None, :, :, None]
    zeta = jnp.exp(log_g[:, None] * (RET_CHUNK - 1.0 - idx))[None, :, :, None]
    g_chunk = jnp.exp(log_g * RET_CHUNK)[None, :, None, None]

    def to_chunks(t):
        return t.astype(jnp.float32).reshape(B, n, RET_CHUNK, H, t.shape[-1]).transpose(1, 0, 3, 2, 4)

    def step(state, inp):
        qc, kc, vc = inp
        scores = jnp.einsum('bhid,bhjd->bhij', qc, kc) * decay
        out = (jnp.einsum('bhij,bhjv->bhiv', scores, vc)
               + jnp.einsum('bhid,bhdv->bhiv', qc, state) * xi)
        state = state * g_chunk + jnp.einsum('bhjd,bhjv->bhdv', kc * zeta, vc)
        return state, out

    state0 = jnp.zeros((B, H, Dk, Dv), jnp.float32)
    _, out = lax.scan(step, state0, (to_chunks(q), to_chunks(k), to_chunks(v)))
    return out.transpose(1, 0, 3, 2, 4).reshape(B, S, H, Dv)


def retention_mixer(h, cos_r, sin_r, w_in, gn_g, gn_b, w_out):
    B, S, _ = h.shape
    z = h @ w_in
    q, k, v, g = jnp.split(z, [RET_HEADS * RET_QK, 2 * RET_HEADS * RET_QK,
                               2 * RET_HEADS * RET_QK + ODD_MIX], axis=-1)
    q = apply_rope(q.reshape(B, S, RET_HEADS, RET_QK), cos_r, sin_r)
    k = apply_rope(k.reshape(B, S, RET_HEADS, RET_QK), cos_r, sin_r) * (RET_QK ** -0.5)
    v = v.reshape(B, S, RET_HEADS, RET_V)
    o = retention_chunkwise(q, k, v).astype(h.dtype)
    o = layer_norm(o, gn_g.reshape(RET_HEADS, RET_V), gn_b.reshape(RET_HEADS, RET_V))
    return (jax.nn.silu(g) * o.reshape(B, S, ODD_MIX)) @ w_out


def memory_cross_attention(h, m, wq, wk, wv, wo, q_norm, k_norm):
    B, S, _ = h.shape
    M = m.shape[1]
    q = rms_norm((h @ wq).reshape(B, S, X_HEADS, X_HEAD_DIM), q_norm)
    k = rms_norm((m @ wk).reshape(B, M, X_HEADS, X_HEAD_DIM), k_norm)
    v = (m @ wv).reshape(B, M, X_HEADS, X_HEAD_DIM)
    s = jnp.einsum('bshd,bmhd->bhsm', q.astype(jnp.float32), k.astype(jnp.float32)) * (X_HEAD_DIM ** -0.5)
    p = jax.nn.softmax(s, axis=-1)
    o = jnp.einsum('bhsm,bmhd->bshd', p, v.astype(jnp.float32)).astype(h.dtype)
    return o.reshape(B, S, D_MODEL) @ wo


def setup_inputs(seed: int = 0) -> dict:
    key = jax.random.key(seed)
    ks = iter(jax.random.split(key, 64))

    def w(shape, fan_in):
        return jax.random.normal(next(ks), shape, jnp.float32) * (fan_in ** -0.5)

    def gain(shape):
        return 1.0 + 0.02 * jax.random.normal(next(ks), shape, jnp.float32)

    def bias(shape):
        return 0.01 * jax.random.normal(next(ks), shape, jnp.float32)

    L, E, O, D = DEPTH, N_EVEN, N_ODD, D_MODEL
    x = jax.random.normal(next(ks), (BATCH, SEQ, D), jnp.float32)
    mem = jax.random.normal(next(ks), (BATCH, MEM_LEN, D), jnp.float32)
    offset = jax.random.randint(next(ks), (BATCH, 1), 0, 1024, dtype=jnp.int32)
    positions = jnp.arange(SEQ, dtype=jnp.int32)[None, :] + offset
    return {
        'x': x, 'mem': mem, 'positions': positions,
        'ffn1_norm': gain((L, D)), 'ffn1_w_gate': w((L, D, D_FF), D),
        'ffn1_w_up': w((L, D, D_FF), D), 'ffn1_w_down': w((L, D_FF, D), D_FF),
        'ffn2_norm': gain((L, D)), 'ffn2_w_gate': w((L, D, D_FF), D),
        'ffn2_w_up': w((L, D, D_FF), D), 'ffn2_w_down': w((L, D_FF, D), D_FF),
        'mix_norm': gain((L, D)), 'xattn_norm': gain((L, D)), 'mem_norm': gain((L, D)),
        'xattn_wq': w((L, D, D), D), 'xattn_wk': w((L, D, D), D),
        'xattn_wv': w((L, D, D), D), 'xattn_wo': w((L, D, D), D),
        'xattn_q_norm': gain((L, X_HEAD_DIM)), 'xattn_k_norm': gain((L, X_HEAD_DIM)),
        'ev_w_in': w((E, D, EVEN_IN), D),
        'ev_conv_w': w((E, CONV_WIDTH, CONV_DIM), CONV_WIDTH), 'ev_conv_b': bias((E, CONV_DIM)),
        'ev_conv_ln_g': gain((E, CONV_DIM)), 'ev_conv_ln_b': bias((E, CONV_DIM)),
        'ev_q_a_norm': gain((E, Q_LORA)), 'ev_w_q_b': w((E, Q_LORA, MLA_HEADS * (QK_NOPE + QK_ROPE)), Q_LORA),
        'ev_kv_a_norm': gain((E, KV_LORA)), 'ev_w_kv_b': w((E, KV_LORA, MLA_HEADS * (QK_NOPE + V_HEAD)), KV_LORA),
        'ev_q_nope_norm': gain((E, QK_NOPE)), 'ev_k_nope_norm': gain((E, QK_NOPE)),
        'ev_q_rope_norm': gain((E, QK_ROPE)), 'ev_k_rope_norm': gain((E, QK_ROPE)),
        'ev_w_out': w((E, EVEN_MIX, D), EVEN_MIX),
        'od_w_in': w((O, D, ODD_IN), D), 'od_gn_g': gain((O, ODD_MIX)), 'od_gn_b': bias((O, ODD_MIX)),
        'od_w_out': w((O, ODD_MIX, D), ODD_MIX),
    }


def reference(x, mem, positions,
              ffn1_norm, ffn1_w_gate, ffn1_w_up, ffn1_w_down,
              ffn2_norm, ffn2_w_gate, ffn2_w_up, ffn2_w_down,
              mix_norm, xattn_norm, mem_norm,
              xattn_wq, xattn_wk, xattn_wv, xattn_wo, xattn_q_norm, xattn_k_norm,
              ev_w_in, ev_conv_w, ev_conv_b, ev_conv_ln_g, ev_conv_ln_b,
              ev_q_a_norm, ev_w_q_b, ev_kv_a_norm, ev_w_kv_b,
              ev_q_nope_norm, ev_k_nope_norm, ev_q_rope_norm, ev_k_rope_norm, ev_w_out,
              od_w_in, od_gn_g, od_gn_b, od_w_out):
    cos_m, sin_m = rope_tables(positions, QK_ROPE)
    cos_r, sin_r = rope_tables(positions, RET_QK)
    for l in range(DEPTH):
        x = x + 0.5 * swiglu(rms_norm(x, ffn1_norm[l]), ffn1_w_gate[l], ffn1_w_up[l], ffn1_w_down[l])
        h = rms_norm(x, mix_norm[l])
        if l % 2 == 0:
            e = l // 2
            x = x + conv_mla_mixer(h, cos_m, sin_m, ev_w_in[e], ev_conv_w[e], ev_conv_b[e],
                                   ev_conv_ln_g[e], ev_conv_ln_b[e], ev_q_a_norm[e], ev_w_q_b[e],
                                   ev_kv_a_norm[e], ev_w_kv_b[e], ev_q_nope_norm[e], ev_k_nope_norm[e],
                                   ev_q_rope_norm[e], ev_k_rope_norm[e], ev_w_out[e])
        else:
            o = l // 2
            x = x + retention_mixer(h, cos_r, sin_r, od_w_in[o], od_gn_g[o], od_gn_b[o], od_w_out[o])
        x = x + memory_cross_attention(rms_norm(x, xattn_norm[l]), rms_norm(mem, mem_norm[l]),
                                       xattn_wq[l], xattn_wk[l], xattn_wv[l], xattn_wo[l],
                                       xattn_q_norm[l], xattn_k_norm[l])
        x = x + 0.5 * swiglu(rms_norm(x, ffn2_norm[l]), ffn2_w_gate[l], ffn2_w_up[l], ffn2_w_down[l])
    return x
```

```cpp
#include <hip/hip_runtime.h>
#include <cstdio>
#include <cstdint>

#define LAS __attribute__((address_space(3)))
#define GAS __attribute__((address_space(1)))
typedef unsigned short bf16_t;
typedef short bf16x8 __attribute__((ext_vector_type(8)));
typedef short s16x4 __attribute__((ext_vector_type(4)));
typedef float f32x4 __attribute__((ext_vector_type(4)));
typedef float f32x2 __attribute__((ext_vector_type(2)));
typedef float f32x16 __attribute__((ext_vector_type(16)));
typedef unsigned u32x4 __attribute__((ext_vector_type(4)));
typedef unsigned u32x2 __attribute__((ext_vector_type(2)));
#define DI __device__ __forceinline__

constexpr int D = 1024, NB = 16, SEQ = 4096, DEPTH = 4, MEMLEN = 256, DFF = 2816;
constexpr int M = NB * SEQ;
constexpr int MM = NB * MEMLEN;
constexpr float EPS = 1e-6f;
constexpr float LOG2E = 1.4426950408889634f;
constexpr int CONV_DIM = 512, CONV_W = 31, MLA_H = 8, QLORA = 256, KVLORA = 128, QK_NOPE = 64, QK_ROPE = 32, VHEAD = 64;
constexpr int EVEN_IN = 1440, EVEN_INP = 1536, S2N = 1792, S2K = 384;
constexpr int RET_H = 4, RET_QK = 256, RET_V = 512, RET_C = 128, ODD_MIX = 2048, ODD_IN = 6144;
constexpr int XH = 4, XHD = 256;

DI int opaque_tid() { int t = threadIdx.x; asm volatile("" : "+v"(t)); return t; }
DI unsigned cvt_pk_bf16(float lo, float hi) { unsigned r; asm volatile("v_cvt_pk_bf16_f32 %0, %1, %2" : "=v"(r) : "v"(lo), "v"(hi)); return r; }
DI float bf_lo(unsigned w) { return __uint_as_float(w << 16); }
DI float bf_hi(unsigned w) { return __uint_as_float(w & 0xffff0000u); }
DI float fast_exp2(float x) { return __builtin_amdgcn_exp2f(x); }
DI float fast_rcp(float x) { return __builtin_amdgcn_rcpf(x); }
DI float fast_rsq(float x) { return __builtin_amdgcn_rsqf(x); }
DI float sigmoidf_(float x) { return fast_rcp(1.0f + fast_exp2(-x * LOG2E)); }
DI float wave_sum(float v) {
#pragma unroll
    for (int o = 1; o < 64; o <<= 1) v += __shfl_xor(v, o);
    return v;
}
DI void sincos_turns(float ang, float& s, float& c) {
    float t = ang * 0.15915494309189535f; t = t - rintf(t);
    s = __builtin_amdgcn_sinf(t); c = __builtin_amdgcn_cosf(t);
}

namespace pg8 {
constexpr int BM = 256, BK = 64, HALF = 128, HTB = HALF * BK * 2, STAGE_BYTES = 8 * HTB, NXCD = 8, WGM = 8;
__host__ __device__ __forceinline__ int lds_byte(int r, int c) { const int st = (r >> 4) * 2 + (c >> 5), rr = r & 15, cc = c & 31, ob = rr * 64 + cc * 2; return st * 1024 + (ob ^ (((ob >> 9) & 1) << 5)); }
__host__ __device__ __forceinline__ void stage_rc(int b, int& R, int& C) { const int st = b / 1024, sb = b % 1024, swz = sb ^ (((sb >> 9) & 1) << 5); R = (st >> 1) * 16 + swz / 64; C = (st & 1) * 32 + (swz % 64) / 2; }
__host__ __device__ __forceinline__ int perm32(int rho) { const int n = rho >> 4, i = rho & 15; return 8 * (i >> 2) + 4 * n + (i & 3); }

struct Unit { int pm, pn; long aoff, boff; };
struct Gemm { const bf16_t* A; const bf16_t* Bt; };

template <int NM_, int NN_, int LDA_, int LDB_, int K_, int AMASK_, int ASH_, long A_PM_, long A_HI_, long A_PN_, int BSH_, long B_HI_, long B_PN_, bool REV_ = false>
struct Cfg { static constexpr int NM = NM_, NN = NN_, LDA = LDA_, LDB = LDB_, K = K_, AMASK = AMASK_, ASH = ASH_, BSH = BSH_; static constexpr long A_PM = A_PM_, A_HI = A_HI_, A_PN = A_PN_, B_HI = B_HI_, B_PN = B_PN_; static constexpr bool REV = REV_; };
template <int MROWS, int NCOLS, int LDA_, int LDB_, int K_> using CfgStd = Cfg<MROWS / 256, NCOLS / 256, LDA_, LDB_, K_, -1, 31, 256L * LDA_, 0, 0, 31, 0, 256L * LDB_>;
template <int MROWS, int NCOLS, int LDA_, int LDB_, int K_> using CfgStdRev = Cfg<MROWS / 256, NCOLS / 256, LDA_, LDB_, K_, -1, 31, 256L * LDA_, 0, 0, 31, 0, 256L * LDB_, true>;

template <class C> struct Order {
    int G, c, rev;
    DI bool next(int i, Unit& u) const {
        constexpr int nM = C::NM, nN = C::NN, nwg = nM * nN;
        const int L = i * G + c; if (L >= nwg) return false;
        int wgid = L; { constexpr int q = nwg / NXCD, r = nwg % NXCD; const int xcd = wgid % NXCD, off = wgid / NXCD; wgid = (xcd < r ? xcd * (q + 1) : r * (q + 1) + (xcd - r) * q) + off; }
        constexpr int nig = WGM * nN; const int gid = wgid / nig, fm = gid * WGM, gsz = (nM - fm) < WGM ? (nM - fm) : WGM;
        u.pm = fm + ((wgid % nig) % gsz); u.pn = (wgid % nig) / gsz;
        if constexpr (nM % NXCD == 0 && nwg % NXCD == 0) { if (rev) { constexpr int P = nM / NXCD; const int x = u.pm / P; u.pm = x * P + (P - 1 - (u.pm - x * P)); } }
        u.aoff = (long)(u.pm & C::AMASK) * C::A_PM + (long)(u.pm >> C::ASH) * C::A_HI + (long)u.pn * C::A_PN;
        u.boff = (long)(u.pm >> C::BSH) * C::B_HI + (long)u.pn * C::B_PN;
        return true;
    }
};

template <class E, class = void> struct EpiNst { static constexpr int value = 0; };
template <class E> struct EpiNst<E, decltype((void)E::NST)> { static constexpr int value = E::NST; };
template <int N> DI void pg8_waitv() { asm volatile("s_waitcnt vmcnt(%0)" :: "n"(N) : "memory"); }
struct NoHook { DI void operator()() const {} };
template <class C, class Epi, class Hook = NoHook>
DI void gemm_phase(LAS unsigned char* lds, const Gemm g, const int G_, const int c_, const Epi& E, const int rev_ = 0, const Hook& hk = Hook()) {
    int cq = c_; asm volatile("" : "+s"(cq));
    Order<C> S; S.G = G_; S.c = cq; S.rev = rev_;
    const int tid = opaque_tid(), wid = __builtin_amdgcn_readfirstlane(tid >> 6), lane = tid & 63, wr = wid >> 2, wc = wid & 3, fr = lane & 15, fq = lane >> 4;
    constexpr int K = C::K, nt = K / BK; static_assert(K % 128 == 0 && K >= 256, "K");
    unsigned voffA[2], voffB[2];
#pragma unroll
    for (int i = 0; i < 2; ++i) { int R, Cc; stage_rc(tid * 16 + i * 8192, R, Cc); const int Rb = Epi::PERM ? ((R & ~31) + perm32(R & 31)) : R;
        voffA[i] = (unsigned)(R * C::LDA + Cc) * 2u; voffB[i] = (unsigned)(Rb * C::LDB + Cc) * 2u; }
    constexpr size_t kstep = (size_t)(BK * 2);
    constexpr size_t hstepA = (size_t)HALF * C::LDA * 2, hstepB = (size_t)HALF * C::LDB * 2;
    const unsigned ldsw = (unsigned)wid * 1024u;
    const int aoff = lds_byte(wr * 64 + fr, fq * 8), boff = lds_byte(wc * 32 + fr, fq * 8);
#define PG8_SA(b, h) (((b) * 2 + (h)) * HTB)
#define PG8_SB(b, h) ((4 + (b) * 2 + (h)) * HTB)
#define PG8_STAGE(bufoff, gbase, voff) do { _Pragma("unroll") for (int _i = 0; _i < 2; ++_i) \
        __builtin_amdgcn_global_load_lds((const unsigned*)((const char*)(gbase) + (voff)[_i]), (LAS unsigned*)(lds + (bufoff) + ldsw + _i * 8192), 16, 0, 0); } while (0)
#define PG8_LDA(dst, b, h) do { _Pragma("unroll") for (int m = 0; m < 4; ++m) _Pragma("unroll") for (int k = 0; k < 2; ++k) dst[m][k] = *(const LAS bf16x8*)(lds + PG8_SA(b, h) + aoff + m * 2048 + k * 1024); } while (0)
#define PG8_LDB(dst, b, h) do { _Pragma("unroll") for (int n = 0; n < 2; ++n) _Pragma("unroll") for (int k = 0; k < 2; ++k) dst[n][k] = *(const LAS bf16x8*)(lds + PG8_SB(b, h) + boff + n * 2048 + k * 1024); } while (0)
#define PG8_MMA(ai, bj, At, Bt) do { __builtin_amdgcn_s_setprio(1); _Pragma("unroll") for (int m = 0; m < 4; ++m) _Pragma("unroll") for (int n = 0; n < 2; ++n) _Pragma("unroll") for (int k = 0; k < 2; ++k) \
        acc[ai][bj][m][n] = __builtin_amdgcn_mfma_f32_16x16x32_bf16(Bt[n][k], At[m][k], acc[ai][bj][m][n], 0, 0, 0); __builtin_amdgcn_s_setprio(0); } while (0)
#define PG8_WAIT_V(n) asm volatile("s_waitcnt vmcnt(" #n ")" ::: "memory")
#define PG8_WAIT_L(n) asm volatile("s_waitcnt lgkmcnt(" #n ")" ::: "memory")
#define PG8_BAR __builtin_amdgcn_s_barrier()
#define PG8_SCHED __builtin_amdgcn_sched_barrier(0)
    Unit cur, nxt; int ui = 0; bool after_epi = false;
    if (!S.next(0, cur)) return;
    f32x4 acc[2][2][4][2];
#pragma unroll
    for (int a = 0; a < 2; ++a)
#pragma unroll
        for (int b = 0; b < 2; ++b)
#pragma unroll
            for (int m = 0; m < 4; ++m)
#pragma unroll
                for (int n = 0; n < 2; ++n) acc[a][b][m][n] = (f32x4){0.f, 0.f, 0.f, 0.f};
    bf16x8 At[4][2], B0[2][2], B1[2][2];
    const char* cA = (const char*)(g.A + cur.aoff); const char* cB = (const char*)(g.Bt + cur.boff);
    PG8_STAGE(PG8_SB(0, 0), cB, voffB); PG8_STAGE(PG8_SB(0, 1), cB + hstepB, voffB); PG8_STAGE(PG8_SA(0, 0), cA, voffA); PG8_STAGE(PG8_SA(0, 1), cA + hstepA, voffA);
    hk();
    if (wr == 1) PG8_BAR;
    PG8_WAIT_V(2); PG8_BAR;
    PG8_STAGE(PG8_SB(1, 0), cB + kstep, voffB); PG8_STAGE(PG8_SA(1, 0), cA + kstep, voffA); PG8_STAGE(PG8_SB(1, 1), cB + hstepB + kstep, voffB);
    PG8_WAIT_V(6); PG8_BAR;
    for (;;) {
        const bool has_next = S.next(ui + 1, nxt);
        constexpr int NST = EpiNst<Epi>::value;
        const char* nA = has_next ? (const char*)(g.A + nxt.aoff) : cA; const char* nB = has_next ? (const char*)(g.Bt + nxt.boff) : cB;
#pragma nounroll
        for (int t = 0; t < nt; t += 2) {
            const bool last = (t == nt - 2); const bool fst = (NST > 0) && after_epi && (t == 0);
            const char* a1 = cA + (size_t)(t + 1) * kstep;
            const char* a2 = last ? nA : cA + (size_t)(t + 2) * kstep; const char* b2 = last ? nB : cB + (size_t)(t + 2) * kstep;
            const char* a3 = a2 + kstep; const char* b3 = b2 + kstep;
            PG8_LDB(B0, 0, 0); PG8_LDB(B1, 0, 1); PG8_SCHED; PG8_LDA(At, 0, 0); PG8_STAGE(PG8_SA(1, 1), a1 + hstepA, voffA);
            if (fst) pg8_waitv<8 + NST>(); else PG8_WAIT_V(8);
            PG8_WAIT_L(0); PG8_BAR; PG8_MMA(0, 0, At, B0); PG8_MMA(0, 1, At, B1); PG8_BAR; PG8_SCHED;
            PG8_LDA(At, 0, 1); PG8_STAGE(PG8_SB(0, 0), b2, voffB); PG8_STAGE(PG8_SB(0, 1), b2 + hstepB, voffB); PG8_STAGE(PG8_SA(0, 0), a2, voffA);
            if (fst) pg8_waitv<8 + NST>(); else PG8_WAIT_V(8);
            PG8_WAIT_L(0); PG8_BAR; PG8_MMA(1, 0, At, B0); PG8_MMA(1, 1, At, B1); PG8_BAR; PG8_SCHED;
            PG8_LDB(B0, 1, 0); PG8_LDB(B1, 1, 1); PG8_SCHED; PG8_LDA(At, 1, 0); PG8_STAGE(PG8_SA(0, 1), a2 + hstepA, voffA);
            PG8_WAIT_V(8); PG8_WAIT_L(0); PG8_BAR; PG8_MMA(0, 0, At, B0); PG8_MMA(0, 1, At, B1); PG8_BAR; PG8_SCHED;
            PG8_LDA(At, 1, 1); PG8_STAGE(PG8_SB(1, 0), b3, voffB); PG8_STAGE(PG8_SB(1, 1), b3 + hstepB, voffB); PG8_STAGE(PG8_SA(1, 0), a3, voffA);
            PG8_WAIT_V(8); PG8_WAIT_L(0); PG8_BAR; PG8_MMA(1, 0, At, B0); PG8_MMA(1, 1, At, B1); PG8_BAR; PG8_SCHED;
        }
        if (wr == 0) PG8_BAR;
        E(acc, cur, wr, wc, fr, fq);
        if (!has_next) break;
#pragma unroll
        for (int a = 0; a < 2; ++a)
#pragma unroll
            for (int b = 0; b < 2; ++b)
#pragma unroll
                for (int m = 0; m < 4; ++m)
#pragma unroll
                    for (int n = 0; n < 2; ++n) acc[a][b][m][n] = (f32x4){0.f, 0.f, 0.f, 0.f};
        cur = nxt; cA = nA; cB = nB; ++ui; after_epi = true;
        if (wr == 1) PG8_BAR;
    }
    PG8_WAIT_V(0);
    PG8_BAR;
#undef PG8_SA
#undef PG8_SB
#undef PG8_STAGE
#undef PG8_LDA
#undef PG8_LDB
#undef PG8_MMA
#undef PG8_WAIT_V
#undef PG8_WAIT_L
#undef PG8_BAR
#undef PG8_SCHED
}
}
using pg8::Unit;

constexpr size_t MiB = 1u << 20;
constexpr size_t WS_CTL = 0, CTL_ZERO_BYTES = 1 * MiB;
constexpr size_t WS_SSQ = 1 * MiB;
constexpr size_t WS_QSS = 5 * MiB;
constexpr size_t WS_LS = 9 * MiB;
constexpr size_t WS_ZS = 13 * MiB;
constexpr size_t WS_GNS = 15 * MiB;
constexpr size_t WS_KSS = 23 * MiB;
constexpr size_t WS_RMEM = 24 * MiB;
constexpr size_t WS_MEMB = 25 * MiB;
constexpr size_t WS_KP = 33 * MiB;
constexpr size_t WS_VT = 65 * MiB;
constexpr size_t WS_W = 97 * MiB;
constexpr size_t W_LAYER = 37 * MiB;
constexpr size_t WO_GU1 = 0, WO_D1 = 11 * MiB, WO_GU2 = 16 * MiB + MiB / 2, WO_D2 = 27 * MiB + MiB / 2, WO_Q = 33 * MiB, WO_O = 35 * MiB;
constexpr size_t WS_WE = WS_W + 4 * W_LAYER;
constexpr size_t W_EVEN = 6 * MiB + MiB / 2, WE_IN = 0, WE_S2 = 3 * MiB, WE_OUT = 4 * MiB + MiB / 2;
constexpr size_t WS_WO = WS_WE + 2 * W_EVEN;
constexpr size_t W_ODD = 16 * MiB, WOD_IN = 0, WOD_OUT = 12 * MiB;
constexpr size_t WS_XB = WS_WO + 2 * W_ODD;
constexpr size_t WS_ACT = WS_XB + 128 * MiB;
constexpr size_t WS_VW = WS_ACT + 512 * MiB;
constexpr size_t WS_END = WS_VW + 32 * MiB;
static_assert(WS_XB == 290 * MiB && WS_END == 962 * MiB, "ws map");
constexpr size_t A_H = 0;
constexpr size_t A_AB = 0, A_ZC = 64 * MiB, A_KR = 112 * MiB, A_QH = 116 * MiB, A_KN = 212 * MiB, A_VB = 276 * MiB, A_MIX = 340 * MiB;
constexpr size_t A_RQ = 0, A_RK = 128 * MiB, A_RV = 256 * MiB;
constexpr size_t A_XQ = 0, A_XP = 128 * MiB, A_XO = 256 * MiB;
constexpr size_t A_WK = 0, A_WV = 8 * MiB;
constexpr int CW_BAR = 4096;
constexpr int CW_KMAX = 16384;
constexpr int CW_SHE = 16384 + 512;
constexpr int CW_TAB = 32768;
DI const float* inp_ptr(const unsigned char* ws, int i) {
    const unsigned long long v = ((const unsigned long long*)(ws + WS_CTL + CW_TAB * 4))[i];
    const unsigned lo = __builtin_amdgcn_readfirstlane((unsigned)v), hi = __builtin_amdgcn_readfirstlane((unsigned)(v >> 32));
    return (const float*)(GAS const float*)(((unsigned long long)hi << 32) | lo); }
#define INP(i) inp_ptr(ws, (i))

constexpr int RING_BYTES = 131072;
constexpr int LDSCTL_OFF = RING_BYTES + 16384;
constexpr int LDS_BYTES = LDSCTL_OFF + 256;
static_assert(LDS_BYTES <= 160 * 1024 && LDS_BYTES > 80 * 1024, "LDS");

#define XB_TMO      128
#define XB_XCNT(j)  (256  + 64 * (j))
#define XB_XSUB(j)  (1280 + 64 * (j))
#define XB_XGEN(j)  (2304 + 64 * (j))
#define XB_TOP      3328
#define XB_TOPGEN   3392
#define XCD_BAR_WORDS 3456
#define XB_SPIN_CAP (1u << 22)
DI unsigned xb_ld(unsigned* p)              { return __hip_atomic_load(p, __ATOMIC_RELAXED, __HIP_MEMORY_SCOPE_AGENT); }
DI unsigned xb_add(unsigned* p, unsigned v) { return __hip_atomic_fetch_add(p, v, __ATOMIC_RELAXED, __HIP_MEMORY_SCOPE_AGENT); }
DI unsigned xb_xcc_id() { return (unsigned)__builtin_amdgcn_s_getreg((3 << 11) | 20) & 0xFu; }
#define XB_SPIN(cond, bar) do { unsigned _sp = 0; while (cond) { __builtin_amdgcn_s_sleep(1); \
    if ((++_sp & 255u) == 0u) { if (xb_ld(&(bar)[XB_TMO])) break; if (_sp > XB_SPIN_CAP) { atomicAdd(&(bar)[XB_TMO], 1u); break; } } } } while (0)
struct XcdBarrier { unsigned* bar; unsigned x; volatile LAS unsigned* st; };
DI XcdBarrier xcd_barrier_post(unsigned* bar, volatile LAS unsigned* st) {
    XcdBarrier b; b.bar = bar; b.x = xb_xcc_id(); b.st = st;
    if (threadIdx.x == 0) st[2] = xb_add(&bar[XB_XCNT(b.x)], 1u);
    return b;
}
#define XL_SUB(j)   (XCD_BAR_WORDS + 64 * (j))
#define XL_GEN(j)   (XCD_BAR_WORDS + 1024 + 64 * (j))
DI void xcd_local_barrier(const XcdBarrier& b) {
    asm volatile("s_waitcnt vmcnt(0)" ::: "memory");
    __syncthreads();
    if (threadIdx.x == 0) {
        unsigned* bar = b.bar;
        unsigned bx = b.x; asm volatile("" : "+s"(bx));
        __builtin_amdgcn_s_waitcnt(0);
        const unsigned target = b.st[4] + b.st[0]; b.st[4] = target;
        (void)__hip_atomic_fetch_add(&bar[XL_SUB(bx)], 1u, __ATOMIC_RELAXED, __HIP_MEMORY_SCOPE_AGENT);
        XB_SPIN(xb_ld(&bar[XL_SUB(bx)]) < target, bar);
        __builtin_amdgcn_fence(__ATOMIC_ACQUIRE, "agent");
        asm volatile("s_waitcnt vmcnt(0)" ::: "memory");
    }
    __syncthreads();
}
DI void cu_local_seam() {
    asm volatile("s_waitcnt vmcnt(0)" ::: "memory");
    __syncthreads();
    if (threadIdx.x == 0) { __builtin_amdgcn_fence(__ATOMIC_ACQUIRE, "agent"); asm volatile("s_waitcnt vmcnt(0)" ::: "memory"); }
    __syncthreads();
}
DI void xcd_barrier_complete(unsigned* bar, unsigned x, unsigned& nloc, unsigned& nx) {
    const unsigned G = gridDim.x * gridDim.y * gridDim.z;
    unsigned sum, cnt, mine, sp = 0u;
    for (;;) {
        sum = 0u; cnt = 0u; mine = 0u;
#pragma unroll
        for (unsigned j = 0; j < 16; ++j) { const unsigned c = xb_ld(&bar[XB_XCNT(j)]); sum += c; cnt += (c > 0u) ? 1u : 0u; mine = (j == x) ? c : mine; }
        if (sum == G) break;
        __builtin_amdgcn_s_sleep(1);
        if ((++sp & 255u) == 0u) { if (xb_ld(&bar[XB_TMO])) break; if (sp > XB_SPIN_CAP) { atomicAdd(&bar[XB_TMO], 1u); break; } }
    }
    nloc = mine > 0u ? mine : 1u; nx = cnt > 0u ? cnt : 1u;
}
DI void xcd_barrier(const XcdBarrier& b) {
    asm volatile("s_waitcnt vmcnt(0)" ::: "memory");
    __syncthreads();
    if (threadIdx.x == 0) {
        unsigned* bar = b.bar;
        unsigned bx = b.x; asm volatile("" : "+s"(bx));
        __builtin_amdgcn_s_waitcnt(0);
        unsigned nloc = b.st[0], nx = b.st[1];
        if (nloc == 0u) { xcd_barrier_complete(bar, bx, nloc, nx); b.st[0] = nloc; b.st[1] = nx; }
        const unsigned old = xb_add(&bar[XB_XSUB(bx)], 1u);
        const unsigned gen = old / nloc;
        if (old + 1u == (gen + 1u) * nloc) {
            __builtin_amdgcn_fence(__ATOMIC_RELEASE, "agent");
            asm volatile("s_waitcnt vmcnt(0)" ::: "memory");
            const unsigned og = xb_add(&bar[XB_TOP], 1u);
            const unsigned tg = og / nx;
            if (og + 1u == (tg + 1u) * nx) xb_add(&bar[XB_TOPGEN], 1u);
            else XB_SPIN(xb_ld(&bar[XB_TOPGEN]) == tg, bar);
            __builtin_amdgcn_fence(__ATOMIC_ACQUIRE, "agent");
            xb_add(&bar[XB_XGEN(bx)], 1u);
            asm volatile("s_waitcnt vmcnt(0)" ::: "memory");
        } else {
            XB_SPIN(xb_ld(&bar[XB_XGEN(bx)]) == gen, bar);
            __builtin_amdgcn_fence(__ATOMIC_ACQUIRE, "agent");
            asm volatile("s_waitcnt vmcnt(0)" ::: "memory");
        }
    }
    __syncthreads();
}

#define EPI_FENCE() do { asm volatile("" ::: "memory"); __builtin_amdgcn_sched_barrier(0); } while (0)
#define EPI_ROW(u, ai, m) ((u).pm * 256 + (ai) * 128 + wr * 64 + (m) * 16 + fr)
DI float sum4(f32x4 a) { return (a.x + a.y) + (a.z + a.w); }
DI float dot4(f32x4 a) { return (a.x * a.x + a.y * a.y) + (a.z * a.z + a.w * a.w); }
DI float rstd16(const float* p16, float invn) {
    const f32x4* p = (const f32x4*)p16; const f32x4 a = p[0], b = p[1], c = p[2], d = p[3];
    return fast_rsq(((sum4(a) + sum4(b)) + (sum4(c) + sum4(d))) * invn + EPS);
}
DI float rstd4(const float* p4, float invn) { const f32x4 a = *(const f32x4*)p4; return fast_rsq(sum4(a) * invn + EPS); }
DI float red_fq(float s) { s += __shfl_xor(s, 16); s += __shfl_xor(s, 32); return s; }
DI u32x4 pack8(f32x4 a, f32x4 b) { u32x4 w; w.x = cvt_pk_bf16(a.x, a.y); w.y = cvt_pk_bf16(a.z, a.w); w.z = cvt_pk_bf16(b.x, b.y); w.w = cvt_pk_bf16(b.z, b.w); return w; }
DI u32x2 pack4(f32x4 a) { u32x2 w; w.x = cvt_pk_bf16(a.x, a.y); w.y = cvt_pk_bf16(a.z, a.w); return w; }
DI f32x4 silu4(f32x4 g) { f32x4 o; o.x = g.x * sigmoidf_(g.x); o.y = g.y * sigmoidf_(g.y); o.z = g.z * sigmoidf_(g.z); o.w = g.w * sigmoidf_(g.w); return o; }
DI f32x4 sig4(f32x4 g) { f32x4 o; o.x = sigmoidf_(g.x); o.y = sigmoidf_(g.y); o.z = sigmoidf_(g.z); o.w = sigmoidf_(g.w); return o; }
typedef f32x4 AccT[2][2][4][2];

#define EPI_OPAQUE() int fr = fr_, fq = fq_; asm volatile("" : "+v"(fr), "+v"(fq))
#define EPI_ROWK(u, k) EPI_ROW(u, (k) >> 2, (k) & 3)
DI void rstd_rows16(const float* ssq, const Unit& u, int wr, int fr, int fq, float (&r)[8]) {
    f32x4 p[8];
#pragma unroll
    for (int k = 0; k < 8; ++k) p[k] = *(const f32x4*)(ssq + (size_t)EPI_ROWK(u, k) * 16 + fq * 4);
#pragma unroll
    for (int k = 0; k < 8; ++k) r[k] = fast_rsq(red_fq(sum4(p[k])) * (1.0f / D) + EPS);
}
DI void sum4_rows(const float* base, int stride, int off, const Unit& u, int wr, int fr, float (&r)[8]) {
    f32x4 p[8];
#pragma unroll
    for (int k = 0; k < 8; ++k) p[k] = *(const f32x4*)(base + (size_t)EPI_ROWK(u, k) * stride + off);
#pragma unroll
    for (int k = 0; k < 8; ++k) r[k] = sum4(p[k]);
}
DI void pos_rows(const int* pos, const Unit& u, int wr, int fr, float (&r)[8]) {
    int p[8];
#pragma unroll
    for (int k = 0; k < 8; ++k) p[k] = pos[EPI_ROWK(u, k)];
#pragma unroll
    for (int k = 0; k < 8; ++k) r[k] = (float)p[k];
}
constexpr int RT_OFF = 131072 + 4096, PT_OFF = RT_OFF + 4096, ZT_OFF = PT_OFF + 4096, GT_OFF = 131072;
DI void row_tables(LAS unsigned char* lds, const float* ssq, const int* pos, int x, int j, int rev) {
    const int tid = opaque_tid(); LAS float* rt = (LAS float*)(lds + RT_OFF); LAS float* pt = (LAS float*)(lds + PT_OFF);
    const int pin = rev ? 7 - (j & 7) : (j & 7);
#pragma unroll
    for (int i = 0; i < 2; ++i) { const int ri = tid + 512 * i, s = ri >> 8, rl = ri & 255; const size_t row = (size_t)(32 * x + 8 * s + pin) * 256 + rl;
        const f32x4* p = (const f32x4*)(ssq + row * 16); const f32x4 a = p[0], b = p[1], c = p[2], d = p[3];
        rt[ri] = fast_rsq(((sum4(a) + sum4(b)) + (sum4(c) + sum4(d))) * (1.0f / D) + EPS);
        if (pos) pt[ri] = (float)pos[row]; }
    asm volatile("s_waitcnt lgkmcnt(0)\n\ts_barrier" ::: "memory");
}
DI void score_tables(LAS unsigned char* lds, const float* qss, const unsigned* kmax, int x, int j, int rev) {
    const int tid = opaque_tid(); LAS float* t1 = (LAS float*)(lds + RT_OFF); const int hd = j >> 3;
    const int pin = rev ? 7 - (j & 7) : (j & 7);
#pragma unroll
    for (int i = 0; i < 2; ++i) { const int ri = tid + 512 * i, s = ri >> 8, rl = ri & 255; const size_t row = (size_t)(32 * x + 8 * s + pin) * 256 + rl;
        t1[ri] = sum4(*(const f32x4*)(qss + row * 16 + hd * 4)); }
    if (tid < 4) t1[1024 + tid] = 16.0f * __uint_as_float(kmax[((32 * x + 8 * tid) >> 4) * 4 + hd]);
    asm volatile("s_waitcnt lgkmcnt(0)\n\ts_barrier" ::: "memory");
}
DI void stage2_tables(LAS unsigned char* lds, const float* zs, const int* pos, const float* gqn, const float* gkn, const float* gqr, int x, int j, int rev) {
    const int tid = opaque_tid(); LAS float* t1 = (LAS float*)(lds + RT_OFF); LAS float* t2 = (LAS float*)(lds + ZT_OFF); LAS float* pt = (LAS float*)(lds + PT_OFF); LAS float* gt = (LAS float*)(lds + GT_OFF);
    const int pin = rev ? 7 - (j & 7) : (j & 7);
#pragma unroll
    for (int i = 0; i < 2; ++i) { const int ri = tid + 512 * i, s = ri >> 8, rl = ri & 255; const size_t row = (size_t)(32 * x + 8 * s + pin) * 256 + rl;
        const f32x4 a = *(const f32x4*)(zs + row * 8), b = *(const f32x4*)(zs + row * 8 + 4);
        t1[ri] = fast_rsq(sum4(a) * (1.0f / QLORA) + EPS); t2[ri] = fast_rsq(sum4(b) * (1.0f / KVLORA) + EPS); pt[ri] = (float)pos[row]; }
    if (tid < 64) { gt[tid] = gqn[tid]; gt[64 + tid] = gkn[tid]; if (tid < 32) gt[128 + tid] = gqr[tid]; }
    asm volatile("s_waitcnt lgkmcnt(0)\n\ts_barrier" ::: "memory");
}
DI void tab_rows(const LAS float* t, const Unit& u, int wr, int fr, float (&r)[8]) {
    const LAS float* b = t + ((u.pm >> 3) & 3) * 256 + wr * 64 + fr;
#pragma unroll
    for (int k = 0; k < 8; ++k) r[k] = b[(k >> 2) * 128 + (k & 3) * 16];
}
#define EPI_GROUPS() _Pragma("unroll") for (int k = 0; k < 8; ++k)
#define EPI_K() const int ai = k >> 2, m = k & 3; __builtin_amdgcn_sched_barrier(0); const int row = EPI_ROW(u, ai, m)

struct EpiSwiGLU { static constexpr bool PERM = true; static constexpr int NST = 8; bf16_t* H; const float* ssq; const LAS float* rt = nullptr;
    DI float one(float ag, float au, float nr, float c) const { asm volatile("" : "+v"(ag), "+v"(au));
        const float e = fast_exp2(ag * nr), d = __builtin_fmaf(e, c, c); return (ag * au) * fast_rcp(d); }
    DI void operator()(const AccT& acc, const Unit& u, int wr, int wc, int fr_, int fq_) const { EPI_OPAQUE();
        float r[8]; if (rt) tab_rows(rt, u, wr, fr, r); else rstd_rows16(ssq, u, wr, fr, fq, r);
        EPI_GROUPS() { EPI_K();
            const float nr = -LOG2E * r[k], c = fast_rcp(r[k] * r[k]);
            f32x4 h0, h1;
#pragma unroll
            for (int j = 0; j < 4; ++j) { h0[j] = one(acc[ai][0][m][0][j], acc[ai][1][m][0][j], nr, c); h1[j] = one(acc[ai][0][m][1][j], acc[ai][1][m][1][j], nr, c); }
            *(u32x4*)(H + (size_t)row * DFF + u.pn * 128 + wc * 32 + 8 * fq) = pack8(h0, h1); }
    }
};
template <bool FINAL> struct EpiResid { static constexpr bool PERM = true; static constexpr int NST = 16; bf16_t* xb; float* ssq; float* out;
    DI void operator()(const AccT& acc, const Unit& u, int wr, int wc, int fr_, int fq_) const { EPI_OPAQUE();
#pragma unroll
        for (int ai = 0; ai < 2; ++ai) {
            u32x4 w[4][2];
#pragma unroll
            for (int m = 0; m < 4; ++m)
#pragma unroll
                for (int bj = 0; bj < 2; ++bj) w[m][bj] = *(const u32x4*)(xb + (size_t)EPI_ROW(u, ai, m) * D + u.pn * 256 + wc * 32 + 8 * fq + bj * 128);
#pragma unroll
            for (int m = 0; m < 4; ++m) { __builtin_amdgcn_sched_barrier(0); const int row = EPI_ROW(u, ai, m); float s = 0.f; const size_t ro = (size_t)row * D + u.pn * 256 + wc * 32 + 8 * fq;
#pragma unroll
                for (int bj = 0; bj < 2; ++bj) { const size_t o = ro + bj * 128; const u32x4 ww = w[m][bj];
                    const f32x4 x0 = (f32x4){bf_lo(ww.x), bf_hi(ww.x), bf_lo(ww.y), bf_hi(ww.y)} + acc[ai][bj][m][0], x1 = (f32x4){bf_lo(ww.z), bf_hi(ww.z), bf_lo(ww.w), bf_hi(ww.w)} + acc[ai][bj][m][1];
                    if (FINAL) { *(f32x4*)(out + o) = x0; *(f32x4*)(out + o + 4) = x1; }
                    else { *(u32x4*)(xb + o) = pack8(x0, x1); s += dot4(x0) + dot4(x1); } }
                if (!FINAL) { s = red_fq(s); if (fq == 0) ssq[(size_t)row * 16 + u.pn * 4 + wc] = s; } }
        }
    }
};
struct EpiQraw { static constexpr bool PERM = true; static constexpr int NST = 16; bf16_t* Q; const float* ssq; float* qss; const LAS float* rt = nullptr;
    DI void operator()(const AccT& acc, const Unit& u, int wr, int wc, int fr_, int fq_) const { EPI_OPAQUE();
        float r[8]; if (rt) tab_rows(rt, u, wr, fr, r); else rstd_rows16(ssq, u, wr, fr, fq, r);
        EPI_GROUPS() { EPI_K(); float s = 0.f;
#pragma unroll
            for (int bj = 0; bj < 2; ++bj) { const f32x4 v0 = acc[ai][bj][m][0] * r[k], v1 = acc[ai][bj][m][1] * r[k]; s += dot4(v0) + dot4(v1);
                *(u32x4*)(Q + (size_t)row * D + u.pn * 256 + bj * 128 + wc * 32 + 8 * fq) = pack8(v0, v1); }
            s = red_fq(s); if (fq == 0) qss[(size_t)row * 16 + u.pn * 4 + wc] = s; }
    }
};
struct EpiScoresN { static constexpr bool PERM = true; static constexpr int NST = 16; bf16_t* P; const LAS float* qt; LAS float* tab;
    DI void operator()(const AccT& acc, const Unit& u, int wr, int wc, int fr_, int fq_) const { EPI_OPAQUE();
        const float sh = qt[1024 + ((u.pm >> 3) & 3)];
        float rq[8]; tab_rows(qt, u, wr, fr, rq);
        u32x4 w[8][2];
        EPI_GROUPS() { const int ai = k >> 2, m = k & 3; __builtin_amdgcn_sched_barrier(0);
            const float rqk = fast_rsq(rq[k] * (1.0f / XHD) + EPS); float sm = 0.f;
#pragma unroll
            for (int bj = 0; bj < 2; ++bj) { f32x4 p0, p1;
#pragma unroll
                for (int j = 0; j < 4; ++j) { p0[j] = fast_exp2(acc[ai][bj][m][0][j] * rqk - sh); p1[j] = fast_exp2(acc[ai][bj][m][1][j] * rqk - sh); }
                const u32x4 ww = pack8(p0, p1); w[k][bj] = ww;
                sm += ((bf_lo(ww.x) + bf_hi(ww.x)) + (bf_lo(ww.y) + bf_hi(ww.y))) + ((bf_lo(ww.z) + bf_hi(ww.z)) + (bf_lo(ww.w) + bf_hi(ww.w))); }
            sm = red_fq(sm); if (fq == 0) tab[(ai * 128 + wr * 64 + m * 16 + fr) * 4 + wc] = sm; }
        asm volatile("s_waitcnt lgkmcnt(0)\n\ts_barrier" ::: "memory");
        EPI_GROUPS() { const int ai = k >> 2, m = k & 3; __builtin_amdgcn_sched_barrier(0); const int row = EPI_ROW(u, ai, m);
            const float li = fast_rcp(sum4(*(const LAS f32x4*)(tab + (ai * 128 + wr * 64 + m * 16 + fr) * 4)));
#pragma unroll
            for (int bj = 0; bj < 2; ++bj) { const u32x4 ww = w[k][bj];
                const f32x4 a = (f32x4){bf_lo(ww.x), bf_hi(ww.x), bf_lo(ww.y), bf_hi(ww.y)} * li, b = (f32x4){bf_lo(ww.z), bf_hi(ww.z), bf_lo(ww.w), bf_hi(ww.w)} * li;
                *(u32x4*)(P + (size_t)row * D + u.pn * 256 + bj * 128 + wc * 32 + 8 * fq) = pack8(a, b); } }
    }
};
struct EpiVW { static constexpr bool PERM = true; bf16_t* VW;
    DI void operator()(const AccT& acc, const Unit& u, int wr, int wc, int fr_, int fq_) const { EPI_OPAQUE();
        bf16_t* base = VW + ((size_t)(u.pm >> 2) * D + (u.pm & 3) * 256) * (XH * MEMLEN) + u.pn * MEMLEN + wc * 32 + 8 * fq;
        EPI_GROUPS() { const int ai = k >> 2, m = k & 3; __builtin_amdgcn_sched_barrier(0); const int r = ai * 128 + wr * 64 + m * 16 + fr;
#pragma unroll
            for (int bj = 0; bj < 2; ++bj) *(u32x4*)(base + (size_t)r * (XH * MEMLEN) + bj * 128) = pack8(acc[ai][bj][m][0], acc[ai][bj][m][1]); }
    }
};
struct EpiMemK { static constexpr bool PERM = true; bf16_t* KP; const float* rmem; float* kss; const float* knorm; const float* qnorm;
    DI void operator()(const AccT& acc, const Unit& u, int wr, int wc, int fr_, int fq_) const { EPI_OPAQUE();
        const int l = u.pm >> 4; f32x4 g[2][2];
#pragma unroll
        for (int bj = 0; bj < 2; ++bj)
#pragma unroll
            for (int n = 0; n < 2; ++n) { const int d = bj * 128 + wc * 32 + 8 * fq + 4 * n; g[bj][n] = *(const f32x4*)(knorm + l * XHD + d) * *(const f32x4*)(qnorm + l * XHD + d) * (LOG2E / 16.0f); }
        float rr[8];
#pragma unroll
        for (int k = 0; k < 8; ++k) rr[k] = rmem[EPI_ROWK(u, k) & (MM - 1)];
        EPI_GROUPS() { EPI_K(); const float r = rr[k]; float s = 0.f;
#pragma unroll
            for (int bj = 0; bj < 2; ++bj) { const f32x4 v0 = acc[ai][bj][m][0] * r, v1 = acc[ai][bj][m][1] * r; s += dot4(v0) + dot4(v1);
                *(u32x4*)(KP + (size_t)row * D + u.pn * 256 + bj * 128 + wc * 32 + 8 * fq) = pack8(v0 * g[bj][0], v1 * g[bj][1]); }
            s = red_fq(s); if (fq == 0) kss[(size_t)row * 16 + u.pn * 4 + wc] = s; }
    }
};
struct EpiMemV { static constexpr bool PERM = true; bf16_t* V; const float* rmem;
    DI void operator()(const AccT& acc, const Unit& u, int wr, int wc, int fr_, int fq_) const { EPI_OPAQUE();
        float rr[8];
#pragma unroll
        for (int k = 0; k < 8; ++k) rr[k] = rmem[EPI_ROWK(u, k) & (MM - 1)];
        EPI_GROUPS() { EPI_K(); const float r = rr[k];
#pragma unroll
            for (int bj = 0; bj < 2; ++bj) *(u32x4*)(V + (size_t)row * D + u.pn * 256 + bj * 128 + wc * 32 + 8 * fq) = pack8(acc[ai][bj][m][0] * r, acc[ai][bj][m][1] * r); }
    }
};
constexpr float LOG2_THETA = 13.287712379549449f;
DI void rope_mla(f32x4& x1, f32x4& x2, float pos, int fq) {
#pragma unroll
    for (int j = 0; j < 4; ++j) { const float inv = fast_exp2(-(float)(4 * fq + j) * (LOG2_THETA / 16.0f)); float s, c; sincos_turns(pos * inv, s, c);
        const float a = x1[j], b = x2[j]; x1[j] = a * c - b * s; x2[j] = a * s + b * c; }
}
struct EpiEven1 { static constexpr bool PERM = true; bf16_t* AB; bf16_t* ZC; bf16_t* KR; const float* ssq; float* zs; const float* gkr; const int* pos; const LAS float* rt = nullptr; const LAS float* pt = nullptr;
    DI void operator()(const AccT& acc, const Unit& u, int wr, int wc, int fr_, int fq_) const { EPI_OPAQUE();
        float rr[8]; if (rt) tab_rows(rt, u, wr, fr, rr); else rstd_rows16(ssq, u, wr, fr, fq, rr);
        float pp[8];
        if (u.pn == 5 && wc == 0) { if (pt) tab_rows(pt, u, wr, fr, pp); else pos_rows(pos, u, wr, fr, pp); }
        EPI_GROUPS() { EPI_K(); const float r = rr[k];
            if (u.pn < 4) {
                const f32x4 a0 = (acc[ai][0][m][0] * r) * sig4(acc[ai][1][m][0] * r), a1 = (acc[ai][0][m][1] * r) * sig4(acc[ai][1][m][1] * r);
                *(u32x4*)(AB + (size_t)row * CONV_DIM + u.pn * 128 + wc * 32 + 8 * fq) = pack8(a0, a1);
            } else if (u.pn == 4) {
                float s = 0.f;
#pragma unroll
                for (int bj = 0; bj < 2; ++bj) { const f32x4 v0 = acc[ai][bj][m][0] * r, v1 = acc[ai][bj][m][1] * r; s += dot4(v0) + dot4(v1);
                    *(u32x4*)(ZC + (size_t)row * S2K + bj * 128 + wc * 32 + 8 * fq) = pack8(v0, v1); }
                s = red_fq(s); if (fq == 0) zs[(size_t)row * 8 + wc] = s;
            } else {
                { const f32x4 v0 = acc[ai][0][m][0] * r, v1 = acc[ai][0][m][1] * r; float s = red_fq(dot4(v0) + dot4(v1));
                  *(u32x4*)(ZC + (size_t)row * S2K + 256 + wc * 32 + 8 * fq) = pack8(v0, v1); if (fq == 0) zs[(size_t)row * 8 + 4 + wc] = s; }
                if (wc == 0) {
                    f32x4 x1 = acc[ai][1][m][0] * r, x2 = acc[ai][1][m][1] * r; const float ss = red_fq(dot4(x1) + dot4(x2));
                    const float rn = fast_rsq(ss * (1.0f / QK_ROPE) + EPS);
                    x1 = x1 * rn * *(const f32x4*)(gkr + 4 * fq); x2 = x2 * rn * *(const f32x4*)(gkr + 16 + 4 * fq);
                    rope_mla(x1, x2, pp[k], fq);
                    *(u32x2*)(KR + (size_t)row * QK_ROPE + 4 * fq) = pack4(x1); *(u32x2*)(KR + (size_t)row * QK_ROPE + 16 + 4 * fq) = pack4(x2);
                }
            }
        }
    }
};
struct EpiEven2 { static constexpr bool PERM = true; static constexpr int NST = 16; bf16_t* QH; bf16_t* KN; bf16_t* VB; const LAS float* tb; float qscale;
    DI void operator()(const AccT& acc, const Unit& u, int wr, int wc, int fr_, int fq_) const { EPI_OPAQUE();
        const bool isq = u.pn < 3; const int ws = (isq ? u.pn : u.pn - 3) * 4 + wc;
        const LAS float* gt = tb + (GT_OFF - RT_OFF) / 4;
        float zz[8]; tab_rows(isq ? tb : tb + (ZT_OFF - RT_OFF) / 4, u, wr, fr, zz);
        float pp[8];
        if (isq && ws >= 8) tab_rows(tb + (PT_OFF - RT_OFF) / 4, u, wr, fr, pp);
        f32x4 G[2][2];
        if (ws < 8) {
#pragma unroll
            for (int bj = 0; bj < 2; ++bj) { const LAS float* g = gt + (isq ? 0 : 64) + 32 * bj + 8 * fq; G[bj][0] = *(const LAS f32x4*)g; G[bj][1] = *(const LAS f32x4*)(g + 4); }
        } else { G[0][0] = *(const LAS f32x4*)(gt + 128 + 4 * fq); G[0][1] = *(const LAS f32x4*)(gt + 128 + 16 + 4 * fq); G[1][0] = G[0][0]; G[1][1] = G[0][1]; }
        EPI_GROUPS() { EPI_K();
            const float rz = zz[k];
            if (ws < 8) {
                f32x4 v[2][2]; float s = 0.f;
#pragma unroll
                for (int bj = 0; bj < 2; ++bj)
#pragma unroll
                    for (int n = 0; n < 2; ++n) { v[bj][n] = acc[ai][bj][m][n] * rz; s += dot4(v[bj][n]); }
                s = red_fq(s); const float rn = fast_rsq(s * (1.0f / QK_NOPE) + EPS) * (isq ? qscale : 1.0f);
                bf16_t* dst = isq ? QH + (size_t)row * 768 + ws * 96 : KN + (size_t)row * 512 + ws * 64;
#pragma unroll
                for (int bj = 0; bj < 2; ++bj) { const int d = 32 * bj + 8 * fq;
                    *(u32x4*)(dst + d) = pack8(v[bj][0] * rn * G[bj][0], v[bj][1] * rn * G[bj][1]); }
            } else if (isq) {
#pragma unroll
                for (int bj = 0; bj < 2; ++bj) { const int head = 2 * (ws - 8) + bj;
                    f32x4 x1 = acc[ai][bj][m][0] * rz, x2 = acc[ai][bj][m][1] * rz; const float ss = red_fq(dot4(x1) + dot4(x2));
                    const float rn = fast_rsq(ss * (1.0f / QK_ROPE) + EPS);
                    x1 = x1 * rn * G[0][0]; x2 = x2 * rn * G[0][1];
                    rope_mla(x1, x2, pp[k], fq);
                    bf16_t* dst = QH + (size_t)row * 768 + head * 96 + 64;
                    *(u32x2*)(dst + 4 * fq) = pack4(x1 * qscale); *(u32x2*)(dst + 16 + 4 * fq) = pack4(x2 * qscale); }
            } else {
#pragma unroll
                for (int bj = 0; bj < 2; ++bj) *(u32x4*)(VB + (size_t)row * 512 + (ws - 8) * 64 + 32 * bj + 8 * fq) = pack8(acc[ai][bj][m][0] * rz, acc[ai][bj][m][1] * rz);
            }
        }
    }
};
struct EpiOdd1 { static constexpr bool PERM = true; static constexpr int NST = 16; bf16_t* Q; bf16_t* Kk; bf16_t* V; const float* ssq; const int* pos; const LAS float* rt = nullptr; const LAS float* pt = nullptr;
    DI void operator()(const AccT& acc, const Unit& u, int wr, int wc, int fr_, int fq_) const { EPI_OPAQUE();
        float rr[8]; if (rt) tab_rows(rt, u, wr, fr, rr); else rstd_rows16(ssq, u, wr, fr, fq, rr);
        if (u.pn < 8) {
            float pp[8]; if (pt) tab_rows(pt, u, wr, fr, pp); else pos_rows(pos, u, wr, fr, pp);
            float inv[2][4];
#pragma unroll
            for (int n = 0; n < 2; ++n)
#pragma unroll
                for (int j = 0; j < 4; ++j) inv[n][j] = fast_exp2(-(float)(32 * wc + 8 * fq + 4 * n + j) * (LOG2_THETA / 128.0f));
            const bool isk = u.pn >= 4; const float osc = isk ? (1.0f / 16.0f) : 1.0f; bf16_t* base = (isk ? Kk : Q) + (u.pn & 3) * 256 + 32 * wc + 8 * fq;
            const float l2gk = __builtin_log2f(1.0f - fast_exp2(-5.0f - (float)(u.pn & 3)));
            EPI_GROUPS() { EPI_K(); const float r = rr[k] * (isk ? osc * fast_exp2(-(float)(16 * m + fr + 1) * l2gk) : 1.0f); const float p = pp[k];
                f32x4 o1[2], o2[2];
#pragma unroll
                for (int n = 0; n < 2; ++n)
#pragma unroll
                    for (int j = 0; j < 4; ++j) { float s, c; sincos_turns(p * inv[n][j], s, c); const float a = acc[ai][0][m][n][j] * r, b = acc[ai][1][m][n][j] * r; o1[n][j] = a * c - b * s; o2[n][j] = a * s + b * c; }
                *(u32x4*)(base + (size_t)row * 1024) = pack8(o1[0], o1[1]); *(u32x4*)(base + (size_t)row * 1024 + 128) = pack8(o2[0], o2[1]); }
        } else {
            EPI_GROUPS() { EPI_K(); const float r = rr[k];
#pragma unroll
                for (int bj = 0; bj < 2; ++bj) *(u32x4*)(V + (size_t)row * ODD_MIX + (u.pn - 8) * 256 + bj * 128 + wc * 32 + 8 * fq) = pack8(acc[ai][bj][m][0] * r, acc[ai][bj][m][1] * r); }
        }
    }
};
struct EpiGate { static constexpr bool PERM = true; static constexpr int NST = 16; bf16_t* O; const float* gns; const LAS float* rt; const LAS float* gt;
    DI void operator()(const AccT& acc, const Unit& u, int wr, int wc, int fr_, int fq_) const { EPI_OPAQUE();
        const int head = u.pn >> 1; const int c0 = u.pn * 256 + wc * 32 + 8 * fq; const int t0 = ((u.pn >> 2) & 1) * 256 + wc * 32 + 8 * fq;
        float rr[8]; tab_rows(rt, u, wr, fr, rr);
#pragma unroll
        for (int ai = 0; ai < 2; ++ai) { EPI_FENCE();
            f32x2 st[4]; u32x4 w[4][2];
#pragma unroll
            for (int m = 0; m < 4; ++m) { const size_t row = EPI_ROW(u, ai, m); st[m] = *(const f32x2*)(gns + row * 32 + head * 8 + fq * 2);
                w[m][0] = *(const u32x4*)(O + row * ODD_MIX + c0); w[m][1] = *(const u32x4*)(O + row * ODD_MIX + c0 + 128); }
            float ga[4], gc[4];
#pragma unroll
            for (int m = 0; m < 4; ++m) {
                const float mean = red_fq(st[m].x) * (1.0f / RET_V), var = red_fq(st[m].y) * (1.0f / RET_V) - mean * mean; ga[m] = fast_rsq(fmaxf(var, 0.f) + EPS); gc[m] = -mean * ga[m]; }
#pragma unroll
            for (int bj = 0; bj < 2; ++bj) { __builtin_amdgcn_sched_barrier(0);
                const int c = c0 + bj * 128, t = t0 + bj * 128;
                const f32x4 G0 = *(const LAS f32x4*)(gt + t), G1 = *(const LAS f32x4*)(gt + t + 4), B0 = *(const LAS f32x4*)(gt + 512 + t), B1 = *(const LAS f32x4*)(gt + 512 + t + 4);
#pragma unroll
                for (int m = 0; m < 4; ++m) { const u32x4 ww = w[m][bj]; const float r = rr[ai * 4 + m];
                    f32x4 o0 = (f32x4){bf_lo(ww.x), bf_hi(ww.x), bf_lo(ww.y), bf_hi(ww.y)}, o1 = (f32x4){bf_lo(ww.z), bf_hi(ww.z), bf_lo(ww.w), bf_hi(ww.w)};
                    o0 = (o0 * ga[m] + gc[m]) * G0 + B0; o1 = (o1 * ga[m] + gc[m]) * G1 + B1;
                    *(u32x4*)(O + (size_t)EPI_ROW(u, ai, m) * ODD_MIX + c) = pack8(silu4(acc[ai][bj][m][0] * r) * o0, silu4(acc[ai][bj][m][1] * r) * o1); }
            }
        }
    }
};
DI void lds_barrier() { asm volatile("s_waitcnt lgkmcnt(0)\n\ts_barrier" ::: "memory"); }
typedef short v4i16_t __attribute__((ext_vector_type(4)));
DI int crow(int r, int hi) { return (r & 3) + 8 * (r >> 2) + 4 * hi; }
#define MFMA32(a, b, c) __builtin_amdgcn_mfma_f32_32x32x16_bf16((a), (b), (c), 0, 0, 0)
#define MFMA16(a, b, c) __builtin_amdgcn_mfma_f32_16x16x32_bf16((a), (b), (c), 0, 0, 0)
constexpr int AT_KP = 208, AT_VP = 144;
constexpr int AT_KB = 64 * AT_KP, AT_VB = 64 * AT_VP;
DI bf16x8 pack_frag(const f32x16& x, int s) {
    u32x4 p; p.x = cvt_pk_bf16(x[8 * s], x[8 * s + 1]); p.y = cvt_pk_bf16(x[8 * s + 2], x[8 * s + 3]); p.z = cvt_pk_bf16(x[8 * s + 4], x[8 * s + 5]); p.w = cvt_pk_bf16(x[8 * s + 6], x[8 * s + 7]);
    return __builtin_bit_cast(bf16x8, p);
}
DI void attn_unit(LAS unsigned char* lds, const bf16_t* QH, const bf16_t* KN, const bf16_t* KR, const bf16_t* VB, bf16_t* MIX, int b, int h, int qb, float shift) {
    const int tid = opaque_tid(), wid = __builtin_amdgcn_readfirstlane(tid >> 6), lane = tid & 63, r32 = lane & 31, hi = lane >> 5;
    const int q0 = qb * 256, ntile = 4 * (qb + 1);
    const size_t rowb = (size_t)b * SEQ;
    LAS unsigned char* Kb = lds; LAS unsigned char* Vb = lds + 2 * AT_KB;
    bf16x8 qf[6];
    { const bf16_t* qp = QH + (rowb + q0 + wid * 32 + r32) * 768 + h * 96 + 8 * hi;
#pragma unroll
      for (int s = 0; s < 6; ++s) qf[s] = *(const bf16x8*)(qp + 16 * s); }
    f32x16 o0, o1;
#pragma unroll
    for (int i = 0; i < 16; ++i) { o0[i] = 0.f; o1[i] = 0.f; }
    float lsum = 0.f;
    const int skey = tid >> 3, sch = tid & 7;
    const int rkey = (tid & 255) >> 2, rch = tid & 3;
    struct Stg { u32x4 k, r, v; };
    Stg RA, RB;
    auto gload = [&](Stg& R, int kt) {
        const size_t row = rowb + (size_t)kt * 64;
        R.k = *(const u32x4*)(KN + (row + skey) * 512 + h * 64 + sch * 8);
        R.v = *(const u32x4*)(VB + (row + skey) * 512 + h * 64 + sch * 8);
        if (tid < 256) R.r = *(const u32x4*)(KR + (row + rkey) * 32 + rch * 8);
    };
    auto swrite = [&](const Stg& R, int buf) {
        *(LAS u32x4*)(Kb + buf * AT_KB + skey * AT_KP + sch * 16) = R.k;
        if (tid < 256) *(LAS u32x4*)(Kb + buf * AT_KB + rkey * AT_KP + 128 + rch * 16) = R.r;
        *(LAS u32x4*)(Vb + buf * AT_VB + skey * AT_VP + sch * 16) = R.v;
    };
    const int qrow = q0 + wid * 32 + r32;
    auto compute = [&](int buf, int kt) {
        const bool active = (64 * kt <= q0 + wid * 32 + 31);
        if (active) {
            const bool needmask = (64 * kt + 63 > q0 + wid * 32);
            const LAS unsigned char* kb = Kb + buf * AT_KB + r32 * AT_KP + 16 * hi;
            const LAS unsigned char* vb = Vb + buf * AT_VB + (4 * hi + ((lane & 15) >> 2)) * AT_VP + (16 * ((lane >> 4) & 1) + 4 * (lane & 3)) * 2;
            bf16x8 kf[12];
#pragma unroll
            for (int s = 0; s < 6; ++s) { kf[2 * s] = *(const LAS bf16x8*)(kb + 32 * s); kf[2 * s + 1] = *(const LAS bf16x8*)(kb + 32 * AT_KP + 32 * s); }
            __builtin_amdgcn_sched_barrier(0);
            f32x16 s0, s1;
#pragma unroll
            for (int i = 0; i < 16; ++i) { s0[i] = -shift; s1[i] = -shift; }
#pragma unroll
            for (int s = 0; s < 6; ++s) { s0 = MFMA32(kf[2 * s], qf[s], s0); s1 = MFMA32(kf[2 * s + 1], qf[s], s1); }
            s16x4 va[4][2], vc[4][2];
#pragma unroll
            for (int f = 0; f < 4; ++f) { const int ko = (32 * (f >> 1) + 16 * (f & 1)) * AT_VP;
                va[f][0] = __builtin_amdgcn_ds_read_tr16_b64_v4i16((LAS v4i16_t*)(vb + ko)); va[f][1] = __builtin_amdgcn_ds_read_tr16_b64_v4i16((LAS v4i16_t*)(vb + ko + 8 * AT_VP));
                vc[f][0] = __builtin_amdgcn_ds_read_tr16_b64_v4i16((LAS v4i16_t*)(vb + ko + 64)); vc[f][1] = __builtin_amdgcn_ds_read_tr16_b64_v4i16((LAS v4i16_t*)(vb + ko + 8 * AT_VP + 64)); }
            __builtin_amdgcn_sched_barrier(0);
#pragma unroll
            for (int i = 0; i < 16; ++i) { s0[i] = fast_exp2(s0[i]); s1[i] = fast_exp2(s1[i]); }
            if (needmask) {
                const int kbase = 64 * kt;
#pragma unroll
                for (int i = 0; i < 16; ++i) { const int kg = kbase + crow(i, hi); if (kg > qrow) s0[i] = 0.f; if (kg + 32 > qrow) s1[i] = 0.f; }
            }
            bf16x8 pf[2][2];
#pragma unroll
            for (int s2 = 0; s2 < 2; ++s2) { pf[0][s2] = pack_frag(s0, s2); pf[1][s2] = pack_frag(s1, s2); }
            { f32x16 t = s0 + s1; lsum += (((t[0] + t[1]) + (t[2] + t[3])) + ((t[4] + t[5]) + (t[6] + t[7]))) + (((t[8] + t[9]) + (t[10] + t[11])) + ((t[12] + t[13]) + (t[14] + t[15]))); }
            __builtin_amdgcn_sched_barrier(0);
#pragma unroll
            for (int f = 0; f < 4; ++f) {
                const bf16x8 v0 = __builtin_shufflevector(va[f][0], va[f][1], 0, 1, 2, 3, 4, 5, 6, 7), v1 = __builtin_shufflevector(vc[f][0], vc[f][1], 0, 1, 2, 3, 4, 5, 6, 7);
                o0 = MFMA32(v0, pf[f >> 1][f & 1], o0); o1 = MFMA32(v1, pf[f >> 1][f & 1], o1);
            }
        }
    };
    gload(RA, 0); gload(RB, 1); swrite(RA, 0); lds_barrier();
    for (int kt = 0; kt < ntile; kt += 2) {
        if (kt + 2 < ntile) gload(RA, kt + 2);
        compute(0, kt);
        swrite(RB, 1);
        lds_barrier();
        if (kt + 3 < ntile) gload(RB, kt + 3);
        compute(1, kt + 1);
        if (kt + 2 < ntile) swrite(RA, 0);
        lds_barrier();
    }
    lsum += __shfl_xor(lsum, 32);
    const float li = 1.0f / lsum;
    bf16_t* op = MIX + (rowb + qrow) * 1024 + 512 + h * 64 + 8 * hi;
    auto store_pair = [&](const f32x16& o, int g, bf16_t* p) {
        u32x2 a = pack4((f32x4){o[4 * g] * li, o[4 * g + 1] * li, o[4 * g + 2] * li, o[4 * g + 3] * li}), c = pack4((f32x4){o[4 * g + 4] * li, o[4 * g + 5] * li, o[4 * g + 6] * li, o[4 * g + 7] * li});
        { const auto r = __builtin_amdgcn_permlane32_swap(a.x, c.x, false, false); a.x = r[0]; c.x = r[1]; }
        { const auto r = __builtin_amdgcn_permlane32_swap(a.y, c.y, false, false); a.y = r[0]; c.y = r[1]; }
        *(u32x4*)(p + 8 * g) = (u32x4){a.x, a.y, c.x, c.y}; };
    store_pair(o0, 0, op); store_pair(o0, 2, op); store_pair(o1, 0, op + 32); store_pair(o1, 2, op + 32);
}

DI void conv_tile(LAS unsigned char* lds, const bf16_t* AB, bf16_t* MIX, const float* cw, const float* cb, const float* lng, const float* lnb, int tile) {
    const int tid = opaque_tid(), wid = tid >> 6, lane = tid & 63;
    const int b = tile >> 7, t0 = (tile & 127) * 32; const size_t rowb = (size_t)b * SEQ;
#pragma unroll
    for (int i = 0; i < 8; ++i) { const int idx = tid + 512 * i;
        if (idx < 62 * 64) { const int r = idx >> 6, ch = idx & 63, tok = t0 - 30 + r; u32x4 v = (u32x4){0u, 0u, 0u, 0u};
            if (tok >= 0) v = *(const u32x4*)(AB + (rowb + tok) * CONV_DIM + ch * 8);
            *(LAS u32x4*)(lds + r * 1024 + ch * 16) = v; } }
    float w[CONV_W];
#pragma unroll
    for (int j = 0; j < CONV_W; ++j) w[j] = cw[j * CONV_DIM + tid];
    const float bias = cb[tid];
    __syncthreads();
    f32x2 xp[31], we[15], wo[15];
#pragma unroll
    for (int r = 0; r < 31; ++r) { xp[r].x = __uint_as_float(((unsigned)*(const LAS unsigned short*)(lds + (2 * r) * 1024 + tid * 2)) << 16); xp[r].y = __uint_as_float(((unsigned)*(const LAS unsigned short*)(lds + (2 * r + 1) * 1024 + tid * 2)) << 16); }
#pragma unroll
    for (int k = 0; k < 15; ++k) { we[k] = (f32x2){w[2 * k], w[2 * k + 1]}; wo[k] = (f32x2){w[2 * k + 1], w[2 * k + 2]}; }
    LAS float* yb = (LAS float*)(lds + 65536);
#pragma unroll
    for (int s = 0; s < 16; ++s) {
        f32x2 ae = (f32x2){bias, 0.f}, ao = (f32x2){bias, 0.f};
#pragma unroll
        for (int k = 0; k < 15; ++k) { ae = __builtin_elementwise_fma(we[k], xp[s + k], ae); ao = __builtin_elementwise_fma(wo[k], xp[s + 1 + k], ao); }
        yb[(2 * s) * CONV_DIM + tid] = (ae.x + ae.y) + w[30] * xp[s + 15].x;
        yb[(2 * s + 1) * CONV_DIM + tid] = (ao.x + ao.y) + w[0] * xp[s].y; }
    __syncthreads();
#pragma unroll
    for (int rr = 0; rr < 4; ++rr) { const int t = wid * 4 + rr;
        const f32x4 a = *(const LAS f32x4*)(yb + t * CONV_DIM + 8 * lane), c = *(const LAS f32x4*)(yb + t * CONV_DIM + 8 * lane + 4);
        const float mean = wave_sum(sum4(a) + sum4(c)) * (1.0f / CONV_DIM);
        const f32x4 da = a - mean, dc = c - mean;
        const float rs = fast_rsq(wave_sum(dot4(da) + dot4(dc)) * (1.0f / CONV_DIM) + EPS);
        const f32x4 ya = da * rs * *(const f32x4*)(lng + 8 * lane) + *(const f32x4*)(lnb + 8 * lane), yc = dc * rs * *(const f32x4*)(lng + 8 * lane + 4) + *(const f32x4*)(lnb + 8 * lane + 4);
        *(u32x4*)(MIX + (rowb + t0 + t) * 1024 + 8 * lane) = pack8(silu4(ya), silu4(yc)); }
    __syncthreads();
}

constexpr int RC = 64;
constexpr int R_SLOT = 32768, R_KO = 16384, R_V = 65536, R_VSZ = 16384, R_P = 98304, R_PP = 144, R_TAB = R_P + RC * R_PP;
static_assert(R_TAB + 4096 <= RING_BYTES, "retention LDS");
DI int r_f(int r) { return ((r & 3) << 1) | (r & 8) | ((r >> 2) & 1); }
DI bf16x8 tr_pair(unsigned a, unsigned a2, int off) {
    u32x2 x, y;
    asm volatile("ds_read_b64_tr_b16 %0, %1 offset:%2" : "=v"(x) : "v"(a), "i"(off) : "memory");
    asm volatile("ds_read_b64_tr_b16 %0, %1 offset:%2" : "=v"(y) : "v"(a2), "i"(off) : "memory");
    u32x4 w; w.x = x.x; w.y = x.y; w.z = y.x; w.w = y.y; return __builtin_bit_cast(bf16x8, w);
}
DI bf16x8 r64_pair(unsigned a, unsigned a2, int off) {
    u32x2 x, y;
    asm volatile("ds_read_b64 %0, %1 offset:%2" : "=v"(x) : "v"(a), "i"(off) : "memory");
    asm volatile("ds_read_b64 %0, %1 offset:%2" : "=v"(y) : "v"(a2), "i"(off) : "memory");
    u32x4 w; w.x = x.x; w.y = x.y; w.z = y.x; w.w = y.y; return __builtin_bit_cast(bf16x8, w);
}
#define R_LGKM2(a, b) asm volatile("s_waitcnt lgkmcnt(0)" : "+v"(a), "+v"(b) :: "memory")
#define R_LGKM8(a, b, c, d, e, f, g_, h_) asm volatile("s_waitcnt lgkmcnt(0)" : "+v"(a), "+v"(b), "+v"(c), "+v"(d), "+v"(e), "+v"(f), "+v"(g_), "+v"(h_) :: "memory")
#define R_LGKM9(a, b, c, d, e, f, g_, h_, i_) asm volatile("s_waitcnt lgkmcnt(0)" : "+v"(a), "+v"(b), "+v"(c), "+v"(d), "+v"(e), "+v"(f), "+v"(g_), "+v"(h_), "+v"(i_) :: "memory")
#define R_WAITV() asm volatile("s_waitcnt vmcnt(0)" ::: "memory")
#define R_PIN(x) asm volatile("" : "+v"(x))
DI void retention_unit(LAS unsigned char* lds, const bf16_t* Q, const bf16_t* Kk, bf16_t* V, float* gns, int b, int h, int vs) {
    const int tid0 = opaque_tid(), wid = __builtin_amdgcn_readfirstlane(tid0 >> 6);
    const float l2g = __builtin_log2f(1.0f - fast_exp2(-5.0f - (float)h));
    const float gC = fast_exp2((float)RC * l2g);
    const size_t rowb = (size_t)b * SEQ;
    const bf16_t* Qh = Q + rowb * 1024 + h * 256; const bf16_t* Kh = Kk + rowb * 1024 + h * 256; bf16_t* Vh = V + rowb * ODD_MIX + h * 512 + vs * 128;
    float* gnh = gns + rowb * 32 + h * 8 + vs * 2;
    const int ib_a = wid & 3, jb_a = 2 * (wid >> 2);
    LAS float* tab = (LAS float*)(lds + R_TAB);
    unsigned aT[8], aT2[8], aV, aV2, aQ[4], aP[4][2];
    { const int lane = tid0 & 63, i16 = lane & 15, g = lane >> 4, fi = r_f(i16);
      const unsigned lb = (unsigned)(uintptr_t)lds;
      const int xq = (g ^ fi) << 4;
      const int xp = (((g >> 1) ^ fi) << 4) | ((g & 1) << 3);
      const int xt = ((((i16 >> 1) & 1) ^ ((i16 >> 2) << 1) ^ ((g & 1) << 3)) << 4) | ((i16 & 1) << 3);
      const int rowtr = (8 * g + (i16 >> 2)) * 256;
#pragma unroll
      for (int t = 0; t < 8; ++t) { aT[t] = lb + rowtr + (xt ^ (32 * t)); aT2[t] = lb + rowtr + 1024 + ((xt ^ (32 * t)) ^ 16); R_PIN(aT[t]); R_PIN(aT2[t]); }
      aV = lb + R_V + rowtr + (xt ^ (32 * wid)); aV2 = lb + R_V + rowtr + 1024 + ((xt ^ (32 * wid)) ^ 16); R_PIN(aV); R_PIN(aV2);
#pragma unroll
      for (int s = 0; s < 4; ++s) { aQ[s] = lb + i16 * 256 + (xq ^ (64 * s)); R_PIN(aQ[s]); aP[s][0] = lb + i16 * 256 + (xp ^ (64 * s)); aP[s][1] = lb + i16 * 256 + (xp ^ (64 * s + 32)); R_PIN(aP[s][0]); R_PIN(aP[s][1]); }
    }
    f32x4 st[16];
#pragma unroll
    for (int t = 0; t < 16; ++t) st[t] = (f32x4){0.f, 0.f, 0.f, 0.f};
    for (int c = 0; c < SEQ / RC; ++c) {
    int tid = tid0; asm volatile("" : "+v"(tid));
    const int lane = tid & 63, i16 = lane & 15, g = lane >> 4;
    auto dma_img = [&](int ldsoff, const bf16_t* src, int pitch) {
#pragma unroll
        for (int i = 0; i < 2; ++i) { const int q = wid + 8 * i, row = 4 * q + g, ch = i16 ^ r_f(row & 15);
            __builtin_amdgcn_global_load_lds((const unsigned*)(src + (size_t)row * pitch + ch * 8), (LAS unsigned*)(lds + ldsoff + q * 1024), 16, 0, 0); }
    };
    auto dma_qk = [&](int slot, int chunk, int half) { dma_img(slot * R_SLOT, Qh + (size_t)chunk * RC * 1024 + half * 128, 1024); dma_img(slot * R_SLOT + R_KO, Kh + (size_t)chunk * RC * 1024 + half * 128, 1024); };
    auto dma_v = [&](int chunk) { dma_img(R_V + (chunk & 1) * R_VSZ, Vh + (size_t)chunk * RC * ODD_MIX, ODD_MIX); };
    auto tab_reduce = [&](int chunk) {
        if (tid < RC) { float s1 = 0.f, s2 = 0.f;
#pragma unroll
            for (int w = 0; w < 8; ++w) { const f32x2 v = *(const LAS f32x2*)(tab + (tid * 8 + w) * 2); s1 += v.x; s2 += v.y; }
            *(f32x2*)(gnh + (size_t)(chunk * RC + tid) * 32) = (f32x2){s1, s2}; }
    };
    if (c == 0) { dma_qk(0, 0, 0); dma_v(0); }
    if (c == 0) R_WAITV(); else asm volatile("s_waitcnt vmcnt(4)" ::: "memory");
    lds_barrier();
    if (c > 0) tab_reduce(c - 1);
    dma_qk(1, c, 1);
    {
        const unsigned vo = (unsigned)((c & 1) * R_VSZ), aVc = aV + vo, aVc2 = aV2 + vo;
        f32x4 sacc[2], oacc[4];
#pragma unroll
        for (int j = 0; j < 2; ++j) sacc[j] = (f32x4){0.f, 0.f, 0.f, 0.f};
#pragma unroll
        for (int j = 0; j < 4; ++j) oacc[j] = (f32x4){0.f, 0.f, 0.f, 0.f};
#pragma unroll
        for (int half = 0; half < 2; ++half) {
            if (half == 1) {
                R_WAITV(); lds_barrier();
                if (c + 1 < SEQ / RC) { dma_qk(0, c + 1, 0); dma_v(c + 1); }
            }
            const int qo = half * R_SLOT, ko = qo + R_KO;
            if (jb_a <= ib_a) { __builtin_amdgcn_sched_barrier(0);
                bf16x8 qn[4], k0[4], k1[4];
#pragma unroll
                for (int s = 0; s < 4; ++s) { qn[s] = *(const LAS bf16x8*)(uintptr_t)(aQ[s] + qo + 16 * ib_a * 256); k0[s] = *(const LAS bf16x8*)(uintptr_t)(aQ[s] + ko + 16 * jb_a * 256);
                    if (jb_a + 1 <= ib_a) k1[s] = *(const LAS bf16x8*)(uintptr_t)(aQ[s] + ko + (16 * jb_a + 16) * 256); }
                __builtin_amdgcn_sched_barrier(0);
#pragma unroll
                for (int s = 0; s < 4; ++s) { sacc[0] = MFMA16(k0[s], qn[s], sacc[0]); if (jb_a + 1 <= ib_a) sacc[1] = MFMA16(k1[s], qn[s], sacc[1]); }
            }
#pragma unroll
            for (int u0 = 0; u0 < 4; u0 += 2) { __builtin_amdgcn_sched_barrier(0);
                bf16x8 qf[2][4];
#pragma unroll
                for (int uu = 0; uu < 2; ++uu)
#pragma unroll
                    for (int i = 0; i < 4; ++i) qf[uu][i] = r64_pair(aP[u0 + uu][0], aP[u0 + uu][1], qo + 16 * i * 256);
                R_LGKM8(qf[0][0], qf[0][1], qf[0][2], qf[0][3], qf[1][0], qf[1][1], qf[1][2], qf[1][3]);
                __builtin_amdgcn_sched_barrier(0);
#pragma unroll
                for (int uu = 0; uu < 2; ++uu) { const int u = u0 + uu;
                    const f32x4 x0 = st[8 * half + 2 * u], x1 = st[8 * half + 2 * u + 1];
                    u32x4 pw; pw.x = cvt_pk_bf16(x0.x, x0.y); pw.y = cvt_pk_bf16(x0.z, x0.w); pw.z = cvt_pk_bf16(x1.x, x1.y); pw.w = cvt_pk_bf16(x1.z, x1.w);
                    const bf16x8 sf = __builtin_bit_cast(bf16x8, pw);
#pragma unroll
                    for (int i = 0; i < 4; ++i) oacc[i] = MFMA16(sf, qf[uu][i], oacc[i]); }
            }
#pragma unroll
            for (int s = 0; s < 2; ++s) { __builtin_amdgcn_sched_barrier(0);
                bf16x8 vf = tr_pair(aVc, aVc2, s * 8192);
                bf16x8 kt[8];
#pragma unroll
                for (int t = 0; t < 8; ++t) kt[t] = tr_pair(aT[t], aT2[t], ko + s * 8192);
                R_LGKM9(vf, kt[0], kt[1], kt[2], kt[3], kt[4], kt[5], kt[6], kt[7]);
                __builtin_amdgcn_sched_barrier(0);
#pragma unroll
                for (int t = 0; t < 8; ++t) st[8 * half + t] = MFMA16(kt[t], vf, st[8 * half + t]); }
            __builtin_amdgcn_sched_barrier(0);
#pragma unroll
            for (int t = 0; t < 8; ++t) st[8 * half + t] = st[8 * half + t] * gC;
        }
#pragma unroll
        for (int jj = 0; jj < 2; ++jj) { const int jb = jb_a + jj;
            f32x4 p = sacc[jj];
            if (jb > ib_a) p = (f32x4){0.f, 0.f, 0.f, 0.f};
            else if (jb == ib_a) {
#pragma unroll
                for (int e = 0; e < 4; ++e) if (4 * g + e > i16) p[e] = 0.f; }
            *(LAS u32x2*)(lds + R_P + (16 * ib_a + i16) * R_PP + (16 * jb + 4 * g) * 2) = pack4(p);
        }
        lds_barrier();
        {
            __builtin_amdgcn_sched_barrier(0);
            bf16x8 v0 = tr_pair(aVc, aVc2, 0), v1 = tr_pair(aVc, aVc2, 8192);
            bf16x8 p0[4], p1[2];
#pragma unroll
            for (int i = 0; i < 4; ++i) p0[i] = *(const LAS bf16x8*)(lds + R_P + (16 * i + i16) * R_PP + 16 * g);
#pragma unroll
            for (int i = 0; i < 2; ++i) p1[i] = *(const LAS bf16x8*)(lds + R_P + (16 * (i + 2) + i16) * R_PP + 64 + 16 * g);
            R_LGKM2(v0, v1);
            __builtin_amdgcn_sched_barrier(0);
#pragma unroll
            for (int i = 0; i < 4; ++i) oacc[i] = MFMA16(v0, p0[i], oacc[i]);
#pragma unroll
            for (int i = 0; i < 2; ++i) oacc[i + 2] = MFMA16(v1, p1[i], oacc[i + 2]);
        }
#pragma unroll
        for (int ib = 0; ib < 4; ++ib) {
            __builtin_amdgcn_sched_barrier(0);
            const f32x4 o = oacc[ib] * fast_exp2((float)(16 * ib + i16 + 1) * l2g);
            *(u32x2*)(Vh + (size_t)(c * RC + 16 * ib + i16) * ODD_MIX + 16 * wid + 4 * g) = pack4(o);
            const float s1 = red_fq(sum4(o)), s2 = red_fq(dot4(o));
            if (g == 0) *(LAS f32x2*)(tab + ((16 * ib + i16) * 8 + wid) * 2) = (f32x2){s1, s2};
        }
    }
    }
    lds_barrier();
    { int tid = tid0; asm volatile("" : "+v"(tid));
      if (tid < RC) { float s1 = 0.f, s2 = 0.f;
#pragma unroll
          for (int w = 0; w < 8; ++w) { const f32x2 v = *(const LAS f32x2*)(tab + (tid * 8 + w) * 2); s1 += v.x; s2 += v.y; }
          *(f32x2*)(gnh + (size_t)((SEQ / RC - 1) * RC + tid) * 32) = (f32x2){s1, s2}; } }
    lds_barrier();
}

enum { MAP_ID = 0, MAP_GU = 1, MAP_E1 = 2, MAP_S2Q = 3, MAP_S2KV = 4 };
template <int MAP> DI int map_src(int n, int& sel) {
    sel = 0;
    if (MAP == MAP_ID) return n;
    const int t = n >> 8, r = n & 255, bj = r >> 7, wc = (r & 127) >> 5, p = r & 31, fq = p >> 3, nn = (p >> 2) & 1, j = p & 3;
    const int rl = 16 * nn + 4 * fq + j;
    if (MAP == MAP_GU) { sel = bj; return t * 128 + (r & 127); }
    if (MAP == MAP_E1) {
        if (t < 4) return (bj ? CONV_DIM : 0) + t * 128 + (r & 127);
        if (t == 4) return 2 * CONV_DIM + r;
        if (r < 128) return 2 * CONV_DIM + QLORA + r;
        if (r < 160) return 2 * CONV_DIM + QLORA + KVLORA + rl;
        return -1;
    }
    const int ws = t * 4 + wc;
    if (MAP == MAP_S2Q) { if (ws < 8) return ws * 96 + 32 * bj + p; return (2 * (ws - 8) + bj) * 96 + 64 + rl; }
      if (ws < 8) return ws * 128 + 32 * bj + p; return (ws - 8) * 128 + 64 + 32 * bj + p;
}
template <int MAP> DI void cvt_matrix(const float* W0, const float* W1, int ldw, int krows, int koff, bf16_t* dst, int ldd, int nrows, const float* gain, float scale, int gw, int NGW, int lane, int& rot) {
    const int nkb = ldd >> 6, nitems = (nrows >> 6) * nkb;
    int first = (gw - rot % NGW + NGW) % NGW; rot += nitems;
    for (int it = first; it < nitems; it += NGW) {
        const int nb = it / nkb, kb = it - nb * nkb, n = nb * 64 + lane; int sel; const int src = map_src<MAP>(n, sel);
        const float* W = sel ? W1 : W0; bf16_t* drow = dst + (size_t)n * ldd + kb * 64;
        float v[64];
#pragma unroll
        for (int i = 0; i < 64; ++i) { const int k = kb * 64 + i - koff; const bool ok = (src >= 0) && (k >= 0) && (k < krows); const int kk = ok ? k : 0;
            const float wv = W[(size_t)kk * ldw + (src >= 0 ? src : 0)]; const float gv = gain ? gain[kk] : 1.0f; v[i] = ok ? wv * gv * scale : 0.f; }
#pragma unroll
        for (int kc = 0; kc < 8; ++kc) { u32x4 o; o.x = cvt_pk_bf16(v[8 * kc], v[8 * kc + 1]); o.y = cvt_pk_bf16(v[8 * kc + 2], v[8 * kc + 3]); o.z = cvt_pk_bf16(v[8 * kc + 4], v[8 * kc + 5]); o.w = cvt_pk_bf16(v[8 * kc + 6], v[8 * kc + 7]);
            *(u32x4*)(drow + kc * 8) = o; }
    }
}

struct Args { const float* in[38]; float* out; unsigned char* ws; };
struct Frame {
    LAS unsigned char* lds; int tid, lane, wave, vcu, G;
    int c, x, j, local; mutable int dir;
};

DI void p0_prologue(const Args& a, const Frame& F) {
    unsigned char* ws = a.ws;
    const int gw = F.vcu * 8 + F.wave, NGW = F.G * 8, lane = F.lane; int rot = 0;
    const size_t DD = (size_t)D * D, DF = (size_t)D * DFF;
    for (int l = 0; l < DEPTH; ++l) {
        bf16_t* wl = (bf16_t*)(ws + WS_W + l * W_LAYER);
        cvt_matrix<MAP_GU>(a.in[4] + l * DF, a.in[5] + l * DF, DFF, D, 0, (bf16_t*)((char*)wl + WO_GU1), D, 2 * DFF, a.in[3] + l * D, 1.0f, gw, NGW, lane, rot);
        cvt_matrix<MAP_ID>(a.in[6] + l * DF, nullptr, D, DFF, 0, (bf16_t*)((char*)wl + WO_D1), DFF, D, nullptr, 0.5f, gw, NGW, lane, rot);
        cvt_matrix<MAP_GU>(a.in[8] + l * DF, a.in[9] + l * DF, DFF, D, 0, (bf16_t*)((char*)wl + WO_GU2), D, 2 * DFF, a.in[7] + l * D, 1.0f, gw, NGW, lane, rot);
        cvt_matrix<MAP_ID>(a.in[10] + l * DF, nullptr, D, DFF, 0, (bf16_t*)((char*)wl + WO_D2), DFF, D, nullptr, 0.5f, gw, NGW, lane, rot);
        cvt_matrix<MAP_ID>(a.in[14] + l * DD, nullptr, D, D, 0, (bf16_t*)((char*)wl + WO_Q), D, D, a.in[12] + l * D, 1.0f, gw, NGW, lane, rot);
        cvt_matrix<MAP_ID>(a.in[17] + l * DD, nullptr, D, D, 0, (bf16_t*)((char*)wl + WO_O), D, D, nullptr, 1.0f, gw, NGW, lane, rot);
        cvt_matrix<MAP_ID>(a.in[15] + l * DD, nullptr, D, D, 0, (bf16_t*)(ws + WS_ACT + A_WK) + l * DD, D, D, a.in[13] + l * D, 1.0f, gw, NGW, lane, rot);
        cvt_matrix<MAP_ID>(a.in[16] + l * DD, nullptr, D, D, 0, (bf16_t*)(ws + WS_ACT + A_WV) + l * DD, D, D, a.in[13] + l * D, 1.0f, gw, NGW, lane, rot);
    }
    for (int e = 0; e < 2; ++e) {
        char* we = (char*)(ws + WS_WE + e * W_EVEN);
        cvt_matrix<MAP_E1>(a.in[20] + (size_t)e * D * EVEN_IN, nullptr, EVEN_IN, D, 0, (bf16_t*)(we + WE_IN), D, EVEN_INP, a.in[11] + (2 * e) * D, 1.0f, gw, NGW, lane, rot);
        cvt_matrix<MAP_S2Q>(a.in[26] + (size_t)e * QLORA * 768, nullptr, 768, QLORA, 0, (bf16_t*)(we + WE_S2), S2K, 768, a.in[25] + e * QLORA, 1.0f, gw, NGW, lane, rot);
        cvt_matrix<MAP_S2KV>(a.in[28] + (size_t)e * KVLORA * 1024, nullptr, 1024, KVLORA, QLORA, (bf16_t*)(we + WE_S2) + (size_t)768 * S2K, S2K, 1024, a.in[27] + e * KVLORA, 1.0f, gw, NGW, lane, rot);
        cvt_matrix<MAP_ID>(a.in[33] + (size_t)e * DD, nullptr, D, D, 0, (bf16_t*)(we + WE_OUT), D, D, nullptr, 1.0f, gw, NGW, lane, rot);
    }
    for (int o = 0; o < 2; ++o) {
        char* wo = (char*)(ws + WS_WO + o * W_ODD);
        cvt_matrix<MAP_ID>(a.in[34] + (size_t)o * D * ODD_IN, nullptr, ODD_IN, D, 0, (bf16_t*)(wo + WOD_IN), D, ODD_IN, a.in[11] + (2 * o + 1) * D, 1.0f, gw, NGW, lane, rot);
        cvt_matrix<MAP_ID>(a.in[37] + (size_t)o * ODD_MIX * D, nullptr, D, ODD_MIX, 0, (bf16_t*)(wo + WOD_OUT), ODD_MIX, D, nullptr, 1.0f, gw, NGW, lane, rot);
    }
    { const float* x = a.in[0]; bf16_t* xb = (bf16_t*)(ws + WS_XB); float* ssq = (float*)(ws + WS_SSQ);
      for (int m0 = gw * 4; m0 < M; m0 += NGW * 4) { f32x4 v[4][4];
#pragma unroll
          for (int r = 0; r < 4; ++r)
#pragma unroll
              for (int j = 0; j < 4; ++j) v[r][j] = ((const f32x4*)(x + (size_t)(m0 + r) * D) + lane)[64 * j];
#pragma unroll
          for (int r = 0; r < 4; ++r) { float s = 0.f;
#pragma unroll
              for (int j = 0; j < 4; ++j) { s += dot4(v[r][j]); *(u32x2*)(xb + (size_t)(m0 + r) * D + 256 * j + 4 * lane) = pack4(v[r][j]); }
              s = wave_sum(s); if (lane < 16) ssq[(size_t)(m0 + r) * 16 + lane] = lane == 0 ? s : 0.f; } } }
    { const float* x = a.in[1]; bf16_t* xb = (bf16_t*)(ws + WS_MEMB); float* rm = (float*)(ws + WS_RMEM);
      for (int m = gw; m < MM; m += NGW) { const f32x4* xr = (const f32x4*)(x + (size_t)m * D) + lane; float s = 0.f;
#pragma unroll
          for (int j = 0; j < 4; ++j) { const f32x4 v = xr[64 * j]; s += dot4(v); *(u32x2*)(xb + (size_t)m * D + 256 * j + 4 * lane) = pack4(v); }
          s = wave_sum(s); if (lane == 0) rm[m] = 1.0f / sqrtf(s * (1.0f / D) + EPS); } }
    if (gw == 0 && lane < 2) { const int e = lane; float mqn = 0.f, mkn = 0.f, mqr = 0.f, mkr = 0.f;
        for (int i = 0; i < QK_NOPE; ++i) { mqn = fmaxf(mqn, fabsf(a.in[29][e * QK_NOPE + i])); mkn = fmaxf(mkn, fabsf(a.in[30][e * QK_NOPE + i])); }
        for (int i = 0; i < QK_ROPE; ++i) { mqr = fmaxf(mqr, fabsf(a.in[31][e * QK_ROPE + i])); mkr = fmaxf(mkr, fabsf(a.in[32][e * QK_ROPE + i])); }
        const float bq = sqrtf(64.f * mqn * mqn + 32.f * mqr * mqr), bk = sqrtf(64.f * mkn * mkn + 32.f * mkr * mkr);
        ((float*)(ws + WS_CTL))[CW_SHE + e] = bq * bk * (LOG2E / sqrtf(96.0f)); }
}
DI void p2_finalize(const Args& a, const Frame& F) {
    unsigned char* ws = a.ws; bf16_t* kp = (bf16_t*)(ws + WS_KP); const float* kss = (const float*)(ws + WS_KSS); unsigned* kmax = (unsigned*)(ws + WS_CTL) + CW_KMAX;
    const int gw = F.vcu * 8 + F.wave, NGW = F.G * 8, lane = F.lane;
    for (int it = gw; it < DEPTH * MM * XH; it += NGW) { const int hh = it & 3, row = it >> 2;
        const float rk = rstd4(kss + (size_t)row * 16 + hh * 4, 1.0f / XHD);
        u32x2* p = (u32x2*)(kp + (size_t)row * D + hh * 256 + 4 * lane); const u32x2 w = *p;
        const u32x2 o = (u32x2){cvt_pk_bf16(bf_lo(w.x) * rk, bf_hi(w.x) * rk), cvt_pk_bf16(bf_lo(w.y) * rk, bf_hi(w.y) * rk)};
        *p = o;
        float s = bf_lo(o.x) * bf_lo(o.x) + bf_hi(o.x) * bf_hi(o.x) + bf_lo(o.y) * bf_lo(o.y) + bf_hi(o.y) * bf_hi(o.y);
        s = wave_sum(s);
        if (lane == 0) { const int l = row / MM, bb = (row % MM) / MEMLEN; __hip_atomic_fetch_max(kmax + l * 64 + bb * 4 + hh, __float_as_uint(sqrtf(s) * 1.0001f), __ATOMIC_RELAXED, __HIP_MEMORY_SCOPE_AGENT); } }
}

#define WSP(T, off) ((T*)(ws + (off)))
#define WS_LOCAL() GAS unsigned char* wsg_ = (GAS unsigned char*)ws_; asm volatile("" : "+s"(wsg_)); unsigned char* ws = (unsigned char*)wsg_
#ifndef SITE
#define SITE 0
#endif
#define SITE_ON(k) (SITE == 0 || SITE == (k))
using pg8::Cfg; using pg8::CfgStd; using pg8::CfgStdRev;
typedef CfgStd<M, 2 * DFF, D, D, D> CfgF1;
typedef CfgStd<M, D, DFF, DFF, DFF> CfgF2;
typedef CfgStd<M, D, D, D, D> CfgDD;
typedef CfgStd<M, EVEN_INP, D, D, D> CfgE1;
typedef CfgStd<M, S2N, S2K, S2K, S2K> CfgE2;
typedef CfgStd<M, 4096, D, D, D> CfgO1;
typedef CfgStd<M, ODD_MIX, D, D, D> CfgO3;
typedef CfgStd<M, D, ODD_MIX, ODD_MIX, ODD_MIX> CfgO4;
typedef Cfg<M / 256, XH, D, D, XHD, -1, 31, 256L * D, 0, 256, 4, 256L * D, 256> CfgXS;
typedef Cfg<NB * 4, XH, D, D, XHD, 3, 31, 256L * D, 0, 256, 2, 256L * D, 256> CfgVW;
typedef Cfg<M / 256, XH, D, D, D, -1, 31, 256L * D, 0, 0, 4, (long)D * D, 256L * D> CfgXF;
typedef Cfg<DEPTH * (MM / 256), XH, D, D, D, 15, 31, 256L * D, 0, 0, 4, (long)D * D, 256L * D> CfgMK;

constexpr size_t SLAB = 64 * MiB; constexpr int XROWS = M / 8;
#define ACTP(off, pitch) ((bf16_t*)(ws + WS_ACT + (size_t)F.x * SLAB + (off) / 8) - (size_t)F.x * XROWS * (pitch))
#define PBAR() do { if (__builtin_amdgcn_readfirstlane((int)bar.st[3])) xcd_local_barrier(bar); else xcd_barrier(bar); } while (0)

DI void ffn_block(const Args& a, const Frame& F, const XcdBarrier& bar, int l, int half, bool final) {
    unsigned char* ws_ = a.ws; const int c = F.c;
#define wgu ((const bf16_t*)(ws + WS_W + l * W_LAYER + (half ? WO_GU2 : WO_GU1)))
#define wd ((const bf16_t*)(ws + WS_W + l * W_LAYER + (half ? WO_D2 : WO_D1)))
    if (SITE_ON(1)) { WS_LOCAL(); pg8::Gemm g{WSP(const bf16_t, WS_XB), wgu};
      const int d = (F.dir ^= 1); constexpr bool tb = true;     auto hk = [&]() { row_tables(F.lds, WSP(const float, WS_SSQ), nullptr, F.x, F.j, d); };
      EpiSwiGLU E{ACTP(A_H, DFF), WSP(const float, WS_SSQ), tb ? (const LAS float*)(F.lds + RT_OFF) : nullptr}; pg8::gemm_phase<CfgF1>(F.lds, g, F.G, c, E, d, hk); }
    PBAR();
    if (SITE_ON(2)) { WS_LOCAL(); pg8::Gemm g{ACTP(A_H, DFF), wd};
      if (final) { EpiResid<true> E{WSP(bf16_t, WS_XB), WSP(float, WS_SSQ), a.out}; pg8::gemm_phase<CfgF2>(F.lds, g, F.G, c, E, (F.dir ^= 1)); }
      else { EpiResid<false> E{WSP(bf16_t, WS_XB), WSP(float, WS_SSQ), a.out}; pg8::gemm_phase<CfgF2>(F.lds, g, F.G, c, E, (F.dir ^= 1)); } }
    PBAR();
}
DI void even_block(const Args& a, const Frame& F, const XcdBarrier& bar, int l) {
    unsigned char* ws_ = a.ws; const int c = F.c, e = l >> 1;
#define pos ((const int*)INP(2))
#define we (ws + WS_WE + e * W_EVEN)
    if (SITE_ON(3)) { WS_LOCAL(); pg8::Gemm g{WSP(const bf16_t, WS_XB), (const bf16_t*)(we + WE_IN)};
      const int d = (F.dir ^= 1); constexpr bool tb = true;     auto hk = [&]() { row_tables(F.lds, WSP(const float, WS_SSQ), pos, F.x, F.j, d); };
      EpiEven1 E{ACTP(A_AB, CONV_DIM), ACTP(A_ZC, S2K), ACTP(A_KR, QK_ROPE), WSP(const float, WS_SSQ), WSP(float, WS_ZS), INP(32) + e * QK_ROPE, pos, tb ? (const LAS float*)(F.lds + RT_OFF) : nullptr, tb ? (const LAS float*)(F.lds + PT_OFF) : nullptr};
      pg8::gemm_phase<CfgE1>(F.lds, g, F.G, c, E, d, hk); }
    PBAR();
    if (SITE_ON(4)) { WS_LOCAL(); pg8::Gemm g{ACTP(A_ZC, S2K), (const bf16_t*)(we + WE_S2)};
      const int d = (F.dir ^= 1);
      auto hk = [&]() { stage2_tables(F.lds, WSP(const float, WS_ZS), pos, INP(29) + e * QK_NOPE, INP(30) + e * QK_NOPE, INP(31) + e * QK_ROPE, F.x, F.j, d); };
      EpiEven2 E{ACTP(A_QH, 768), ACTP(A_KN, 512), ACTP(A_VB, 512), (const LAS float*)(F.lds + RT_OFF), LOG2E * 0.10206207261596575f};
      pg8::gemm_phase<CfgE2>(F.lds, g, F.G, c, E, d, hk); }
    if (SITE_ON(5)) { WS_LOCAL(); for (int q = c; q < M / 32; q += F.G) { const int n = q >> 3;
        conv_tile(F.lds, ACTP(A_AB, CONV_DIM), ACTP(A_MIX, 1024), INP(21) + e * CONV_W * CONV_DIM, INP(22) + e * CONV_DIM, INP(23) + e * CONV_DIM, INP(24) + e * CONV_DIM, F.x * (M / 32 / 8) + n); } }
    PBAR();
    if (SITE_ON(6)) { WS_LOCAL(); const float shift = WSP(const float, WS_CTL)[CW_SHE + e];
      for (int q = c; q < NB * MLA_H * 8; q += F.G) { const int n = q >> 3, b = 2 * F.x + (n >> 6), h = (n >> 3) & 7, pr = n & 7;
          attn_unit(F.lds, ACTP(A_QH, 768), ACTP(A_KN, 512), ACTP(A_KR, QK_ROPE), ACTP(A_VB, 512), ACTP(A_MIX, 1024), b, h, pr, shift);
          attn_unit(F.lds, ACTP(A_QH, 768), ACTP(A_KN, 512), ACTP(A_KR, QK_ROPE), ACTP(A_VB, 512), ACTP(A_MIX, 1024), b, h, 15 - pr, shift); } }
    PBAR();
    if (SITE_ON(7)) { WS_LOCAL(); pg8::Gemm g{ACTP(A_MIX, 1024), (const bf16_t*)(we + WE_OUT)};
      EpiResid<false> E{WSP(bf16_t, WS_XB), WSP(float, WS_SSQ), a.out}; pg8::gemm_phase<CfgDD>(F.lds, g, F.G, c, E, (F.dir ^= 1)); }
    PBAR();
}
DI void odd_block(const Args& a, const Frame& F, const XcdBarrier& bar, int l) {
    unsigned char* ws_ = a.ws; const int c = F.c, o = l >> 1;
#define wo (ws + WS_WO + o * W_ODD)
    if (SITE_ON(8)) { WS_LOCAL(); pg8::Gemm g{WSP(const bf16_t, WS_XB), (const bf16_t*)(wo + WOD_IN)};
      const int d = (F.dir ^= 1); constexpr bool tb = true;     auto hk = [&]() { row_tables(F.lds, WSP(const float, WS_SSQ), pos, F.x, F.j, d); };
      EpiOdd1 E{ACTP(A_RQ, 1024), ACTP(A_RK, 1024), ACTP(A_RV, ODD_MIX), WSP(const float, WS_SSQ), pos, tb ? (const LAS float*)(F.lds + RT_OFF) : nullptr, tb ? (const LAS float*)(F.lds + PT_OFF) : nullptr}; pg8::gemm_phase<CfgO1>(F.lds, g, F.G, c, E, d, hk); }
    PBAR();
    if (SITE_ON(9)) { WS_LOCAL(); for (int q = c; q < NB * RET_H * 4; q += F.G) { const int n = q >> 3;
        retention_unit(F.lds, ACTP(A_RQ, 1024), ACTP(A_RK, 1024), ACTP(A_RV, ODD_MIX), WSP(float, WS_GNS), 2 * F.x + (n >> 4), (n >> 2) & 3, n & 3); } }
    PBAR();
    if (SITE_ON(10)) { WS_LOCAL(); pg8::Gemm g{WSP(const bf16_t, WS_XB), (const bf16_t*)(wo + WOD_IN) + (size_t)4096 * D};
      const int d = (F.dir ^= 1);
      auto hk = [&]() { { const int t = opaque_tid(); const int gcol = ((F.j >> 3) + 4 * (t >> 8)) * 256 + (t & 255); LAS float* gt = (LAS float*)(F.lds + PT_OFF);
                          gt[t] = (INP(35) + o * ODD_MIX)[gcol]; gt[512 + t] = (INP(36) + o * ODD_MIX)[gcol]; }
                        row_tables(F.lds, WSP(const float, WS_SSQ), nullptr, F.x, F.j, d); };
      EpiGate E{ACTP(A_RV, ODD_MIX), WSP(const float, WS_GNS), (const LAS float*)(F.lds + RT_OFF), (const LAS float*)(F.lds + PT_OFF)}; pg8::gemm_phase<CfgO3>(F.lds, g, F.G, c, E, d, hk); }
    PBAR();
    if (SITE_ON(11)) { WS_LOCAL(); pg8::Gemm g{ACTP(A_RV, ODD_MIX), (const bf16_t*)(wo + WOD_OUT)};
      EpiResid<false> E{WSP(bf16_t, WS_XB), WSP(float, WS_SSQ), a.out}; pg8::gemm_phase<CfgO4>(F.lds, g, F.G, c, E, (F.dir ^= 1)); }
    PBAR();
}
DI void xattn_block(const Args& a, const Frame& F, const XcdBarrier& bar, int l) {
    unsigned char* ws_ = a.ws; const int c = F.c;
#define wl (ws + WS_W + l * W_LAYER)
    if (SITE_ON(12)) { WS_LOCAL(); pg8::Gemm g{WSP(const bf16_t, WS_XB), (const bf16_t*)(wl + WO_Q)};
      const int d = (F.dir ^= 1); constexpr bool tb = true;     auto hk = [&]() { row_tables(F.lds, WSP(const float, WS_SSQ), nullptr, F.x, F.j, d); };
      EpiQraw E{ACTP(A_XQ, 1024), WSP(const float, WS_SSQ), WSP(float, WS_QSS), tb ? (const LAS float*)(F.lds + RT_OFF) : nullptr}; pg8::gemm_phase<CfgDD>(F.lds, g, F.G, c, E, d, hk); }
    if (SITE_ON(14)) { WS_LOCAL(); pg8::Gemm g{(const bf16_t*)(wl + WO_O), WSP(const bf16_t, WS_VT) + (size_t)l * MM * D};
      EpiVW E{WSP(bf16_t, WS_VW)}; pg8::gemm_phase<CfgVW>(F.lds, g, F.G, c, E, 0); }
    cu_local_seam();
    if (SITE_ON(13)) { WS_LOCAL(); pg8::Gemm g{ACTP(A_XQ, 1024), WSP(const bf16_t, WS_KP) + (size_t)l * MM * D};
      auto hk = [&]() { score_tables(F.lds, WSP(const float, WS_QSS), WSP(const unsigned, WS_CTL) + CW_KMAX + l * 64, F.x, F.j, F.dir); };
      EpiScoresN E{ACTP(A_XP, 1024), (const LAS float*)(F.lds + RT_OFF), (LAS float*)(F.lds + RING_BYTES)}; pg8::gemm_phase<CfgXS>(F.lds, g, F.G, c, E, F.dir, hk); }
    PBAR();
    if (SITE_ON(15)) { WS_LOCAL(); pg8::Gemm g{ACTP(A_XP, 1024), WSP(const bf16_t, WS_VW)};
      EpiResid<false> E{WSP(bf16_t, WS_XB), WSP(float, WS_SSQ), a.out}; pg8::gemm_phase<CfgXF>(F.lds, g, F.G, c, E, (F.dir ^= 1)); }
    PBAR();
}

__global__ void __launch_bounds__(512, 2) fwd_kernel(Args a) {
    extern __shared__ __attribute__((aligned(16))) unsigned char lds_raw[];
    Frame F; F.lds = (LAS unsigned char*)lds_raw; F.tid = threadIdx.x; F.lane = F.tid & 63; F.wave = __builtin_amdgcn_readfirstlane(F.tid >> 6);
    F.G = gridDim.x; { const int bx = blockIdx.x; F.vcu = (F.G % 8 == 0) ? (bx % 8) * (F.G / 8) + bx / 8 : bx; }
    F.c = blockIdx.x; F.x = 0; F.j = 0; F.local = 0; F.dir = 1;
    unsigned char* ws_ = a.ws; unsigned char* ws = ws_;
    if (F.tid < 64) ((LAS unsigned*)(F.lds + LDSCTL_OFF))[F.tid] = 0u;
    if (F.tid < 38) ((const float**)(ws + WS_CTL + CW_TAB * 4))[F.tid] = a.in[F.tid];
    __syncthreads();
    const XcdBarrier bar = xcd_barrier_post(WSP(unsigned, WS_CTL) + CW_BAR, (volatile LAS unsigned*)(F.lds + LDSCTL_OFF));
    if (SITE_ON(16)) p0_prologue(a, F);
    xcd_barrier(bar);
    if (SITE_ON(17)) { WS_LOCAL(); pg8::Gemm g{WSP(const bf16_t, WS_MEMB), WSP(const bf16_t, WS_ACT + A_WK)};
      EpiMemK E{WSP(bf16_t, WS_KP), WSP(const float, WS_RMEM), WSP(float, WS_KSS), INP(19), INP(18)}; pg8::gemm_phase<CfgMK>(F.lds, g, F.G, blockIdx.x, E); }
    if (SITE_ON(18)) { WS_LOCAL(); pg8::Gemm g{WSP(const bf16_t, WS_MEMB), WSP(const bf16_t, WS_ACT + A_WV)};
      EpiMemV E{WSP(bf16_t, WS_VT), WSP(const float, WS_RMEM)}; pg8::gemm_phase<CfgMK>(F.lds, g, F.G, blockIdx.x, E); }
    xcd_barrier(bar);
    if (SITE_ON(19)) p2_finalize(a, F);
    { volatile LAS unsigned* st = (volatile LAS unsigned*)(F.lds + LDSCTL_OFF);
      if (F.tid == 0) { unsigned ok = (F.G % 8 == 0) ? 1u : 0u; unsigned* bw = WSP(unsigned, WS_CTL) + CW_BAR;
#pragma unroll
          for (unsigned jx = 0; jx < 16; ++jx) { const unsigned cnt = xb_ld(&bw[XB_XCNT(jx)]); ok &= (jx < 8u) ? (cnt == (unsigned)F.G / 8u) : (cnt == 0u); }
          ok &= (xb_ld(&bw[XB_TMO]) == 0u) ? 1u : 0u;
          st[3] = ok; st[4] = 0u; }
      __syncthreads();
      if (st[3] != 0u) { F.local = 1; F.x = (int)bar.x; F.j = (int)st[2]; F.c = 8 * F.j + F.x; }
      else { F.local = 0; F.c = blockIdx.x; F.x = F.c & 7; F.j = F.c >> 3; }
      F.x = __builtin_amdgcn_readfirstlane(F.x); F.j = __builtin_amdgcn_readfirstlane(F.j); F.c = __builtin_amdgcn_readfirstlane(F.c); F.local = __builtin_amdgcn_readfirstlane(F.local); }
    xcd_barrier(bar);
    for (int l = 0; l < DEPTH; ++l) {
        ffn_block(a, F, bar, l, 0, false);
        if (l & 1) odd_block(a, F, bar, l); else even_block(a, F, bar, l);
        xattn_block(a, F, bar, l);
        ffn_block(a, F, bar, l, 1, l == DEPTH - 1);
    }
}

extern "C" void kernel_launch(void* const* d_in, const int* in_sizes, int n_in, void* d_out, int out_size, void* d_ws, size_t ws_size, hipStream_t stream) {
    static int grid = 0;
    if (grid == 0) {
        if (n_in != 38 || out_size != M * D || ws_size < WS_END) { fprintf(stderr, "kernel_launch: unexpected problem (n_in %d, out %d, ws %zu < %zu)\n", n_in, out_size, ws_size, (size_t)WS_END); grid = -1; return; }
        int dev = 0, cus = 0, per_cu = 0;
        if (hipGetDevice(&dev) != hipSuccess || hipDeviceGetAttribute(&cus, hipDeviceAttributeMultiprocessorCount, dev) != hipSuccess) { grid = -1; return; }
        if (cus != 256) { fprintf(stderr, "kernel_launch: this build needs 256 compute units (one workgroup each; the per-phase row tables assume it), found %d\n", cus); grid = -1; return; }
        if (hipFuncSetAttribute((const void*)fwd_kernel, hipFuncAttributeMaxDynamicSharedMemorySize, LDS_BYTES) != hipSuccess) { fprintf(stderr, "kernel_launch: hipFuncSetAttribute failed\n"); grid = -1; return; }
        if (hipOccupancyMaxActiveBlocksPerMultiprocessor(&per_cu, (const void*)fwd_kernel, 512, LDS_BYTES) != hipSuccess || per_cu < 1) fprintf(stderr, "kernel_launch: occupancy query reports %d blocks per CU\n", per_cu);
        (void)hipGetLastError();
        grid = cus;
    }
    if (grid < 0) return;
    if (hipMemsetAsync((char*)d_ws + WS_CTL, 0, CTL_ZERO_BYTES, stream) != hipSuccess) return;
    Args a{};
    for (int i = 0; i < 38; ++i) a.in[i] = (const float*)d_in[i];
    a.out = (float*)d_out; a.ws = (unsigned char*)d_ws;
    hipLaunchKernelGGL(fwd_kernel, dim3(grid), dim3(512), LDS_BYTES, stream, a);
}
```

```cpp
#include <hip/hip_runtime.h>
#include <cstdio>
#include <cstdint>

#define LAS __attribute__((address_space(3)))
#define GAS __attribute__((address_space(1)))
typedef unsigned short bf16_t;
typedef short bf16x8 __attribute__((ext_vector_type(8)));
typedef short s16x4 __attribute__((ext_vector_type(4)));
typedef float f32x4 __attribute__((ext_vector_type(4)));
typedef float f32x2 __attribute__((ext_vector_type(2)));
typedef float f32x16 __attribute__((ext_vector_type(16)));
typedef unsigned u32x4 __attribute__((ext_vector_type(4)));
typedef unsigned u32x2 __attribute__((ext_vector_type(2)));
#define DI __device__ __forceinline__

constexpr int D = 1024, NB = 16, SEQ = 4096, DEPTH = 4, MEMLEN = 256, DFF = 2816;
constexpr int M = NB * SEQ;
constexpr int MM = NB * MEMLEN;
constexpr float EPS = 1e-6f;
constexpr float LOG2E = 1.4426950408889634f;
constexpr int CONV_DIM = 512, CONV_W = 31, MLA_H = 8, QLORA = 256, KVLORA = 128, QK_NOPE = 64, QK_ROPE = 32, VHEAD = 64;
constexpr int EVEN_IN = 1440, EVEN_INP = 1536, S2N = 1792, S2K = 384;
constexpr int RET_H = 4, RET_QK = 256, RET_V = 512, RET_C = 128, ODD_MIX = 2048, ODD_IN = 6144;
constexpr int XH = 4, XHD = 256;

DI int opaque_tid() { int t = threadIdx.x; asm volatile("" : "+v"(t)); return t; }
DI unsigned cvt_pk_bf16(float lo, float hi) { unsigned r; asm volatile("v_cvt_pk_bf16_f32 %0, %1, %2" : "=v"(r) : "v"(lo), "v"(hi)); return r; }
DI float bf_lo(unsigned w) { return __uint_as_float(w << 16); }
DI float bf_hi(unsigned w) { return __uint_as_float(w & 0xffff0000u); }
DI float fast_exp2(float x) { return __builtin_amdgcn_exp2f(x); }
DI float fast_rcp(float x) { return __builtin_amdgcn_rcpf(x); }
DI float fast_rsq(float x) { return __builtin_amdgcn_rsqf(x); }
DI float sigmoidf_(float x) { return fast_rcp(1.0f + fast_exp2(-x * LOG2E)); }
DI float wave_sum(float v) {
#pragma unroll
    for (int o = 1; o < 64; o <<= 1) v += __shfl_xor(v, o);
    return v;
}
DI void sincos_turns(float ang, float& s, float& c) {
    float t = ang * 0.15915494309189535f; t = t - rintf(t);
    s = __builtin_amdgcn_sinf(t); c = __builtin_amdgcn_cosf(t);
}

namespace pg8 {
constexpr int BM = 256, BK = 64, HALF = 128, HTB = HALF * BK * 2, STAGE_BYTES = 8 * HTB, NXCD = 8, WGM = 8;
__host__ __device__ __forceinline__ int lds_byte(int r, int c) { const int st = (r >> 4) * 2 + (c >> 5), rr = r & 15, cc = c & 31, ob = rr * 64 + cc * 2; return st * 1024 + (ob ^ (((ob >> 9) & 1) << 5)); }
__host__ __device__ __forceinline__ void stage_rc(int b, int& R, int& C) { const int st = b / 1024, sb = b % 1024, swz = sb ^ (((sb >> 9) & 1) << 5); R = (st >> 1) * 16 + swz / 64; C = (st & 1) * 32 + (swz % 64) / 2; }
__host__ __device__ __forceinline__ int perm32(int rho) { const int n = rho >> 4, i = rho & 15; return 8 * (i >> 2) + 4 * n + (i & 3); }

struct Unit { int pm, pn; long aoff, boff; };
struct Gemm { const bf16_t* A; const bf16_t* Bt; };

template <int NM_, int NN_, int LDA_, int LDB_, int K_, int AMASK_, int ASH_, long A_PM_, long A_HI_, long A_PN_, int BSH_, long B_HI_, long B_PN_, bool REV_ = false>
struct Cfg { static constexpr int NM = NM_, NN = NN_, LDA = LDA_, LDB = LDB_, K = K_, AMASK = AMASK_, ASH = ASH_, BSH = BSH_; static constexpr long A_PM = A_PM_, A_HI = A_HI_, A_PN = A_PN_, B_HI = B_HI_, B_PN = B_PN_; static constexpr bool REV = REV_; };
template <int MROWS, int NCOLS, int LDA_, int LDB_, int K_> using CfgStd = Cfg<MROWS / 256, NCOLS / 256, LDA_, LDB_, K_, -1, 31, 256L * LDA_, 0, 0, 31, 0, 256L * LDB_>;
template <int MROWS, int NCOLS, int LDA_, int LDB_, int K_> using CfgStdRev = Cfg<MROWS / 256, NCOLS / 256, LDA_, LDB_, K_, -1, 31, 256L * LDA_, 0, 0, 31, 0, 256L * LDB_, true>;

template <class C> struct Order {
    int G, c, rev;
    DI bool next(int i, Unit& u) const {
        constexpr int nM = C::NM, nN = C::NN, nwg = nM * nN;
        const int L = i * G + c; if (L >= nwg) return false;
        int wgid = L; { constexpr int q = nwg / NXCD, r = nwg % NXCD; const int xcd = wgid % NXCD, off = wgid / NXCD; wgid = (xcd < r ? xcd * (q + 1) : r * (q + 1) + (xcd - r) * q) + off; }
        constexpr int nig = WGM * nN; const int gid = wgid / nig, fm = gid * WGM, gsz = (nM - fm) < WGM ? (nM - fm) : WGM;
        u.pm = fm + ((wgid % nig) % gsz); u.pn = (wgid % nig) / gsz;
        if constexpr (nM % NXCD == 0 && nwg % NXCD == 0) { if (rev) { constexpr int P = nM / NXCD; const int x = u.pm / P; u.pm = x * P + (P - 1 - (u.pm - x * P)); } }
        u.aoff = (long)(u.pm & C::AMASK) * C::A_PM + (long)(u.pm >> C::ASH) * C::A_HI + (long)u.pn * C::A_PN;
        u.boff = (long)(u.pm >> C::BSH) * C::B_HI + (long)u.pn * C::B_PN;
        return true;
    }
};

template <class E, class = void> struct EpiNst { static constexpr int value = 0; };
template <class E> struct EpiNst<E, decltype((void)E::NST)> { static constexpr int value = E::NST; };
template <int N> DI void pg8_waitv() { asm volatile("s_waitcnt vmcnt(%0)" :: "n"(N) : "memory"); }
struct NoHook { DI void operator()() const {} };
template <class C, class Epi, class Hook = NoHook>
DI void gemm_phase(LAS unsigned char* lds, const Gemm g, const int G_, const int c_, const Epi& E, const int rev_ = 0, const Hook& hk = Hook()) {
    int cq = c_; asm volatile("" : "+s"(cq));
    Order<C> S; S.G = G_; S.c = cq; S.rev = rev_;
    const int tid = opaque_tid(), wid = __builtin_amdgcn_readfirstlane(tid >> 6), lane = tid & 63, wr = wid >> 2, wc = wid & 3, fr = lane & 15, fq = lane >> 4;
    constexpr int K = C::K, nt = K / BK; static_assert(K % 128 == 0 && K >= 256, "K");
    unsigned voffA[2], voffB[2];
#pragma unroll
    for (int i = 0; i < 2; ++i) { int R, Cc; stage_rc(tid * 16 + i * 8192, R, Cc); const int Rb = Epi::PERM ? ((R & ~31) + perm32(R & 31)) : R;
        voffA[i] = (unsigned)(R * C::LDA + Cc) * 2u; voffB[i] = (unsigned)(Rb * C::LDB + Cc) * 2u; }
    constexpr size_t kstep = (size_t)(BK * 2);
    constexpr size_t hstepA = (size_t)HALF * C::LDA * 2, hstepB = (size_t)HALF * C::LDB * 2;
    const unsigned ldsw = (unsigned)wid * 1024u;
    const int aoff = lds_byte(wr * 64 + fr, fq * 8), boff = lds_byte(wc * 32 + fr, fq * 8);
#define PG8_SA(b, h) (((b) * 2 + (h)) * HTB)
#define PG8_SB(b, h) ((4 + (b) * 2 + (h)) * HTB)
#define PG8_STAGE(bufoff, gbase, voff) do { _Pragma("unroll") for (int _i = 0; _i < 2; ++_i) \
        __builtin_amdgcn_global_load_lds((const unsigned*)((const char*)(gbase) + (voff)[_i]), (LAS unsigned*)(lds + (bufoff) + ldsw + _i * 8192), 16, 0, 0); } while (0)
#define PG8_LDA(dst, b, h) do { _Pragma("unroll") for (int m = 0; m < 4; ++m) _Pragma("unroll") for (int k = 0; k < 2; ++k) dst[m][k] = *(const LAS bf16x8*)(lds + PG8_SA(b, h) + aoff + m * 2048 + k * 1024); } while (0)
#define PG8_LDB(dst, b, h) do { _Pragma("unroll") for (int n = 0; n < 2; ++n) _Pragma("unroll") for (int k = 0; k < 2; ++k) dst[n][k] = *(const LAS bf16x8*)(lds + PG8_SB(b, h) + boff + n * 2048 + k * 1024); } while (0)
#define PG8_MMA(ai, bj, At, Bt) do { __builtin_amdgcn_s_setprio(1); _Pragma("unroll") for (int m = 0; m < 4; ++m) _Pragma("unroll") for (int n = 0; n < 2; ++n) _Pragma("unroll") for (int k = 0; k < 2; ++k) \
        acc[ai][bj][m][n] = __builtin_amdgcn_mfma_f32_16x16x32_bf16(Bt[n][k], At[m][k], acc[ai][bj][m][n], 0, 0, 0); __builtin_amdgcn_s_setprio(0); } while (0)
#define PG8_WAIT_V(n) asm volatile("s_waitcnt vmcnt(" #n ")" ::: "memory")
#define PG8_WAIT_L(n) asm volatile("s_waitcnt lgkmcnt(" #n ")" ::: "memory")
#define PG8_BAR __builtin_amdgcn_s_barrier()
#define PG8_SCHED __builtin_amdgcn_sched_barrier(0)
    Unit cur, nxt; int ui = 0; bool after_epi = false;
    if (!S.next(0, cur)) return;
    f32x4 acc[2][2][4][2];
#pragma unroll
    for (int a = 0; a < 2; ++a)
#pragma unroll
        for (int b = 0; b < 2; ++b)
#pragma unroll
            for (int m = 0; m < 4; ++m)
#pragma unroll
                for (int n = 0; n < 2; ++n) acc[a][b][m][n] = (f32x4){0.f, 0.f, 0.f, 0.f};
    bf16x8 At[4][2], B0[2][2], B1[2][2];
    const char* cA = (const char*)(g.A + cur.aoff); const char* cB = (const char*)(g.Bt + cur.boff);
    PG8_STAGE(PG8_SB(0, 0), cB, voffB); PG8_STAGE(PG8_SB(0, 1), cB + hstepB, voffB); PG8_STAGE(PG8_SA(0, 0), cA, voffA); PG8_STAGE(PG8_SA(0, 1), cA + hstepA, voffA);
    hk();
    if (wr == 1) PG8_BAR;
    PG8_WAIT_V(2); PG8_BAR;
    PG8_STAGE(PG8_SB(1, 0), cB + kstep, voffB); PG8_STAGE(PG8_SA(1, 0), cA + kstep, voffA); PG8_STAGE(PG8_SB(1, 1), cB + hstepB + kstep, voffB);
    PG8_WAIT_V(6); PG8_BAR;
    for (;;) {
        const bool has_next = S.next(ui + 1, nxt);
        constexpr int NST = EpiNst<Epi>::value;
        const char* nA = has_next ? (const char*)(g.A + nxt.aoff) : cA; const char* nB = has_next ? (const char*)(g.Bt + nxt.boff) : cB;
#pragma nounroll
        for (int t = 0; t < nt; t += 2) {
            const bool last = (t == nt - 2); const bool fst = (NST > 0) && after_epi && (t == 0);
            const char* a1 = cA + (size_t)(t + 1) * kstep;
            const char* a2 = last ? nA : cA + (size_t)(t + 2) * kstep; const char* b2 = last ? nB : cB + (size_t)(t + 2) * kstep;
            const char* a3 = a2 + kstep; const char* b3 = b2 + kstep;
            PG8_LDB(B0, 0, 0); PG8_LDB(B1, 0, 1); PG8_SCHED; PG8_LDA(At, 0, 0); PG8_STAGE(PG8_SA(1, 1), a1 + hstepA, voffA);
            if (fst) pg8_waitv<8 + NST>(); else PG8_WAIT_V(8);
            PG8_WAIT_L(0); PG8_BAR; PG8_MMA(0, 0, At, B0); PG8_MMA(0, 1, At, B1); PG8_BAR; PG8_SCHED;
            PG8_LDA(At, 0, 1); PG8_STAGE(PG8_SB(0, 0), b2, voffB); PG8_STAGE(PG8_SB(0, 1), b2 + hstepB, voffB); PG8_STAGE(PG8_SA(0, 0), a2, voffA);
            if (fst) pg8_waitv<8 + NST>(); else PG8_WAIT_V(8);
            PG8_WAIT_L(0); PG8_BAR; PG8_MMA(1, 0, At, B0); PG8_MMA(1, 1, At, B1); PG8_BAR; PG8_SCHED;
            PG8_LDB(B0, 1, 0); PG8_LDB(B1, 1, 1); PG8_SCHED; PG8_LDA(At, 1, 0); PG8_STAGE(PG8_SA(0, 1), a2 + hstepA, voffA);
            PG8_WAIT_V(8); PG8_WAIT_L(0); PG8_BAR; PG8_MMA(0, 0, At, B0); PG8_MMA(0, 1, At, B1); PG8_BAR; PG8_SCHED;
            PG8_LDA(At, 1, 1); PG8_STAGE(PG8_SB(1, 0), b3, voffB); PG8_STAGE(PG8_SB(1, 1), b3 + hstepB, voffB); PG8_STAGE(PG8_SA(1, 0), a3, voffA);
            PG8_WAIT_V(8); PG8_WAIT_L(0); PG8_BAR; PG8_MMA(1, 0, At, B0); PG8_MMA(1, 1, At, B1); PG8_BAR; PG8_SCHED;
        }
        if (wr == 0) PG8_BAR;
        E(acc, cur, wr, wc, fr, fq);
        if (!has_next) break;
#pragma unroll
        for (int a = 0; a < 2; ++a)
#pragma unroll
            for (int b = 0; b < 2; ++b)
#pragma unroll
                for (int m = 0; m < 4; ++m)
#pragma unroll
                    for (int n = 0; n < 2; ++n) acc[a][b][m][n] = (f32x4){0.f, 0.f, 0.f, 0.f};
        cur = nxt; cA = nA; cB = nB; ++ui; after_epi = true;
        if (wr == 1) PG8_BAR;
    }
    PG8_WAIT_V(0);
    PG8_BAR;
#undef PG8_SA
#undef PG8_SB
#undef PG8_STAGE
#undef PG8_LDA
#undef PG8_LDB
#undef PG8_MMA
#undef PG8_WAIT_V
#undef PG8_WAIT_L
#undef PG8_BAR
#undef PG8_SCHED
}
}
using pg8::Unit;

constexpr size_t MiB = 1u << 20;
constexpr size_t WS_CTL = 0, CTL_ZERO_BYTES = 1 * MiB;
constexpr size_t WS_SSQ = 1 * MiB;
constexpr size_t WS_QSS = 5 * MiB;
constexpr size_t WS_LS = 9 * MiB;
constexpr size_t WS_ZS = 13 * MiB;
constexpr size_t WS_GNS = 15 * MiB;
constexpr size_t WS_KSS = 23 * MiB;
constexpr size_t WS_RMEM = 24 * MiB;
constexpr size_t WS_MEMB = 25 * MiB;
constexpr size_t WS_KP = 33 * MiB;
constexpr size_t WS_VT = 65 * MiB;
constexpr size_t WS_W = 97 * MiB;
constexpr size_t W_LAYER = 37 * MiB;
constexpr size_t WO_GU1 = 0, WO_D1 = 11 * MiB, WO_GU2 = 16 * MiB + MiB / 2, WO_D2 = 27 * MiB + MiB / 2, WO_Q = 33 * MiB, WO_O = 35 * MiB;
constexpr size_t WS_WE = WS_W + 4 * W_LAYER;
constexpr size_t W_EVEN = 6 * MiB + MiB / 2, WE_IN = 0, WE_S2 = 3 * MiB, WE_OUT = 4 * MiB + MiB / 2;
constexpr size_t WS_WO = WS_WE + 2 * W_EVEN;
constexpr size_t W_ODD = 16 * MiB, WOD_IN = 0, WOD_OUT = 12 * MiB;
constexpr size_t WS_XB = WS_WO + 2 * W_ODD;
constexpr size_t WS_ACT = WS_XB + 128 * MiB;
constexpr size_t WS_VW = WS_ACT + 512 * MiB;
constexpr size_t WS_END = WS_VW + 32 * MiB;
static_assert(WS_XB == 290 * MiB && WS_END == 962 * MiB, "ws map");
constexpr size_t A_H = 0;
constexpr size_t A_AB = 0, A_ZC = 64 * MiB, A_KR = 112 * MiB, A_QH = 116 * MiB, A_KN = 212 * MiB, A_VB = 276 * MiB, A_MIX = 340 * MiB;
constexpr size_t A_RQ = 0, A_RK = 128 * MiB, A_RV = 256 * MiB;
constexpr size_t A_XQ = 0, A_XP = 128 * MiB, A_XO = 256 * MiB;
constexpr size_t A_WK = 0, A_WV = 8 * MiB;
constexpr int CW_BAR = 4096;
constexpr int CW_KMAX = 16384;
constexpr int CW_SHE = 16384 + 512;
constexpr int CW_TAB = 32768;
DI const float* inp_ptr(const unsigned char* ws, int i) {
    const unsigned long long v = ((const unsigned long long*)(ws + WS_CTL + CW_TAB * 4))[i];
    const unsigned lo = __builtin_amdgcn_readfirstlane((unsigned)v), hi = __builtin_amdgcn_readfirstlane((unsigned)(v >> 32));
    return (const float*)(GAS const float*)(((unsigned long long)hi << 32) | lo); }
#define INP(i) inp_ptr(ws, (i))

constexpr int RING_BYTES = 131072;
constexpr int LDSCTL_OFF = RING_BYTES + 16384;
constexpr int LDS_BYTES = LDSCTL_OFF + 256;
static_assert(LDS_BYTES <= 160 * 1024 && LDS_BYTES > 80 * 1024, "LDS");

#define XB_TMO      128
#define XB_XCNT(j)  (256  + 64 * (j))
#define XB_XSUB(j)  (1280 + 64 * (j))
#define XB_XGEN(j)  (2304 + 64 * (j))
#define XB_TOP      3328
#define XB_TOPGEN   3392
#define XCD_BAR_WORDS 3456
#define XB_SPIN_CAP (1u << 22)
DI unsigned xb_ld(unsigned* p)              { return __hip_atomic_load(p, __ATOMIC_RELAXED, __HIP_MEMORY_SCOPE_AGENT); }
DI unsigned xb_add(unsigned* p, unsigned v) { return __hip_atomic_fetch_add(p, v, __ATOMIC_RELAXED, __HIP_MEMORY_SCOPE_AGENT); }
DI unsigned xb_xcc_id() { return (unsigned)__builtin_amdgcn_s_getreg((3 << 11) | 20) & 0xFu; }
#define XB_SPIN(cond, bar) do { unsigned _sp = 0; while (cond) { __builtin_amdgcn_s_sleep(1); \
    if ((++_sp & 255u) == 0u) { if (xb_ld(&(bar)[XB_TMO])) break; if (_sp > XB_SPIN_CAP) { atomicAdd(&(bar)[XB_TMO], 1u); break; } } } } while (0)
struct XcdBarrier { unsigned* bar; unsigned x; volatile LAS unsigned* st; };
DI XcdBarrier xcd_barrier_post(unsigned* bar, volatile LAS unsigned* st) {
    XcdBarrier b; b.bar = bar; b.x = xb_xcc_id(); b.st = st;
    if (threadIdx.x == 0) st[2] = xb_add(&bar[XB_XCNT(b.x)], 1u);
    return b;
}
#define XL_SUB(j)   (XCD_BAR_WORDS + 64 * (j))
#define XL_GEN(j)   (XCD_BAR_WORDS + 1024 + 64 * (j))
DI void xcd_local_barrier(const XcdBarrier& b) {
    asm volatile("s_waitcnt vmcnt(0)" ::: "memory");
    __syncthreads();
    if (threadIdx.x == 0) {
        unsigned* bar = b.bar;
        unsigned bx = b.x; asm volatile("" : "+s"(bx));
        __builtin_amdgcn_s_waitcnt(0);
        const unsigned target = b.st[4] + b.st[0]; b.st[4] = target;
        (void)__hip_atomic_fetch_add(&bar[XL_SUB(bx)], 1u, __ATOMIC_RELAXED, __HIP_MEMORY_SCOPE_AGENT);
        XB_SPIN(xb_ld(&bar[XL_SUB(bx)]) < target, bar);
        __builtin_amdgcn_fence(__ATOMIC_ACQUIRE, "agent");
        asm volatile("s_waitcnt vmcnt(0)" ::: "memory");
    }
    __syncthreads();
}
DI void cu_local_seam() {
    asm volatile("s_waitcnt vmcnt(0)" ::: "memory");
    __syncthreads();
    if (threadIdx.x == 0) { __builtin_amdgcn_fence(__ATOMIC_ACQUIRE, "agent"); asm volatile("s_waitcnt vmcnt(0)" ::: "memory"); }
    __syncthreads();
}
DI void xcd_barrier_complete(unsigned* bar, unsigned x, unsigned& nloc, unsigned& nx) {
    const unsigned G = gridDim.x * gridDim.y * gridDim.z;
    unsigned sum, cnt, mine, sp = 0u;
    for (;;) {
        sum = 0u; cnt = 0u; mine = 0u;
#pragma unroll
        for (unsigned j = 0; j < 16; ++j) { const unsigned c = xb_ld(&bar[XB_XCNT(j)]); sum += c; cnt += (c > 0u) ? 1u : 0u; mine = (j == x) ? c : mine; }
        if (sum == G) break;
        __builtin_amdgcn_s_sleep(1);
        if ((++sp & 255u) == 0u) { if (xb_ld(&bar[XB_TMO])) break; if (sp > XB_SPIN_CAP) { atomicAdd(&bar[XB_TMO], 1u); break; } }
    }
    nloc = mine > 0u ? mine : 1u; nx = cnt > 0u ? cnt : 1u;
}
DI void xcd_barrier(const XcdBarrier& b) {
    asm volatile("s_waitcnt vmcnt(0)" ::: "memory");
    __syncthreads();
    if (threadIdx.x == 0) {
        unsigned* bar = b.bar;
        unsigned bx = b.x; asm volatile("" : "+s"(bx));
        __builtin_amdgcn_s_waitcnt(0);
        unsigned nloc = b.st[0], nx = b.st[1];
        if (nloc == 0u) { xcd_barrier_complete(bar, bx, nloc, nx); b.st[0] = nloc; b.st[1] = nx; }
        const unsigned old = xb_add(&bar[XB_XSUB(bx)], 1u);
        const unsigned gen = old / nloc;
        if (old + 1u == (gen + 1u) * nloc) {
            __builtin_amdgcn_fence(__ATOMIC_RELEASE, "agent");
            asm volatile("s_waitcnt vmcnt(0)" ::: "memory");
            const unsigned og = xb_add(&bar[XB_TOP], 1u);
            const unsigned tg = og / nx;
            if (og + 1u == (tg + 1u) * nx) xb_add(&bar[XB_TOPGEN], 1u);
            else XB_SPIN(xb_ld(&bar[XB_TOPGEN]) == tg, bar);
            __builtin_amdgcn_fence(__ATOMIC_ACQUIRE, "agent");
            xb_add(&bar[XB_XGEN(bx)], 1u);
            asm volatile("s_waitcnt vmcnt(0)" ::: "memory");
        } else {
            XB_SPIN(xb_ld(&bar[XB_XGEN(bx)]) == gen, bar);
            __builtin_amdgcn_fence(__ATOMIC_ACQUIRE, "agent");
            asm volatile("s_waitcnt vmcnt(0)" ::: "memory");
        }
    }
    __syncthreads();
}

#define EPI_FENCE() do { asm volatile("" ::: "memory"); __builtin_amdgcn_sched_barrier(0); } while (0)
#define EPI_ROW(u, ai, m) ((u).pm * 256 + (ai) * 128 + wr * 64 + (m) * 16 + fr)
DI float sum4(f32x4 a) { return (a.x + a.y) + (a.z + a.w); }
DI float dot4(f32x4 a) { return (a.x * a.x + a.y * a.y) + (a.z * a.z + a.w * a.w); }
DI float rstd16(const float* p16, float invn) {
    const f32x4* p = (const f32x4*)p16; const f32x4 a = p[0], b = p[1], c = p[2], d = p[3];
    return fast_rsq(((sum4(a) + sum4(b)) + (sum4(c) + sum4(d))) * invn + EPS);
}
DI float rstd4(const float* p4, float invn) { const f32x4 a = *(const f32x4*)p4; return fast_rsq(sum4(a) * invn + EPS); }
DI float red_fq(float s) { s += __shfl_xor(s, 16); s += __shfl_xor(s, 32); return s; }
DI u32x4 pack8(f32x4 a, f32x4 b) { u32x4 w; w.x = cvt_pk_bf16(a.x, a.y); w.y = cvt_pk_bf16(a.z, a.w); w.z = cvt_pk_bf16(b.x, b.y); w.w = cvt_pk_bf16(b.z, b.w); return w; }
DI u32x2 pack4(f32x4 a) { u32x2 w; w.x = cvt_pk_bf16(a.x, a.y); w.y = cvt_pk_bf16(a.z, a.w); return w; }
DI f32x4 silu4(f32x4 g) { f32x4 o; o.x = g.x * sigmoidf_(g.x); o.y = g.y * sigmoidf_(g.y); o.z = g.z * sigmoidf_(g.z); o.w = g.w * sigmoidf_(g.w); return o; }
DI f32x4 sig4(f32x4 g) { f32x4 o; o.x = sigmoidf_(g.x); o.y = sigmoidf_(g.y); o.z = sigmoidf_(g.z); o.w = sigmoidf_(g.w); return o; }
typedef f32x4 AccT[2][2][4][2];

#define EPI_OPAQUE() int fr = fr_, fq = fq_; asm volatile("" : "+v"(fr), "+v"(fq))
#define EPI_ROWK(u, k) EPI_ROW(u, (k) >> 2, (k) & 3)
DI void rstd_rows16(const float* ssq, const Unit& u, int wr, int fr, int fq, float (&r)[8]) {
    f32x4 p[8];
#pragma unroll
    for (int k = 0; k < 8; ++k) p[k] = *(const f32x4*)(ssq + (size_t)EPI_ROWK(u, k) * 16 + fq * 4);
#pragma unroll
    for (int k = 0; k < 8; ++k) r[k] = fast_rsq(red_fq(sum4(p[k])) * (1.0f / D) + EPS);
}
DI void sum4_rows(const float* base, int stride, int off, const Unit& u, int wr, int fr, float (&r)[8]) {
    f32x4 p[8];
#pragma unroll
    for (int k = 0; k < 8; ++k) p[k] = *(const f32x4*)(base + (size_t)EPI_ROWK(u, k) * stride + off);
#pragma unroll
    for (int k = 0; k < 8; ++k) r[k] = sum4(p[k]);
}
DI void pos_rows(const int* pos, const Unit& u, int wr, int fr, float (&r)[8]) {
    int p[8];
#pragma unroll
    for (int k = 0; k < 8; ++k) p[k] = pos[EPI_ROWK(u, k)];
#pragma unroll
    for (int k = 0; k < 8; ++k) r[k] = (float)p[k];
}
constexpr int RT_OFF = 131072 + 4096, PT_OFF = RT_OFF + 4096;
DI void row_tables(LAS unsigned char* lds, const float* ssq, const int* pos, int x, int j, int rev) {
    const int tid = opaque_tid(); LAS float* rt = (LAS float*)(lds + RT_OFF); LAS float* pt = (LAS float*)(lds + PT_OFF);
    const int pin = rev ? 7 - (j & 7) : (j & 7);
#pragma unroll
    for (int i = 0; i < 2; ++i) { const int ri = tid + 512 * i, s = ri >> 8, rl = ri & 255; const size_t row = (size_t)(32 * x + 8 * s + pin) * 256 + rl;
        const f32x4* p = (const f32x4*)(ssq + row * 16); const f32x4 a = p[0], b = p[1], c = p[2], d = p[3];
        rt[ri] = fast_rsq(((sum4(a) + sum4(b)) + (sum4(c) + sum4(d))) * (1.0f / D) + EPS);
        if (pos) pt[ri] = (float)pos[row]; }
    asm volatile("s_waitcnt lgkmcnt(0)\n\ts_barrier" ::: "memory");
}
DI void score_tables(LAS unsigned char* lds, const float* qss, const unsigned* kmax, int x, int j, int rev) {
    const int tid = opaque_tid(); LAS float* t1 = (LAS float*)(lds + RT_OFF); const int hd = j >> 3;
    const int pin = rev ? 7 - (j & 7) : (j & 7);
#pragma unroll
    for (int i = 0; i < 2; ++i) { const int ri = tid + 512 * i, s = ri >> 8, rl = ri & 255; const size_t row = (size_t)(32 * x + 8 * s + pin) * 256 + rl;
        t1[ri] = sum4(*(const f32x4*)(qss + row * 16 + hd * 4)); }
    if (tid < 4) t1[1024 + tid] = 16.0f * __uint_as_float(kmax[((32 * x + 8 * tid) >> 4) * 4 + hd]);
    asm volatile("s_waitcnt lgkmcnt(0)\n\ts_barrier" ::: "memory");
}
DI void tab_rows(const LAS float* t, const Unit& u, int wr, int fr, float (&r)[8]) {
    const LAS float* b = t + ((u.pm >> 3) & 3) * 256 + wr * 64 + fr;
#pragma unroll
    for (int k = 0; k < 8; ++k) r[k] = b[(k >> 2) * 128 + (k & 3) * 16];
}
#define EPI_GROUPS() _Pragma("unroll") for (int k = 0; k < 8; ++k)
#define EPI_K() const int ai = k >> 2, m = k & 3; __builtin_amdgcn_sched_barrier(0); const int row = EPI_ROW(u, ai, m)

struct EpiSwiGLU { static constexpr bool PERM = true; static constexpr int NST = 8; bf16_t* H; const float* ssq; const LAS float* rt = nullptr;
    DI float one(float ag, float au, float nr, float c) const { asm volatile("" : "+v"(ag), "+v"(au));
        const float e = fast_exp2(ag * nr), d = __builtin_fmaf(e, c, c); return (ag * au) * fast_rcp(d); }
    DI void operator()(const AccT& acc, const Unit& u, int wr, int wc, int fr_, int fq_) const { EPI_OPAQUE();
        float r[8]; if (rt) tab_rows(rt, u, wr, fr, r); else rstd_rows16(ssq, u, wr, fr, fq, r);
        EPI_GROUPS() { EPI_K();
            const float nr = -LOG2E * r[k], c = fast_rcp(r[k] * r[k]);
            f32x4 h0, h1;
#pragma unroll
            for (int j = 0; j < 4; ++j) { h0[j] = one(acc[ai][0][m][0][j], acc[ai][1][m][0][j], nr, c); h1[j] = one(acc[ai][0][m][1][j], acc[ai][1][m][1][j], nr, c); }
            *(u32x4*)(H + (size_t)row * DFF + u.pn * 128 + wc * 32 + 8 * fq) = pack8(h0, h1); }
    }
};
template <bool FINAL> struct EpiResid { static constexpr bool PERM = true; static constexpr int NST = 16; bf16_t* xb; float* ssq; float* out;
    DI void operator()(const AccT& acc, const Unit& u, int wr, int wc, int fr_, int fq_) const { EPI_OPAQUE();
        const char* xbb = (const char*)xb;
        const unsigned off0 = (unsigned)(((u.pm * 256 + wr * 64 + fr) * D + u.pn * 256 + wc * 32 + 8 * fq) * 2);
        const unsigned so0 = (unsigned)(((u.pm * 256 + wr * 64 + fr) * 16 + u.pn * 4 + wc) * 4);
#pragma unroll
        for (int ai = 0; ai < 2; ++ai) {
            u32x4 w[4][2];
#pragma unroll
            for (int m = 0; m < 4; ++m)
#pragma unroll
                for (int bj = 0; bj < 2; ++bj) w[m][bj] = *(const u32x4*)(xbb + (off0 + (unsigned)((ai * 128 + m * 16) * D * 2 + bj * 256)));
#pragma unroll
            for (int m = 0; m < 4; ++m) { __builtin_amdgcn_sched_barrier(0); f32x4 sq = (f32x4){0.f, 0.f, 0.f, 0.f};
#pragma unroll
                for (int bj = 0; bj < 2; ++bj) { const unsigned ob = off0 + (unsigned)((ai * 128 + m * 16) * D * 2 + bj * 256); const u32x4 ww = w[m][bj];
                    const f32x4 x0 = (f32x4){bf_lo(ww.x), bf_hi(ww.x), bf_lo(ww.y), bf_hi(ww.y)} + acc[ai][bj][m][0], x1 = (f32x4){bf_lo(ww.z), bf_hi(ww.z), bf_lo(ww.w), bf_hi(ww.w)} + acc[ai][bj][m][1];
                    if (FINAL) { float* op = (float*)((char*)out + 2u * (size_t)ob); *(f32x4*)op = x0; *(f32x4*)(op + 4) = x1; }
                    else { *(u32x4*)((char*)xb + ob) = pack8(x0, x1); sq = __builtin_elementwise_fma(x0, x0, sq); sq = __builtin_elementwise_fma(x1, x1, sq); } }
                if (!FINAL) { const float s = red_fq(sum4(sq)); if (fq == 0) *(float*)((char*)ssq + (so0 + (unsigned)((ai * 128 + m * 16) * 64))) = s; } }
        }
    }
};
struct EpiQraw { static constexpr bool PERM = true; static constexpr int NST = 16; bf16_t* Q; const float* ssq; float* qss; const LAS float* rt = nullptr;
    DI void operator()(const AccT& acc, const Unit& u, int wr, int wc, int fr_, int fq_) const { EPI_OPAQUE();
        float r[8]; if (rt) tab_rows(rt, u, wr, fr, r); else rstd_rows16(ssq, u, wr, fr, fq, r);
        EPI_GROUPS() { EPI_K(); float s = 0.f;
#pragma unroll
            for (int bj = 0; bj < 2; ++bj) { const f32x4 v0 = acc[ai][bj][m][0] * r[k], v1 = acc[ai][bj][m][1] * r[k]; s += dot4(v0) + dot4(v1);
                *(u32x4*)(Q + (size_t)row * D + u.pn * 256 + bj * 128 + wc * 32 + 8 * fq) = pack8(v0, v1); }
            s = red_fq(s); if (fq == 0) qss[(size_t)row * 16 + u.pn * 4 + wc] = s; }
    }
};
struct EpiScoresN { static constexpr bool PERM = true; static constexpr int NST = 16; bf16_t* P; const LAS float* qt; LAS float* tab;
    DI void operator()(const AccT& acc, const Unit& u, int wr, int wc, int fr_, int fq_) const { EPI_OPAQUE();
        const float sh = qt[1024 + ((u.pm >> 3) & 3)];
        float rq[8]; tab_rows(qt, u, wr, fr, rq);
        u32x4 w[8][2];
        EPI_GROUPS() { const int ai = k >> 2, m = k & 3; __builtin_amdgcn_sched_barrier(0);
            const float rqk = fast_rsq(rq[k] * (1.0f / XHD) + EPS); float sm = 0.f;
#pragma unroll
            for (int bj = 0; bj < 2; ++bj) { f32x4 p0, p1;
#pragma unroll
                for (int j = 0; j < 4; ++j) { p0[j] = fast_exp2(acc[ai][bj][m][0][j] * rqk - sh); p1[j] = fast_exp2(acc[ai][bj][m][1][j] * rqk - sh); }
                const u32x4 ww = pack8(p0, p1); w[k][bj] = ww;
                sm += ((bf_lo(ww.x) + bf_hi(ww.x)) + (bf_lo(ww.y) + bf_hi(ww.y))) + ((bf_lo(ww.z) + bf_hi(ww.z)) + (bf_lo(ww.w) + bf_hi(ww.w))); }
            sm = red_fq(sm); if (fq == 0) tab[(ai * 128 + wr * 64 + m * 16 + fr) * 4 + wc] = sm; }
        asm volatile("s_waitcnt lgkmcnt(0)\n\ts_barrier" ::: "memory");
        EPI_GROUPS() { const int ai = k >> 2, m = k & 3; __builtin_amdgcn_sched_barrier(0); const int row = EPI_ROW(u, ai, m);
            const float li = fast_rcp(sum4(*(const LAS f32x4*)(tab + (ai * 128 + wr * 64 + m * 16 + fr) * 4)));
#pragma unroll
            for (int bj = 0; bj < 2; ++bj) { const u32x4 ww = w[k][bj];
                const f32x4 a = (f32x4){bf_lo(ww.x), bf_hi(ww.x), bf_lo(ww.y), bf_hi(ww.y)} * li, b = (f32x4){bf_lo(ww.z), bf_hi(ww.z), bf_lo(ww.w), bf_hi(ww.w)} * li;
                *(u32x4*)(P + (size_t)row * D + u.pn * 256 + bj * 128 + wc * 32 + 8 * fq) = pack8(a, b); } }
    }
};
struct EpiVW { static constexpr bool PERM = true; bf16_t* VW;
    DI void operator()(const AccT& acc, const Unit& u, int wr, int wc, int fr_, int fq_) const { EPI_OPAQUE();
        bf16_t* base = VW + ((size_t)(u.pm >> 2) * D + (u.pm & 3) * 256) * (XH * MEMLEN) + u.pn * MEMLEN + wc * 32 + 8 * fq;
        EPI_GROUPS() { const int ai = k >> 2, m = k & 3; __builtin_amdgcn_sched_barrier(0); const int r = ai * 128 + wr * 64 + m * 16 + fr;
#pragma unroll
            for (int bj = 0; bj < 2; ++bj) *(u32x4*)(base + (size_t)r * (XH * MEMLEN) + bj * 128) = pack8(acc[ai][bj][m][0], acc[ai][bj][m][1]); }
    }
};
struct EpiMemK { static constexpr bool PERM = true; bf16_t* KP; const float* rmem; float* kss; const float* knorm; const float* qnorm;
    DI void operator()(const AccT& acc, const Unit& u, int wr, int wc, int fr_, int fq_) const { EPI_OPAQUE();
        const int l = u.pm >> 4; f32x4 g[2][2];
#pragma unroll
        for (int bj = 0; bj < 2; ++bj)
#pragma unroll
            for (int n = 0; n < 2; ++n) { const int d = bj * 128 + wc * 32 + 8 * fq + 4 * n; g[bj][n] = *(const f32x4*)(knorm + l * XHD + d) * *(const f32x4*)(qnorm + l * XHD + d) * (LOG2E / 16.0f); }
        float rr[8];
#pragma unroll
        for (int k = 0; k < 8; ++k) rr[k] = rmem[EPI_ROWK(u, k) & (MM - 1)];
        EPI_GROUPS() { EPI_K(); const float r = rr[k]; float s = 0.f;
#pragma unroll
            for (int bj = 0; bj < 2; ++bj) { const f32x4 v0 = acc[ai][bj][m][0] * r, v1 = acc[ai][bj][m][1] * r; s += dot4(v0) + dot4(v1);
                *(u32x4*)(KP + (size_t)row * D + u.pn * 256 + bj * 128 + wc * 32 + 8 * fq) = pack8(v0 * g[bj][0], v1 * g[bj][1]); }
            s = red_fq(s); if (fq == 0) kss[(size_t)row * 16 + u.pn * 4 + wc] = s; }
    }
};
struct EpiMemV { static constexpr bool PERM = true; bf16_t* V; const float* rmem;
    DI void operator()(const AccT& acc, const Unit& u, int wr, int wc, int fr_, int fq_) const { EPI_OPAQUE();
        float rr[8];
#pragma unroll
        for (int k = 0; k < 8; ++k) rr[k] = rmem[EPI_ROWK(u, k) & (MM - 1)];
        EPI_GROUPS() { EPI_K(); const float r = rr[k];
#pragma unroll
            for (int bj = 0; bj < 2; ++bj) *(u32x4*)(V + (size_t)row * D + u.pn * 256 + bj * 128 + wc * 32 + 8 * fq) = pack8(acc[ai][bj][m][0] * r, acc[ai][bj][m][1] * r); }
    }
};
constexpr float LOG2_THETA = 13.287712379549449f;
DI void rope_mla(f32x4& x1, f32x4& x2, float pos, int fq) {
#pragma unroll
    for (int j = 0; j < 4; ++j) { const float inv = fast_exp2(-(float)(4 * fq + j) * (LOG2_THETA / 16.0f)); float s, c; sincos_turns(pos * inv, s, c);
        const float a = x1[j], b = x2[j]; x1[j] = a * c - b * s; x2[j] = a * s + b * c; }
}
struct EpiEven1 { static constexpr bool PERM = true; bf16_t* AB; bf16_t* ZC; bf16_t* KR; const float* ssq; float* zs; const float* gkr; const int* pos; const LAS float* rt = nullptr; const LAS float* pt = nullptr;
    DI void operator()(const AccT& acc, const Unit& u, int wr, int wc, int fr_, int fq_) const { EPI_OPAQUE();
        float rr[8]; if (rt) tab_rows(rt, u, wr, fr, rr); else rstd_rows16(ssq, u, wr, fr, fq, rr);
        float pp[8];
        if (u.pn == 5 && wc == 0) { if (pt) tab_rows(pt, u, wr, fr, pp); else pos_rows(pos, u, wr, fr, pp); }
        EPI_GROUPS() { EPI_K(); const float r = rr[k];
            if (u.pn < 4) {
                const f32x4 a0 = (acc[ai][0][m][0] * r) * sig4(acc[ai][1][m][0] * r), a1 = (acc[ai][0][m][1] * r) * sig4(acc[ai][1][m][1] * r);
                *(u32x4*)(AB + (size_t)row * CONV_DIM + u.pn * 128 + wc * 32 + 8 * fq) = pack8(a0, a1);
            } else if (u.pn == 4) {
                float s = 0.f;
#pragma unroll
                for (int bj = 0; bj < 2; ++bj) { const f32x4 v0 = acc[ai][bj][m][0] * r, v1 = acc[ai][bj][m][1] * r; s += dot4(v0) + dot4(v1);
                    *(u32x4*)(ZC + (size_t)row * S2K + bj * 128 + wc * 32 + 8 * fq) = pack8(v0, v1); }
                s = red_fq(s); if (fq == 0) zs[(size_t)row * 8 + wc] = s;
            } else {
                { const f32x4 v0 = acc[ai][0][m][0] * r, v1 = acc[ai][0][m][1] * r; float s = red_fq(dot4(v0) + dot4(v1));
                  *(u32x4*)(ZC + (size_t)row * S2K + 256 + wc * 32 + 8 * fq) = pack8(v0, v1); if (fq == 0) zs[(size_t)row * 8 + 4 + wc] = s; }
                if (wc == 0) {
                    f32x4 x1 = acc[ai][1][m][0] * r, x2 = acc[ai][1][m][1] * r; const float ss = red_fq(dot4(x1) + dot4(x2));
                    const float rn = fast_rsq(ss * (1.0f / QK_ROPE) + EPS);
                    x1 = x1 * rn * *(const f32x4*)(gkr + 4 * fq); x2 = x2 * rn * *(const f32x4*)(gkr + 16 + 4 * fq);
                    rope_mla(x1, x2, pp[k], fq);
                    *(u32x2*)(KR + (size_t)row * QK_ROPE + 4 * fq) = pack4(x1); *(u32x2*)(KR + (size_t)row * QK_ROPE + 16 + 4 * fq) = pack4(x2);
                }
            }
        }
    }
};
struct EpiEven2 { static constexpr bool PERM = true; bf16_t* QH; bf16_t* KN; bf16_t* VB; const float* zs; const float* gqn; const float* gqr; const float* gkn; const int* pos; float qscale;
    DI void operator()(const AccT& acc, const Unit& u, int wr, int wc, int fr_, int fq_) const { EPI_OPAQUE();
        const bool isq = u.pn < 3; const int ws = (isq ? u.pn : u.pn - 3) * 4 + wc;
        float zz[8]; sum4_rows(zs, 8, isq ? 0 : 4, u, wr, fr, zz);
        float pp[8];
        if (isq && ws >= 8) pos_rows(pos, u, wr, fr, pp);
        EPI_GROUPS() { EPI_K();
            const float rz = fast_rsq(zz[k] * (isq ? 1.0f / QLORA : 1.0f / KVLORA) + EPS);
            if (ws < 8) {
                f32x4 v[2][2]; float s = 0.f;
#pragma unroll
                for (int bj = 0; bj < 2; ++bj)
#pragma unroll
                    for (int n = 0; n < 2; ++n) { v[bj][n] = acc[ai][bj][m][n] * rz; s += dot4(v[bj][n]); }
                s = red_fq(s); const float rn = fast_rsq(s * (1.0f / QK_NOPE) + EPS) * (isq ? qscale : 1.0f);
                const float* g = isq ? gqn : gkn; bf16_t* dst = isq ? QH + (size_t)row * 768 + ws * 96 : KN + (size_t)row * 512 + ws * 64;
#pragma unroll
                for (int bj = 0; bj < 2; ++bj) { const int d = 32 * bj + 8 * fq;
                    *(u32x4*)(dst + d) = pack8(v[bj][0] * rn * *(const f32x4*)(g + d), v[bj][1] * rn * *(const f32x4*)(g + d + 4)); }
            } else if (isq) {
#pragma unroll
                for (int bj = 0; bj < 2; ++bj) { const int head = 2 * (ws - 8) + bj;
                    f32x4 x1 = acc[ai][bj][m][0] * rz, x2 = acc[ai][bj][m][1] * rz; const float ss = red_fq(dot4(x1) + dot4(x2));
                    const float rn = fast_rsq(ss * (1.0f / QK_ROPE) + EPS);
                    x1 = x1 * rn * *(const f32x4*)(gqr + 4 * fq); x2 = x2 * rn * *(const f32x4*)(gqr + 16 + 4 * fq);
                    rope_mla(x1, x2, pp[k], fq);
                    bf16_t* dst = QH + (size_t)row * 768 + head * 96 + 64;
                    *(u32x2*)(dst + 4 * fq) = pack4(x1 * qscale); *(u32x2*)(dst + 16 + 4 * fq) = pack4(x2 * qscale); }
            } else {
#pragma unroll
                for (int bj = 0; bj < 2; ++bj) *(u32x4*)(VB + (size_t)row * 512 + (ws - 8) * 64 + 32 * bj + 8 * fq) = pack8(acc[ai][bj][m][0] * rz, acc[ai][bj][m][1] * rz);
            }
        }
    }
};
struct EpiOdd1 { static constexpr bool PERM = true; static constexpr int NST = 16; bf16_t* Q; bf16_t* Kk; bf16_t* V; const float* ssq; const int* pos; const LAS float* rt = nullptr; const LAS float* pt = nullptr;
    DI void operator()(const AccT& acc, const Unit& u, int wr, int wc, int fr_, int fq_) const { EPI_OPAQUE();
        float rr[8]; if (rt) tab_rows(rt, u, wr, fr, rr); else rstd_rows16(ssq, u, wr, fr, fq, rr);
        if (u.pn < 8) {
            float pp[8]; if (pt) tab_rows(pt, u, wr, fr, pp); else pos_rows(pos, u, wr, fr, pp);
            float inv[2][4];
#pragma unroll
            for (int n = 0; n < 2; ++n)
#pragma unroll
                for (int j = 0; j < 4; ++j) inv[n][j] = fast_exp2(-(float)(32 * wc + 8 * fq + 4 * n + j) * (LOG2_THETA / 128.0f));
            const bool isk = u.pn >= 4; const float osc = isk ? (1.0f / 16.0f) : 1.0f; bf16_t* base = (isk ? Kk : Q) + (u.pn & 3) * 256 + 32 * wc + 8 * fq;
            const float l2gk = __builtin_log2f(1.0f - fast_exp2(-5.0f - (float)(u.pn & 3)));
            EPI_GROUPS() { EPI_K(); const float r = rr[k] * (isk ? osc * fast_exp2(-(float)(16 * m + fr + 1) * l2gk) : 1.0f); const float p = pp[k];
                f32x4 o1[2], o2[2];
#pragma unroll
                for (int n = 0; n < 2; ++n)
#pragma unroll
                    for (int j = 0; j < 4; ++j) { float s, c; sincos_turns(p * inv[n][j], s, c); const float a = acc[ai][0][m][n][j] * r, b = acc[ai][1][m][n][j] * r; o1[n][j] = a * c - b * s; o2[n][j] = a * s + b * c; }
                *(u32x4*)(base + (size_t)row * 1024) = pack8(o1[0], o1[1]); *(u32x4*)(base + (size_t)row * 1024 + 128) = pack8(o2[0], o2[1]); }
        } else {
            EPI_GROUPS() { EPI_K(); const float r = rr[k];
#pragma unroll
                for (int bj = 0; bj < 2; ++bj) *(u32x4*)(V + (size_t)row * ODD_MIX + (u.pn - 8) * 256 + bj * 128 + wc * 32 + 8 * fq) = pack8(acc[ai][bj][m][0] * r, acc[ai][bj][m][1] * r); }
        }
    }
};
struct EpiGate { static constexpr bool PERM = true; static constexpr int NST = 16; bf16_t* O; const float* gns; const LAS float* rt; const LAS float* gt;
    DI void operator()(const AccT& acc, const Unit& u, int wr, int wc, int fr_, int fq_) const { EPI_OPAQUE();
        const int head = u.pn >> 1; const int c0 = u.pn * 256 + wc * 32 + 8 * fq; const int t0 = ((u.pn >> 2) & 1) * 256 + wc * 32 + 8 * fq;
        float rr[8]; tab_rows(rt, u, wr, fr, rr);
#pragma unroll
        for (int ai = 0; ai < 2; ++ai) { EPI_FENCE();
            f32x2 st[4]; u32x4 w[4][2];
#pragma unroll
            for (int m = 0; m < 4; ++m) { const size_t row = EPI_ROW(u, ai, m); st[m] = *(const f32x2*)(gns + row * 32 + head * 8 + fq * 2);
                w[m][0] = *(const u32x4*)(O + row * ODD_MIX + c0); w[m][1] = *(const u32x4*)(O + row * ODD_MIX + c0 + 128); }
            float ga[4], gc[4];
#pragma unroll
            for (int m = 0; m < 4; ++m) {
                const float mean = red_fq(st[m].x) * (1.0f / RET_V), var = red_fq(st[m].y) * (1.0f / RET_V) - mean * mean; ga[m] = fast_rsq(fmaxf(var, 0.f) + EPS); gc[m] = -mean * ga[m]; }
#pragma unroll
            for (int bj = 0; bj < 2; ++bj) { __builtin_amdgcn_sched_barrier(0);
                const int c = c0 + bj * 128, t = t0 + bj * 128;
                const f32x4 G0 = *(const LAS f32x4*)(gt + t), G1 = *(const LAS f32x4*)(gt + t + 4), B0 = *(const LAS f32x4*)(gt + 512 + t), B1 = *(const LAS f32x4*)(gt + 512 + t + 4);
#pragma unroll
                for (int m = 0; m < 4; ++m) { const u32x4 ww = w[m][bj]; const float r = rr[ai * 4 + m];
                    f32x4 o0 = (f32x4){bf_lo(ww.x), bf_hi(ww.x), bf_lo(ww.y), bf_hi(ww.y)}, o1 = (f32x4){bf_lo(ww.z), bf_hi(ww.z), bf_lo(ww.w), bf_hi(ww.w)};
                    o0 = (o0 * ga[m] + gc[m]) * G0 + B0; o1 = (o1 * ga[m] + gc[m]) * G1 + B1;
                    *(u32x4*)(O + (size_t)EPI_ROW(u, ai, m) * ODD_MIX + c) = pack8(silu4(acc[ai][bj][m][0] * r) * o0, silu4(acc[ai][bj][m][1] * r) * o1); }
            }
        }
    }
};
DI void lds_barrier() { asm volatile("s_waitcnt lgkmcnt(0)\n\ts_barrier" ::: "memory"); }
typedef short v4i16_t __attribute__((ext_vector_type(4)));
DI int crow(int r, int hi) { return (r & 3) + 8 * (r >> 2) + 4 * hi; }
#define MFMA32(a, b, c) __builtin_amdgcn_mfma_f32_32x32x16_bf16((a), (b), (c), 0, 0, 0)
#define MFMA16(a, b, c) __builtin_amdgcn_mfma_f32_16x16x32_bf16((a), (b), (c), 0, 0, 0)
constexpr int AT_KP = 208, AT_VP = 144;
constexpr int AT_KB = 64 * AT_KP, AT_VB = 64 * AT_VP;
DI bf16x8 pack_frag(const f32x16& x, int s) {
    u32x4 p; p.x = cvt_pk_bf16(x[8 * s], x[8 * s + 1]); p.y = cvt_pk_bf16(x[8 * s + 2], x[8 * s + 3]); p.z = cvt_pk_bf16(x[8 * s + 4], x[8 * s + 5]); p.w = cvt_pk_bf16(x[8 * s + 6], x[8 * s + 7]);
    return __builtin_bit_cast(bf16x8, p);
}
DI void attn_unit(LAS unsigned char* lds, const bf16_t* QH, const bf16_t* KN, const bf16_t* KR, const bf16_t* VB, bf16_t* MIX, int b, int h, int qb, float shift) {
    const int tid = opaque_tid(), wid = __builtin_amdgcn_readfirstlane(tid >> 6), lane = tid & 63, r32 = lane & 31, hi = lane >> 5;
    const int q0 = qb * 256, ntile = 4 * (qb + 1);
    const size_t rowb = (size_t)b * SEQ;
    LAS unsigned char* Kb = lds; LAS unsigned char* Vb = lds + 2 * AT_KB;
    bf16x8 qf[6];
    { const bf16_t* qp = QH + (rowb + q0 + wid * 32 + r32) * 768 + h * 96 + 8 * hi;
#pragma unroll
      for (int s = 0; s < 6; ++s) qf[s] = *(const bf16x8*)(qp + 16 * s); }
    f32x16 o0, o1;
#pragma unroll
    for (int i = 0; i < 16; ++i) { o0[i] = 0.f; o1[i] = 0.f; }
    float lsum = 0.f;
    const int skey = tid >> 3, sch = tid & 7;
    const int rkey = (tid & 255) >> 2, rch = tid & 3;
    struct Stg { u32x4 k, r, v; };
    Stg RA, RB;
    auto gload = [&](Stg& R, int kt) {
        const size_t row = rowb + (size_t)kt * 64;
        R.k = *(const u32x4*)(KN + (row + skey) * 512 + h * 64 + sch * 8);
        R.v = *(const u32x4*)(VB + (row + skey) * 512 + h * 64 + sch * 8);
        if (tid < 256) R.r = *(const u32x4*)(KR + (row + rkey) * 32 + rch * 8);
    };
    auto swrite = [&](const Stg& R, int buf) {
        *(LAS u32x4*)(Kb + buf * AT_KB + skey * AT_KP + sch * 16) = R.k;
        if (tid < 256) *(LAS u32x4*)(Kb + buf * AT_KB + rkey * AT_KP + 128 + rch * 16) = R.r;
        *(LAS u32x4*)(Vb + buf * AT_VB + skey * AT_VP + sch * 16) = R.v;
    };
    const int qrow = q0 + wid * 32 + r32;
    auto compute = [&](int buf, int kt) {
        const bool active = (64 * kt <= q0 + wid * 32 + 31);
        if (active) {
            const bool needmask = (64 * kt + 63 > q0 + wid * 32);
            const LAS unsigned char* kb = Kb + buf * AT_KB + r32 * AT_KP + 16 * hi;
            const LAS unsigned char* vb = Vb + buf * AT_VB + (4 * hi + ((lane & 15) >> 2)) * AT_VP + (16 * ((lane >> 4) & 1) + 4 * (lane & 3)) * 2;
            bf16x8 kf[12];
#pragma unroll
            for (int s = 0; s < 6; ++s) { kf[2 * s] = *(const LAS bf16x8*)(kb + 32 * s); kf[2 * s + 1] = *(const LAS bf16x8*)(kb + 32 * AT_KP + 32 * s); }
            __builtin_amdgcn_sched_barrier(0);
            f32x16 s0, s1;
#pragma unroll
            for (int i = 0; i < 16; ++i) { s0[i] = -shift; s1[i] = -shift; }
#pragma unroll
            for (int s = 0; s < 6; ++s) { s0 = MFMA32(kf[2 * s], qf[s], s0); s1 = MFMA32(kf[2 * s + 1], qf[s], s1); }
            s16x4 va[4][2], vc[4][2];
#pragma unroll
            for (int f = 0; f < 4; ++f) { const int ko = (32 * (f >> 1) + 16 * (f & 1)) * AT_VP;
                va[f][0] = __builtin_amdgcn_ds_read_tr16_b64_v4i16((LAS v4i16_t*)(vb + ko)); va[f][1] = __builtin_amdgcn_ds_read_tr16_b64_v4i16((LAS v4i16_t*)(vb + ko + 8 * AT_VP));
                vc[f][0] = __builtin_amdgcn_ds_read_tr16_b64_v4i16((LAS v4i16_t*)(vb + ko + 64)); vc[f][1] = __builtin_amdgcn_ds_read_tr16_b64_v4i16((LAS v4i16_t*)(vb + ko + 8 * AT_VP + 64)); }
            __builtin_amdgcn_sched_barrier(0);
#pragma unroll
            for (int i = 0; i < 16; ++i) { s0[i] = fast_exp2(s0[i]); s1[i] = fast_exp2(s1[i]); }
            if (needmask) {
                const int kbase = 64 * kt;
#pragma unroll
                for (int i = 0; i < 16; ++i) { const int kg = kbase + crow(i, hi); if (kg > qrow) s0[i] = 0.f; if (kg + 32 > qrow) s1[i] = 0.f; }
            }
            bf16x8 pf[2][2];
#pragma unroll
            for (int s2 = 0; s2 < 2; ++s2) { pf[0][s2] = pack_frag(s0, s2); pf[1][s2] = pack_frag(s1, s2); }
            { f32x16 t = s0 + s1; lsum += (((t[0] + t[1]) + (t[2] + t[3])) + ((t[4] + t[5]) + (t[6] + t[7]))) + (((t[8] + t[9]) + (t[10] + t[11])) + ((t[12] + t[13]) + (t[14] + t[15]))); }
            __builtin_amdgcn_sched_barrier(0);
#pragma unroll
            for (int f = 0; f < 4; ++f) {
                const bf16x8 v0 = __builtin_shufflevector(va[f][0], va[f][1], 0, 1, 2, 3, 4, 5, 6, 7), v1 = __builtin_shufflevector(vc[f][0], vc[f][1], 0, 1, 2, 3, 4, 5, 6, 7);
                o0 = MFMA32(v0, pf[f >> 1][f & 1], o0); o1 = MFMA32(v1, pf[f >> 1][f & 1], o1);
            }
        }
    };
    gload(RA, 0); gload(RB, 1); swrite(RA, 0); lds_barrier();
    for (int kt = 0; kt < ntile; kt += 2) {
        if (kt + 2 < ntile) gload(RA, kt + 2);
        compute(0, kt);
        swrite(RB, 1);
        lds_barrier();
        if (kt + 3 < ntile) gload(RB, kt + 3);
        compute(1, kt + 1);
        if (kt + 2 < ntile) swrite(RA, 0);
        lds_barrier();
    }
    lsum += __shfl_xor(lsum, 32);
    const float li = 1.0f / lsum;
    bf16_t* op = MIX + (rowb + qrow) * 1024 + 512 + h * 64 + 8 * hi;
    auto store_pair = [&](const f32x16& o, int g, bf16_t* p) {
        u32x2 a = pack4((f32x4){o[4 * g] * li, o[4 * g + 1] * li, o[4 * g + 2] * li, o[4 * g + 3] * li}), c = pack4((f32x4){o[4 * g + 4] * li, o[4 * g + 5] * li, o[4 * g + 6] * li, o[4 * g + 7] * li});
        { const auto r = __builtin_amdgcn_permlane32_swap(a.x, c.x, false, false); a.x = r[0]; c.x = r[1]; }
        { const auto r = __builtin_amdgcn_permlane32_swap(a.y, c.y, false, false); a.y = r[0]; c.y = r[1]; }
        *(u32x4*)(p + 8 * g) = (u32x4){a.x, a.y, c.x, c.y}; };
    store_pair(o0, 0, op); store_pair(o0, 2, op); store_pair(o1, 0, op + 32); store_pair(o1, 2, op + 32);
}

DI void conv_tile(LAS unsigned char* lds, const bf16_t* AB, bf16_t* MIX, const float* cw, const float* cb, const float* lng, const float* lnb, int tile) {
    const int tid = opaque_tid(), wid = tid >> 6, lane = tid & 63;
    const int b = tile >> 7, t0 = (tile & 127) * 32; const size_t rowb = (size_t)b * SEQ;
#pragma unroll
    for (int i = 0; i < 8; ++i) { const int idx = tid + 512 * i;
        if (idx < 62 * 64) { const int r = idx >> 6, ch = idx & 63, tok = t0 - 30 + r; u32x4 v = (u32x4){0u, 0u, 0u, 0u};
            if (tok >= 0) v = *(const u32x4*)(AB + (rowb + tok) * CONV_DIM + ch * 8);
            *(LAS u32x4*)(lds + r * 1024 + ch * 16) = v; } }
    float w[CONV_W];
#pragma unroll
    for (int j = 0; j < CONV_W; ++j) w[j] = cw[j * CONV_DIM + tid];
    const float bias = cb[tid];
    __syncthreads();
    f32x2 xp[31], we[15], wo[15];
#pragma unroll
    for (int r = 0; r < 31; ++r) { xp[r].x = __uint_as_float(((unsigned)*(const LAS unsigned short*)(lds + (2 * r) * 1024 + tid * 2)) << 16); xp[r].y = __uint_as_float(((unsigned)*(const LAS unsigned short*)(lds + (2 * r + 1) * 1024 + tid * 2)) << 16); }
#pragma unroll
    for (int k = 0; k < 15; ++k) { we[k] = (f32x2){w[2 * k], w[2 * k + 1]}; wo[k] = (f32x2){w[2 * k + 1], w[2 * k + 2]}; }
    LAS float* yb = (LAS float*)(lds + 65536);
#pragma unroll
    for (int s = 0; s < 16; ++s) {
        f32x2 ae = (f32x2){bias, 0.f}, ao = (f32x2){bias, 0.f};
#pragma unroll
        for (int k = 0; k < 15; ++k) { ae = __builtin_elementwise_fma(we[k], xp[s + k], ae); ao = __builtin_elementwise_fma(wo[k], xp[s + 1 + k], ao); }
        yb[(2 * s) * CONV_DIM + tid] = (ae.x + ae.y) + w[30] * xp[s + 15].x;
        yb[(2 * s + 1) * CONV_DIM + tid] = (ao.x + ao.y) + w[0] * xp[s].y; }
    __syncthreads();
#pragma unroll
    for (int rr = 0; rr < 4; ++rr) { const int t = wid * 4 + rr;
        const f32x4 a = *(const LAS f32x4*)(yb + t * CONV_DIM + 8 * lane), c = *(const LAS f32x4*)(yb + t * CONV_DIM + 8 * lane + 4);
        const float mean = wave_sum(sum4(a) + sum4(c)) * (1.0f / CONV_DIM);
        const f32x4 da = a - mean, dc = c - mean;
        const float rs = fast_rsq(wave_sum(dot4(da) + dot4(dc)) * (1.0f / CONV_DIM) + EPS);
        const f32x4 ya = da * rs * *(const f32x4*)(lng + 8 * lane) + *(const f32x4*)(lnb + 8 * lane), yc = dc * rs * *(const f32x4*)(lng + 8 * lane + 4) + *(const f32x4*)(lnb + 8 * lane + 4);
        *(u32x4*)(MIX + (rowb + t0 + t) * 1024 + 8 * lane) = pack8(silu4(ya), silu4(yc)); }
    __syncthreads();
}

constexpr int RC = 64;
constexpr int R_SLOT = 32768, R_KO = 16384, R_V = 65536, R_VSZ = 16384, R_P = 98304, R_PP = 144, R_TAB = R_P + RC * R_PP;
static_assert(R_TAB + 4096 <= RING_BYTES, "retention LDS");
DI int r_f(int r) { return ((r & 3) << 1) | (r & 8) | ((r >> 2) & 1); }
DI bf16x8 tr_pair(unsigned a, unsigned a2, int off) {
    u32x2 x, y;
    asm volatile("ds_read_b64_tr_b16 %0, %1 offset:%2" : "=v"(x) : "v"(a), "i"(off) : "memory");
    asm volatile("ds_read_b64_tr_b16 %0, %1 offset:%2" : "=v"(y) : "v"(a2), "i"(off) : "memory");
    u32x4 w; w.x = x.x; w.y = x.y; w.z = y.x; w.w = y.y; return __builtin_bit_cast(bf16x8, w);
}
DI bf16x8 r64_pair(unsigned a, unsigned a2, int off) {
    u32x2 x, y;
    asm volatile("ds_read_b64 %0, %1 offset:%2" : "=v"(x) : "v"(a), "i"(off) : "memory");
    asm volatile("ds_read_b64 %0, %1 offset:%2" : "=v"(y) : "v"(a2), "i"(off) : "memory");
    u32x4 w; w.x = x.x; w.y = x.y; w.z = y.x; w.w = y.y; return __builtin_bit_cast(bf16x8, w);
}
#define R_LGKM2(a, b) asm volatile("s_waitcnt lgkmcnt(0)" : "+v"(a), "+v"(b) :: "memory")
#define R_LGKM8(a, b, c, d, e, f, g_, h_) asm volatile("s_waitcnt lgkmcnt(0)" : "+v"(a), "+v"(b), "+v"(c), "+v"(d), "+v"(e), "+v"(f), "+v"(g_), "+v"(h_) :: "memory")
#define R_LGKM9(a, b, c, d, e, f, g_, h_, i_) asm volatile("s_waitcnt lgkmcnt(0)" : "+v"(a), "+v"(b), "+v"(c), "+v"(d), "+v"(e), "+v"(f), "+v"(g_), "+v"(h_), "+v"(i_) :: "memory")
#define R_WAITV() asm volatile("s_waitcnt vmcnt(0)" ::: "memory")
#define R_PIN(x) asm volatile("" : "+v"(x))
DI void retention_unit(LAS unsigned char* lds, const bf16_t* Q, const bf16_t* Kk, bf16_t* V, float* gns, int b, int h, int vs) {
    const int tid0 = opaque_tid(), wid = __builtin_amdgcn_readfirstlane(tid0 >> 6);
    const float l2g = __builtin_log2f(1.0f - fast_exp2(-5.0f - (float)h));
    const float gC = fast_exp2((float)RC * l2g);
    const size_t rowb = (size_t)b * SEQ;
    const bf16_t* Qh = Q + rowb * 1024 + h * 256; const bf16_t* Kh = Kk + rowb * 1024 + h * 256; bf16_t* Vh = V + rowb * ODD_MIX + h * 512 + vs * 128;
    float* gnh = gns + rowb * 32 + h * 8 + vs * 2;
    const int ib_a = wid & 3, jb_a = 2 * (wid >> 2);
    LAS float* tab = (LAS float*)(lds + R_TAB);
    unsigned aT[8], aT2[8], aV, aV2, aQ[4], aP[4][2];
    { const int lane = tid0 & 63, i16 = lane & 15, g = lane >> 4, fi = r_f(i16);
      const unsigned lb = (unsigned)(uintptr_t)lds;
      const int xq = (g ^ fi) << 4;
      const int xp = (((g >> 1) ^ fi) << 4) | ((g & 1) << 3);
      const int xt = ((((i16 >> 1) & 1) ^ ((i16 >> 2) << 1) ^ ((g & 1) << 3)) << 4) | ((i16 & 1) << 3);
      const int rowtr = (8 * g + (i16 >> 2)) * 256;
#pragma unroll
      for (int t = 0; t < 8; ++t) { aT[t] = lb + rowtr + (xt ^ (32 * t)); aT2[t] = lb + rowtr + 1024 + ((xt ^ (32 * t)) ^ 16); R_PIN(aT[t]); R_PIN(aT2[t]); }
      aV = lb + R_V + rowtr + (xt ^ (32 * wid)); aV2 = lb + R_V + rowtr + 1024 + ((xt ^ (32 * wid)) ^ 16); R_PIN(aV); R_PIN(aV2);
#pragma unroll
      for (int s = 0; s < 4; ++s) { aQ[s] = lb + i16 * 256 + (xq ^ (64 * s)); R_PIN(aQ[s]); aP[s][0] = lb + i16 * 256 + (xp ^ (64 * s)); aP[s][1] = lb + i16 * 256 + (xp ^ (64 * s + 32)); R_PIN(aP[s][0]); R_PIN(aP[s][1]); }
    }
    f32x4 st[16];
#pragma unroll
    for (int t = 0; t < 16; ++t) st[t] = (f32x4){0.f, 0.f, 0.f, 0.f};
    for (int c = 0; c < SEQ / RC; ++c) {
    int tid = tid0; asm volatile("" : "+v"(tid));
    const int lane = tid & 63, i16 = lane & 15, g = lane >> 4;
    auto dma_img = [&](int ldsoff, const bf16_t* src, int pitch) {
#pragma unroll
        for (int i = 0; i < 2; ++i) { const int q = wid + 8 * i, row = 4 * q + g, ch = i16 ^ r_f(row & 15);
            __builtin_amdgcn_global_load_lds((const unsigned*)(src + (size_t)row * pitch + ch * 8), (LAS unsigned*)(lds + ldsoff + q * 1024), 16, 0, 0); }
    };
    auto dma_qk = [&](int slot, int chunk, int half) { dma_img(slot * R_SLOT, Qh + (size_t)chunk * RC * 1024 + half * 128, 1024); dma_img(slot * R_SLOT + R_KO, Kh + (size_t)chunk * RC * 1024 + half * 128, 1024); };
    auto dma_v = [&](int chunk) { dma_img(R_V + (chunk & 1) * R_VSZ, Vh + (size_t)chunk * RC * ODD_MIX, ODD_MIX); };
    auto tab_reduce = [&](int chunk) {
        if (tid < RC) { float s1 = 0.f, s2 = 0.f;
#pragma unroll
            for (int w = 0; w < 8; ++w) { const f32x2 v = *(const LAS f32x2*)(tab + (tid * 8 + w) * 2); s1 += v.x; s2 += v.y; }
            *(f32x2*)(gnh + (size_t)(chunk * RC + tid) * 32) = (f32x2){s1, s2}; }
    };
    if (c == 0) { dma_qk(0, 0, 0); dma_v(0); }
    if (c == 0) R_WAITV(); else asm volatile("s_waitcnt vmcnt(4)" ::: "memory");
    lds_barrier();
    if (c > 0) tab_reduce(c - 1);
    dma_qk(1, c, 1);
    {
        const unsigned vo = (unsigned)((c & 1) * R_VSZ), aVc = aV + vo, aVc2 = aV2 + vo;
        f32x4 sacc[2], oacc[4];
#pragma unroll
        for (int j = 0; j < 2; ++j) sacc[j] = (f32x4){0.f, 0.f, 0.f, 0.f};
#pragma unroll
        for (int j = 0; j < 4; ++j) oacc[j] = (f32x4){0.f, 0.f, 0.f, 0.f};
#pragma unroll
        for (int half = 0; half < 2; ++half) {
            if (half == 1) {
                R_WAITV(); lds_barrier();
                if (c + 1 < SEQ / RC) { dma_qk(0, c + 1, 0); dma_v(c + 1); }
            }
            const int qo = half * R_SLOT, ko = qo + R_KO;
            if (jb_a <= ib_a) { __builtin_amdgcn_sched_barrier(0);
                bf16x8 qn[4], k0[4], k1[4];
#pragma unroll
                for (int s = 0; s < 4; ++s) { qn[s] = *(const LAS bf16x8*)(uintptr_t)(aQ[s] + qo + 16 * ib_a * 256); k0[s] = *(const LAS bf16x8*)(uintptr_t)(aQ[s] + ko + 16 * jb_a * 256);
                    if (jb_a + 1 <= ib_a) k1[s] = *(const LAS bf16x8*)(uintptr_t)(aQ[s] + ko + (16 * jb_a + 16) * 256); }
                __builtin_amdgcn_sched_barrier(0);
#pragma unroll
                for (int s = 0; s < 4; ++s) { sacc[0] = MFMA16(k0[s], qn[s], sacc[0]); if (jb_a + 1 <= ib_a) sacc[1] = MFMA16(k1[s], qn[s], sacc[1]); }
            }
#pragma unroll
            for (int u0 = 0; u0 < 4; u0 += 2) { __builtin_amdgcn_sched_barrier(0);
                bf16x8 qf[2][4];
#pragma unroll
                for (int uu = 0; uu < 2; ++uu)
#pragma unroll
                    for (int i = 0; i < 4; ++i) qf[uu][i] = r64_pair(aP[u0 + uu][0], aP[u0 + uu][1], qo + 16 * i * 256);
                R_LGKM8(qf[0][0], qf[0][1], qf[0][2], qf[0][3], qf[1][0], qf[1][1], qf[1][2], qf[1][3]);
                __builtin_amdgcn_sched_barrier(0);
#pragma unroll
                for (int uu = 0; uu < 2; ++uu) { const int u = u0 + uu;
                    const f32x4 x0 = st[8 * half + 2 * u], x1 = st[8 * half + 2 * u + 1];
                    u32x4 pw; pw.x = cvt_pk_bf16(x0.x, x0.y); pw.y = cvt_pk_bf16(x0.z, x0.w); pw.z = cvt_pk_bf16(x1.x, x1.y); pw.w = cvt_pk_bf16(x1.z, x1.w);
                    const bf16x8 sf = __builtin_bit_cast(bf16x8, pw);
#pragma unroll
                    for (int i = 0; i < 4; ++i) oacc[i] = MFMA16(sf, qf[uu][i], oacc[i]); }
            }
#pragma unroll
            for (int s = 0; s < 2; ++s) { __builtin_amdgcn_sched_barrier(0);
                bf16x8 vf = tr_pair(aVc, aVc2, s * 8192);
                bf16x8 kt[8];
#pragma unroll
                for (int t = 0; t < 8; ++t) kt[t] = tr_pair(aT[t], aT2[t], ko + s * 8192);
                R_LGKM9(vf, kt[0], kt[1], kt[2], kt[3], kt[4], kt[5], kt[6], kt[7]);
                __builtin_amdgcn_sched_barrier(0);
#pragma unroll
                for (int t = 0; t < 8; ++t) st[8 * half + t] = MFMA16(kt[t], vf, st[8 * half + t]); }
            __builtin_amdgcn_sched_barrier(0);
#pragma unroll
            for (int t = 0; t < 8; ++t) st[8 * half + t] = st[8 * half + t] * gC;
        }
#pragma unroll
        for (int jj = 0; jj < 2; ++jj) { const int jb = jb_a + jj;
            f32x4 p = sacc[jj];
            if (jb > ib_a) p = (f32x4){0.f, 0.f, 0.f, 0.f};
            else if (jb == ib_a) {
#pragma unroll
                for (int e = 0; e < 4; ++e) if (4 * g + e > i16) p[e] = 0.f; }
            *(LAS u32x2*)(lds + R_P + (16 * ib_a + i16) * R_PP + (16 * jb + 4 * g) * 2) = pack4(p);
        }
        lds_barrier();
        {
            __builtin_amdgcn_sched_barrier(0);
            bf16x8 v0 = tr_pair(aVc, aVc2, 0), v1 = tr_pair(aVc, aVc2, 8192);
            bf16x8 p0[4], p1[2];
#pragma unroll
            for (int i = 0; i < 4; ++i) p0[i] = *(const LAS bf16x8*)(lds + R_P + (16 * i + i16) * R_PP + 16 * g);
#pragma unroll
            for (int i = 0; i < 2; ++i) p1[i] = *(const LAS bf16x8*)(lds + R_P + (16 * (i + 2) + i16) * R_PP + 64 + 16 * g);
            R_LGKM2(v0, v1);
            __builtin_amdgcn_sched_barrier(0);
#pragma unroll
            for (int i = 0; i < 4; ++i) oacc[i] = MFMA16(v0, p0[i], oacc[i]);
#pragma unroll
            for (int i = 0; i < 2; ++i) oacc[i + 2] = MFMA16(v1, p1[i], oacc[i + 2]);
        }
#pragma unroll
        for (int ib = 0; ib < 4; ++ib) {
            __builtin_amdgcn_sched_barrier(0);
            const f32x4 o = oacc[ib] * fast_exp2((float)(16 * ib + i16 + 1) * l2g);
            *(u32x2*)(Vh + (size_t)(c * RC + 16 * ib + i16) * ODD_MIX + 16 * wid + 4 * g) = pack4(o);
            const float s1 = red_fq(sum4(o)), s2 = red_fq(dot4(o));
            if (g == 0) *(LAS f32x2*)(tab + ((16 * ib + i16) * 8 + wid) * 2) = (f32x2){s1, s2};
        }
    }
    }
    lds_barrier();
    { int tid = tid0; asm volatile("" : "+v"(tid));
      if (tid < RC) { float s1 = 0.f, s2 = 0.f;
#pragma unroll
          for (int w = 0; w < 8; ++w) { const f32x2 v = *(const LAS f32x2*)(tab + (tid * 8 + w) * 2); s1 += v.x; s2 += v.y; }
          *(f32x2*)(gnh + (size_t)((SEQ / RC - 1) * RC + tid) * 32) = (f32x2){s1, s2}; } }
    lds_barrier();
}

enum { MAP_ID = 0, MAP_GU = 1, MAP_E1 = 2, MAP_S2Q = 3, MAP_S2KV = 4 };
template <int MAP> DI int map_src(int n, int& sel) {
    sel = 0;
    if (MAP == MAP_ID) return n;
    const int t = n >> 8, r = n & 255, bj = r >> 7, wc = (r & 127) >> 5, p = r & 31, fq = p >> 3, nn = (p >> 2) & 1, j = p & 3;
    const int rl = 16 * nn + 4 * fq + j;
    if (MAP == MAP_GU) { sel = bj; return t * 128 + (r & 127); }
    if (MAP == MAP_E1) {
        if (t < 4) return (bj ? CONV_DIM : 0) + t * 128 + (r & 127);
        if (t == 4) return 2 * CONV_DIM + r;
        if (r < 128) return 2 * CONV_DIM + QLORA + r;
        if (r < 160) return 2 * CONV_DIM + QLORA + KVLORA + rl;
        return -1;
    }
    const int ws = t * 4 + wc;
    if (MAP == MAP_S2Q) { if (ws < 8) return ws * 96 + 32 * bj + p; return (2 * (ws - 8) + bj) * 96 + 64 + rl; }
      if (ws < 8) return ws * 128 + 32 * bj + p; return (ws - 8) * 128 + 64 + 32 * bj + p;
}
template <int MAP> DI void cvt_matrix(const float* W0, const float* W1, int ldw, int krows, int koff, bf16_t* dst, int ldd, int nrows, const float* gain, float scale, int gw, int NGW, int lane, int& rot) {
    const int nkb = ldd >> 6, nitems = (nrows >> 6) * nkb;
    int first = (gw - rot % NGW + NGW) % NGW; rot += nitems;
    for (int it = first; it < nitems; it += NGW) {
        const int nb = it / nkb, kb = it - nb * nkb, n = nb * 64 + lane; int sel; const int src = map_src<MAP>(n, sel);
        const float* W = sel ? W1 : W0; bf16_t* drow = dst + (size_t)n * ldd + kb * 64;
        float v[64];
#pragma unroll
        for (int i = 0; i < 64; ++i) { const int k = kb * 64 + i - koff; const bool ok = (src >= 0) && (k >= 0) && (k < krows); const int kk = ok ? k : 0;
            const float wv = W[(size_t)kk * ldw + (src >= 0 ? src : 0)]; const float gv = gain ? gain[kk] : 1.0f; v[i] = ok ? wv * gv * scale : 0.f; }
#pragma unroll
        for (int kc = 0; kc < 8; ++kc) { u32x4 o; o.x = cvt_pk_bf16(v[8 * kc], v[8 * kc + 1]); o.y = cvt_pk_bf16(v[8 * kc + 2], v[8 * kc + 3]); o.z = cvt_pk_bf16(v[8 * kc + 4], v[8 * kc + 5]); o.w = cvt_pk_bf16(v[8 * kc + 6], v[8 * kc + 7]);
            *(u32x4*)(drow + kc * 8) = o; }
    }
}

struct Args { const float* in[38]; float* out; unsigned char* ws; };
struct Frame {
    LAS unsigned char* lds; int tid, lane, wave, vcu, G;
    int c, x, j, local; mutable int dir;
};

DI void p0_prologue(const Args& a, const Frame& F) {
    unsigned char* ws = a.ws;
    const int gw = F.vcu * 8 + F.wave, NGW = F.G * 8, lane = F.lane; int rot = 0;
    const size_t DD = (size_t)D * D, DF = (size_t)D * DFF;
    for (int l = 0; l < DEPTH; ++l) {
        bf16_t* wl = (bf16_t*)(ws + WS_W + l * W_LAYER);
        cvt_matrix<MAP_GU>(a.in[4] + l * DF, a.in[5] + l * DF, DFF, D, 0, (bf16_t*)((char*)wl + WO_GU1), D, 2 * DFF, a.in[3] + l * D, 1.0f, gw, NGW, lane, rot);
        cvt_matrix<MAP_ID>(a.in[6] + l * DF, nullptr, D, DFF, 0, (bf16_t*)((char*)wl + WO_D1), DFF, D, nullptr, 0.5f, gw, NGW, lane, rot);
        cvt_matrix<MAP_GU>(a.in[8] + l * DF, a.in[9] + l * DF, DFF, D, 0, (bf16_t*)((char*)wl + WO_GU2), D, 2 * DFF, a.in[7] + l * D, 1.0f, gw, NGW, lane, rot);
        cvt_matrix<MAP_ID>(a.in[10] + l * DF, nullptr, D, DFF, 0, (bf16_t*)((char*)wl + WO_D2), DFF, D, nullptr, 0.5f, gw, NGW, lane, rot);
        cvt_matrix<MAP_ID>(a.in[14] + l * DD, nullptr, D, D, 0, (bf16_t*)((char*)wl + WO_Q), D, D, a.in[12] + l * D, 1.0f, gw, NGW, lane, rot);
        cvt_matrix<MAP_ID>(a.in[17] + l * DD, nullptr, D, D, 0, (bf16_t*)((char*)wl + WO_O), D, D, nullptr, 1.0f, gw, NGW, lane, rot);
        cvt_matrix<MAP_ID>(a.in[15] + l * DD, nullptr, D, D, 0, (bf16_t*)(ws + WS_ACT + A_WK) + l * DD, D, D, a.in[13] + l * D, 1.0f, gw, NGW, lane, rot);
        cvt_matrix<MAP_ID>(a.in[16] + l * DD, nullptr, D, D, 0, (bf16_t*)(ws + WS_ACT + A_WV) + l * DD, D, D, a.in[13] + l * D, 1.0f, gw, NGW, lane, rot);
    }
    for (int e = 0; e < 2; ++e) {
        char* we = (char*)(ws + WS_WE + e * W_EVEN);
        cvt_matrix<MAP_E1>(a.in[20] + (size_t)e * D * EVEN_IN, nullptr, EVEN_IN, D, 0, (bf16_t*)(we + WE_IN), D, EVEN_INP, a.in[11] + (2 * e) * D, 1.0f, gw, NGW, lane, rot);
        cvt_matrix<MAP_S2Q>(a.in[26] + (size_t)e * QLORA * 768, nullptr, 768, QLORA, 0, (bf16_t*)(we + WE_S2), S2K, 768, a.in[25] + e * QLORA, 1.0f, gw, NGW, lane, rot);
        cvt_matrix<MAP_S2KV>(a.in[28] + (size_t)e * KVLORA * 1024, nullptr, 1024, KVLORA, QLORA, (bf16_t*)(we + WE_S2) + (size_t)768 * S2K, S2K, 1024, a.in[27] + e * KVLORA, 1.0f, gw, NGW, lane, rot);
        cvt_matrix<MAP_ID>(a.in[33] + (size_t)e * DD, nullptr, D, D, 0, (bf16_t*)(we + WE_OUT), D, D, nullptr, 1.0f, gw, NGW, lane, rot);
    }
    for (int o = 0; o < 2; ++o) {
        char* wo = (char*)(ws + WS_WO + o * W_ODD);
        cvt_matrix<MAP_ID>(a.in[34] + (size_t)o * D * ODD_IN, nullptr, ODD_IN, D, 0, (bf16_t*)(wo + WOD_IN), D, ODD_IN, a.in[11] + (2 * o + 1) * D, 1.0f, gw, NGW, lane, rot);
        cvt_matrix<MAP_ID>(a.in[37] + (size_t)o * ODD_MIX * D, nullptr, D, ODD_MIX, 0, (bf16_t*)(wo + WOD_OUT), ODD_MIX, D, nullptr, 1.0f, gw, NGW, lane, rot);
    }
    { const float* x = a.in[0]; bf16_t* xb = (bf16_t*)(ws + WS_XB); float* ssq = (float*)(ws + WS_SSQ);
      for (int m0 = gw * 4; m0 < M; m0 += NGW * 4) { f32x4 v[4][4];
#pragma unroll
          for (int r = 0; r < 4; ++r)
#pragma unroll
              for (int j = 0; j < 4; ++j) v[r][j] = ((const f32x4*)(x + (size_t)(m0 + r) * D) + lane)[64 * j];
#pragma unroll
          for (int r = 0; r < 4; ++r) { float s = 0.f;
#pragma unroll
              for (int j = 0; j < 4; ++j) { s += dot4(v[r][j]); *(u32x2*)(xb + (size_t)(m0 + r) * D + 256 * j + 4 * lane) = pack4(v[r][j]); }
              s = wave_sum(s); if (lane < 16) ssq[(size_t)(m0 + r) * 16 + lane] = lane == 0 ? s : 0.f; } } }
    { const float* x = a.in[1]; bf16_t* xb = (bf16_t*)(ws + WS_MEMB); float* rm = (float*)(ws + WS_RMEM);
      for (int m = gw; m < MM; m += NGW) { const f32x4* xr = (const f32x4*)(x + (size_t)m * D) + lane; float s = 0.f;
#pragma unroll
          for (int j = 0; j < 4; ++j) { const f32x4 v = xr[64 * j]; s += dot4(v); *(u32x2*)(xb + (size_t)m * D + 256 * j + 4 * lane) = pack4(v); }
          s = wave_sum(s); if (lane == 0) rm[m] = 1.0f / sqrtf(s * (1.0f / D) + EPS); } }
    if (gw == 0 && lane < 2) { const int e = lane; float mqn = 0.f, mkn = 0.f, mqr = 0.f, mkr = 0.f;
        for (int i = 0; i < QK_NOPE; ++i) { mqn = fmaxf(mqn, fabsf(a.in[29][e * QK_NOPE + i])); mkn = fmaxf(mkn, fabsf(a.in[30][e * QK_NOPE + i])); }
        for (int i = 0; i < QK_ROPE; ++i) { mqr = fmaxf(mqr, fabsf(a.in[31][e * QK_ROPE + i])); mkr = fmaxf(mkr, fabsf(a.in[32][e * QK_ROPE + i])); }
        const float bq = sqrtf(64.f * mqn * mqn + 32.f * mqr * mqr), bk = sqrtf(64.f * mkn * mkn + 32.f * mkr * mkr);
        ((float*)(ws + WS_CTL))[CW_SHE + e] = bq * bk * (LOG2E / sqrtf(96.0f)); }
}
DI void p2_finalize(const Args& a, const Frame& F) {
    unsigned char* ws = a.ws; bf16_t* kp = (bf16_t*)(ws + WS_KP); const float* kss = (const float*)(ws + WS_KSS); unsigned* kmax = (unsigned*)(ws + WS_CTL) + CW_KMAX;
    const int gw = F.vcu * 8 + F.wave, NGW = F.G * 8, lane = F.lane;
    for (int it = gw; it < DEPTH * MM * XH; it += NGW) { const int hh = it & 3, row = it >> 2;
        const float rk = rstd4(kss + (size_t)row * 16 + hh * 4, 1.0f / XHD);
        u32x2* p = (u32x2*)(kp + (size_t)row * D + hh * 256 + 4 * lane); const u32x2 w = *p;
        const u32x2 o = (u32x2){cvt_pk_bf16(bf_lo(w.x) * rk, bf_hi(w.x) * rk), cvt_pk_bf16(bf_lo(w.y) * rk, bf_hi(w.y) * rk)};
        *p = o;
        float s = bf_lo(o.x) * bf_lo(o.x) + bf_hi(o.x) * bf_hi(o.x) + bf_lo(o.y) * bf_lo(o.y) + bf_hi(o.y) * bf_hi(o.y);
        s = wave_sum(s);
        if (lane == 0) { const int l = row / MM, bb = (row % MM) / MEMLEN; __hip_atomic_fetch_max(kmax + l * 64 + bb * 4 + hh, __float_as_uint(sqrtf(s) * 1.0001f), __ATOMIC_RELAXED, __HIP_MEMORY_SCOPE_AGENT); } }
}

#define WSP(T, off) ((T*)(ws + (off)))
#define WS_LOCAL() GAS unsigned char* wsg_ = (GAS unsigned char*)ws_; asm volatile("" : "+s"(wsg_)); unsigned char* ws = (unsigned char*)wsg_
#ifndef SITE
#define SITE 0
#endif
#define SITE_ON(k) (SITE == 0 || SITE == (k))
using pg8::Cfg; using pg8::CfgStd; using pg8::CfgStdRev;
typedef CfgStd<M, 2 * DFF, D, D, D> CfgF1;
typedef CfgStd<M, D, DFF, DFF, DFF> CfgF2;
typedef CfgStd<M, D, D, D, D> CfgDD;
typedef CfgStd<M, EVEN_INP, D, D, D> CfgE1;
typedef CfgStd<M, S2N, S2K, S2K, S2K> CfgE2;
typedef CfgStd<M, 4096, D, D, D> CfgO1;
typedef CfgStd<M, ODD_MIX, D, D, D> CfgO3;
typedef CfgStd<M, D, ODD_MIX, ODD_MIX, ODD_MIX> CfgO4;
typedef Cfg<M / 256, XH, D, D, XHD, -1, 31, 256L * D, 0, 256, 4, 256L * D, 256> CfgXS;
typedef Cfg<NB * 4, XH, D, D, XHD, 3, 31, 256L * D, 0, 256, 2, 256L * D, 256> CfgVW;
typedef Cfg<M / 256, XH, D, D, D, -1, 31, 256L * D, 0, 0, 4, (long)D * D, 256L * D> CfgXF;
typedef Cfg<DEPTH * (MM / 256), XH, D, D, D, 15, 31, 256L * D, 0, 0, 4, (long)D * D, 256L * D> CfgMK;

constexpr size_t SLAB = 64 * MiB; constexpr int XROWS = M / 8;
#define ACTP(off, pitch) ((bf16_t*)(ws + WS_ACT + (size_t)F.x * SLAB + (off) / 8) - (size_t)F.x * XROWS * (pitch))
#define PBAR() do { if (__builtin_amdgcn_readfirstlane((int)bar.st[3])) xcd_local_barrier(bar); else xcd_barrier(bar); } while (0)

DI void ffn_block(const Args& a, const Frame& F, const XcdBarrier& bar, int l, int half, bool final) {
    unsigned char* ws_ = a.ws; const int c = F.c;
#define wgu ((const bf16_t*)(ws + WS_W + l * W_LAYER + (half ? WO_GU2 : WO_GU1)))
#define wd ((const bf16_t*)(ws + WS_W + l * W_LAYER + (half ? WO_D2 : WO_D1)))
    if (SITE_ON(1)) { WS_LOCAL(); pg8::Gemm g{WSP(const bf16_t, WS_XB), wgu};
      const int d = (F.dir ^= 1); constexpr bool tb = true;     auto hk = [&]() { row_tables(F.lds, WSP(const float, WS_SSQ), nullptr, F.x, F.j, d); };
      EpiSwiGLU E{ACTP(A_H, DFF), WSP(const float, WS_SSQ), tb ? (const LAS float*)(F.lds + RT_OFF) : nullptr}; pg8::gemm_phase<CfgF1>(F.lds, g, F.G, c, E, d, hk); }
    PBAR();
    if (SITE_ON(2)) { WS_LOCAL(); pg8::Gemm g{ACTP(A_H, DFF), wd};
      if (final) { EpiResid<true> E{WSP(bf16_t, WS_XB), WSP(float, WS_SSQ), a.out}; pg8::gemm_phase<CfgF2>(F.lds, g, F.G, c, E, (F.dir ^= 1)); }
      else { EpiResid<false> E{WSP(bf16_t, WS_XB), WSP(float, WS_SSQ), a.out}; pg8::gemm_phase<CfgF2>(F.lds, g, F.G, c, E, (F.dir ^= 1)); } }
    PBAR();
}
DI void even_block(const Args& a, const Frame& F, const XcdBarrier& bar, int l) {
    unsigned char* ws_ = a.ws; const int c = F.c, e = l >> 1;
#define pos ((const int*)INP(2))
#define we (ws + WS_WE + e * W_EVEN)
    if (SITE_ON(3)) { WS_LOCAL(); pg8::Gemm g{WSP(const bf16_t, WS_XB), (const bf16_t*)(we + WE_IN)};
      const int d = (F.dir ^= 1); constexpr bool tb = true;     auto hk = [&]() { row_tables(F.lds, WSP(const float, WS_SSQ), pos, F.x, F.j, d); };
      EpiEven1 E{ACTP(A_AB, CONV_DIM), ACTP(A_ZC, S2K), ACTP(A_KR, QK_ROPE), WSP(const float, WS_SSQ), WSP(float, WS_ZS), INP(32) + e * QK_ROPE, pos, tb ? (const LAS float*)(F.lds + RT_OFF) : nullptr, tb ? (const LAS float*)(F.lds + PT_OFF) : nullptr};
      pg8::gemm_phase<CfgE1>(F.lds, g, F.G, c, E, d, hk); }
    PBAR();
    if (SITE_ON(4)) { WS_LOCAL(); pg8::Gemm g{ACTP(A_ZC, S2K), (const bf16_t*)(we + WE_S2)};
      EpiEven2 E{ACTP(A_QH, 768), ACTP(A_KN, 512), ACTP(A_VB, 512), WSP(const float, WS_ZS), INP(29) + e * QK_NOPE, INP(31) + e * QK_ROPE, INP(30) + e * QK_NOPE, pos, LOG2E * 0.10206207261596575f};
      pg8::gemm_phase<CfgE2>(F.lds, g, F.G, c, E, (F.dir ^= 1)); }
    if (SITE_ON(5)) { WS_LOCAL(); for (int q = c; q < M / 32; q += F.G) { const int n = q >> 3;
        conv_tile(F.lds, ACTP(A_AB, CONV_DIM), ACTP(A_MIX, 1024), INP(21) + e * CONV_W * CONV_DIM, INP(22) + e * CONV_DIM, INP(23) + e * CONV_DIM, INP(24) + e * CONV_DIM, F.x * (M / 32 / 8) + n); } }
    PBAR();
    if (SITE_ON(6)) { WS_LOCAL(); const float shift = WSP(const float, WS_CTL)[CW_SHE + e];
      for (int q = c; q < NB * MLA_H * 8; q += F.G) { const int n = q >> 3, b = 2 * F.x + (n >> 6), h = (n >> 3) & 7, pr = n & 7;
          attn_unit(F.lds, ACTP(A_QH, 768), ACTP(A_KN, 512), ACTP(A_KR, QK_ROPE), ACTP(A_VB, 512), ACTP(A_MIX, 1024), b, h, pr, shift);
          attn_unit(F.lds, ACTP(A_QH, 768), ACTP(A_KN, 512), ACTP(A_KR, QK_ROPE), ACTP(A_VB, 512), ACTP(A_MIX, 1024), b, h, 15 - pr, shift); } }
    PBAR();
    if (SITE_ON(7)) { WS_LOCAL(); pg8::Gemm g{ACTP(A_MIX, 1024), (const bf16_t*)(we + WE_OUT)};
      EpiResid<false> E{WSP(bf16_t, WS_XB), WSP(float, WS_SSQ), a.out}; pg8::gemm_phase<CfgDD>(F.lds, g, F.G, c, E, (F.dir ^= 1)); }
    PBAR();
}
DI void odd_block(const Args& a, const Frame& F, const XcdBarrier& bar, int l) {
    unsigned char* ws_ = a.ws; const int c = F.c, o = l >> 1;
#define wo (ws + WS_WO + o * W_ODD)
    if (SITE_ON(8)) { WS_LOCAL(); pg8::Gemm g{WSP(const bf16_t, WS_XB), (const bf16_t*)(wo + WOD_IN)};
      const int d = (F.dir ^= 1); constexpr bool tb = true;     auto hk = [&]() { row_tables(F.lds, WSP(const float, WS_SSQ), pos, F.x, F.j, d); };
      EpiOdd1 E{ACTP(A_RQ, 1024), ACTP(A_RK, 1024), ACTP(A_RV, ODD_MIX), WSP(const float, WS_SSQ), pos, tb ? (const LAS float*)(F.lds + RT_OFF) : nullptr, tb ? (const LAS float*)(F.lds + PT_OFF) : nullptr}; pg8::gemm_phase<CfgO1>(F.lds, g, F.G, c, E, d, hk); }
    PBAR();
    if (SITE_ON(9)) { WS_LOCAL(); for (int q = c; q < NB * RET_H * 4; q += F.G) { const int n = q >> 3;
        retention_unit(F.lds, ACTP(A_RQ, 1024), ACTP(A_RK, 1024), ACTP(A_RV, ODD_MIX), WSP(float, WS_GNS), 2 * F.x + (n >> 4), (n >> 2) & 3, n & 3); } }
    PBAR();
    if (SITE_ON(10)) { WS_LOCAL(); pg8::Gemm g{WSP(const bf16_t, WS_XB), (const bf16_t*)(wo + WOD_IN) + (size_t)4096 * D};
      const int d = (F.dir ^= 1);
      auto hk = [&]() { { const int t = opaque_tid(); const int gcol = ((F.j >> 3) + 4 * (t >> 8)) * 256 + (t & 255); LAS float* gt = (LAS float*)(F.lds + PT_OFF);
                          gt[t] = (INP(35) + o * ODD_MIX)[gcol]; gt[512 + t] = (INP(36) + o * ODD_MIX)[gcol]; }
                        row_tables(F.lds, WSP(const float, WS_SSQ), nullptr, F.x, F.j, d); };
      EpiGate E{ACTP(A_RV, ODD_MIX), WSP(const float, WS_GNS), (const LAS float*)(F.lds + RT_OFF), (const LAS float*)(F.lds + PT_OFF)}; pg8::gemm_phase<CfgO3>(F.lds, g, F.G, c, E, d, hk); }
    PBAR();
    if (SITE_ON(11)) { WS_LOCAL(); pg8::Gemm g{ACTP(A_RV, ODD_MIX), (const bf16_t*)(wo + WOD_OUT)};
      EpiResid<false> E{WSP(bf16_t, WS_XB), WSP(float, WS_SSQ), a.out}; pg8::gemm_phase<CfgO4>(F.lds, g, F.G, c, E, (F.dir ^= 1)); }
    PBAR();
}
DI void xattn_block(const Args& a, const Frame& F, const XcdBarrier& bar, int l) {
    unsigned char* ws_ = a.ws; const int c = F.c;
#define wl (ws + WS_W + l * W_LAYER)
    if (SITE_ON(12)) { WS_LOCAL(); pg8::Gemm g{WSP(const bf16_t, WS_XB), (const bf16_t*)(wl + WO_Q)};
      const int d = (F.dir ^= 1); constexpr bool tb = true;     auto hk = [&]() { row_tables(F.lds, WSP(const float, WS_SSQ), nullptr, F.x, F.j, d); };
      EpiQraw E{ACTP(A_XQ, 1024), WSP(const float, WS_SSQ), WSP(float, WS_QSS), tb ? (const LAS float*)(F.lds + RT_OFF) : nullptr}; pg8::gemm_phase<CfgDD>(F.lds, g, F.G, c, E, d, hk); }
    if (SITE_ON(14)) { WS_LOCAL(); pg8::Gemm g{(const bf16_t*)(wl + WO_O), WSP(const bf16_t, WS_VT) + (size_t)l * MM * D};
      EpiVW E{WSP(bf16_t, WS_VW)}; pg8::gemm_phase<CfgVW>(F.lds, g, F.G, c, E, 0); }
    cu_local_seam();
    if (SITE_ON(13)) { WS_LOCAL(); pg8::Gemm g{ACTP(A_XQ, 1024), WSP(const bf16_t, WS_KP) + (size_t)l * MM * D};
      auto hk = [&]() { score_tables(F.lds, WSP(const float, WS_QSS), WSP(const unsigned, WS_CTL) + CW_KMAX + l * 64, F.x, F.j, F.dir); };
      EpiScoresN E{ACTP(A_XP, 1024), (const LAS float*)(F.lds + RT_OFF), (LAS float*)(F.lds + RING_BYTES)}; pg8::gemm_phase<CfgXS>(F.lds, g, F.G, c, E, F.dir, hk); }
    PBAR();
    if (SITE_ON(15)) { WS_LOCAL(); pg8::Gemm g{ACTP(A_XP, 1024), WSP(const bf16_t, WS_VW)};
      EpiResid<false> E{WSP(bf16_t, WS_XB), WSP(float, WS_SSQ), a.out}; pg8::gemm_phase<CfgXF>(F.lds, g, F.G, c, E, (F.dir ^= 1)); }
    PBAR();
}

__global__ void __launch_bounds__(512, 2) fwd_kernel(Args a) {
    extern __shared__ __attribute__((aligned(16))) unsigned char lds_raw[];
    Frame F; F.lds = (LAS unsigned char*)lds_raw; F.tid = threadIdx.x; F.lane = F.tid & 63; F.wave = __builtin_amdgcn_readfirstlane(F.tid >> 6);
    F.G = gridDim.x; { const int bx = blockIdx.x; F.vcu = (F.G % 8 == 0) ? (bx % 8) * (F.G / 8) + bx / 8 : bx; }
    F.c = blockIdx.x; F.x = 0; F.j = 0; F.local = 0; F.dir = 1;
    unsigned char* ws_ = a.ws; unsigned char* ws = ws_;
    if (F.tid < 64) ((LAS unsigned*)(F.lds + LDSCTL_OFF))[F.tid] = 0u;
    if (F.tid < 38) ((const float**)(ws + WS_CTL + CW_TAB * 4))[F.tid] = a.in[F.tid];
    __syncthreads();
    const XcdBarrier bar = xcd_barrier_post(WSP(unsigned, WS_CTL) + CW_BAR, (volatile LAS unsigned*)(F.lds + LDSCTL_OFF));
    if (SITE_ON(16)) p0_prologue(a, F);
    xcd_barrier(bar);
    if (SITE_ON(17)) { WS_LOCAL(); pg8::Gemm g{WSP(const bf16_t, WS_MEMB), WSP(const bf16_t, WS_ACT + A_WK)};
      EpiMemK E{WSP(bf16_t, WS_KP), WSP(const float, WS_RMEM), WSP(float, WS_KSS), INP(19), INP(18)}; pg8::gemm_phase<CfgMK>(F.lds, g, F.G, blockIdx.x, E); }
    if (SITE_ON(18)) { WS_LOCAL(); pg8::Gemm g{WSP(const bf16_t, WS_MEMB), WSP(const bf16_t, WS_ACT + A_WV)};
      EpiMemV E{WSP(bf16_t, WS_VT), WSP(const float, WS_RMEM)}; pg8::gemm_phase<CfgMK>(F.lds, g, F.G, blockIdx.x, E); }
    xcd_barrier(bar);
    if (SITE_ON(19)) p2_finalize(a, F);
    { volatile LAS unsigned* st = (volatile LAS unsigned*)(F.lds + LDSCTL_OFF);
      if (F.tid == 0) { unsigned ok = (F.G % 8 == 0) ? 1u : 0u; unsigned* bw = WSP(unsigned, WS_CTL) + CW_BAR;
#pragma unroll
          for (unsigned jx = 0; jx < 16; ++jx) { const unsigned cnt = xb_ld(&bw[XB_XCNT(jx)]); ok &= (jx < 8u) ? (cnt == (unsigned)F.G / 8u) : (cnt == 0u); }
          ok &= (xb_ld(&bw[XB_TMO]) == 0u) ? 1u : 0u;
          st[3] = ok; st[4] = 0u; }
      __syncthreads();
      if (st[3] != 0u) { F.local = 1; F.x = (int)bar.x; F.j = (int)st[2]; F.c = 8 * F.j + F.x; }
      else { F.local = 0; F.c = blockIdx.x; F.x = F.c & 7; F.j = F.c >> 3; }
      F.x = __builtin_amdgcn_readfirstlane(F.x); F.j = __builtin_amdgcn_readfirstlane(F.j); F.c = __builtin_amdgcn_readfirstlane(F.c); F.local = __builtin_amdgcn_readfirstlane(F.local); }
    xcd_barrier(bar);
    for (int l = 0; l < DEPTH; ++l) {
        ffn_block(a, F, bar, l, 0, false);
        if (l & 1) odd_block(a, F, bar, l); else even_block(a, F, bar, l);
        xattn_block(a, F, bar, l);
        ffn_block(a, F, bar, l, 1, l == DEPTH - 1);
    }
}

extern "C" void kernel_launch(void* const* d_in, const int* in_sizes, int n_in, void* d_out, int out_size, void* d_ws, size_t ws_size, hipStream_t stream) {
    static int grid = 0;
    if (grid == 0) {
        if (n_in != 38 || out_size != M * D || ws_size < WS_END) { fprintf(stderr, "kernel_launch: unexpected problem (n_in %d, out %d, ws %zu < %zu)\n", n_in, out_size, ws_size, (size_t)WS_END); grid = -1; return; }
        int dev = 0, cus = 0, per_cu = 0;
        if (hipGetDevice(&dev) != hipSuccess || hipDeviceGetAttribute(&cus, hipDeviceAttributeMultiprocessorCount, dev) != hipSuccess) { grid = -1; return; }
        if (cus != 256) { fprintf(stderr, "kernel_launch: this build needs 256 compute units (one workgroup each; the per-phase row tables assume it), found %d\n", cus); grid = -1; return; }
        if (hipFuncSetAttribute((const void*)fwd_kernel, hipFuncAttributeMaxDynamicSharedMemorySize, LDS_BYTES) != hipSuccess) { fprintf(stderr, "kernel_launch: hipFuncSetAttribute failed\n"); grid = -1; return; }
        if (hipOccupancyMaxActiveBlocksPerMultiprocessor(&per_cu, (const void*)fwd_kernel, 512, LDS_BYTES) != hipSuccess || per_cu < 1) fprintf(stderr, "kernel_launch: occupancy query reports %d blocks per CU\n", per_cu);
        (void)hipGetLastError();
        grid = cus;
    }
    if (grid < 0) return;
    if (hipMemsetAsync((char*)d_ws + WS_CTL, 0, CTL_ZERO_BYTES, stream) != hipSuccess) return;
    Args a{};
    for (int i = 0; i < 38; ++i) a.in[i] = (const float*)d_in[i];
    a.out = (float*)d_out; a.ws = (unsigned char*)d_ws;
    hipLaunchKernelGGL(fwd_kernel, dim3(grid), dim3(512), LDS_BYTES, stream, a);
}
```

```cpp
#include <hip/hip_runtime.h>
#include <cstdio>
#include <cstdint>

#define LAS __attribute__((address_space(3)))
#define GAS __attribute__((address_space(1)))
typedef unsigned short bf16_t;
typedef short bf16x8 __attribute__((ext_vector_type(8)));
typedef short s16x4 __attribute__((ext_vector_type(4)));
typedef float f32x4 __attribute__((ext_vector_type(4)));
typedef float f32x2 __attribute__((ext_vector_type(2)));
typedef float f32x16 __attribute__((ext_vector_type(16)));
typedef unsigned u32x4 __attribute__((ext_vector_type(4)));
typedef unsigned u32x2 __attribute__((ext_vector_type(2)));
#define DI __device__ __forceinline__

constexpr int D = 1024, NB = 16, SEQ = 4096, DEPTH = 4, MEMLEN = 256, DFF = 2816;
constexpr int M = NB * SEQ;
constexpr int MM = NB * MEMLEN;
constexpr float EPS = 1e-6f;
constexpr float LOG2E = 1.4426950408889634f;
constexpr int CONV_DIM = 512, CONV_W = 31, MLA_H = 8, QLORA = 256, KVLORA = 128, QK_NOPE = 64, QK_ROPE = 32, VHEAD = 64;
constexpr int EVEN_IN = 1440, EVEN_INP = 1536, S2N = 1792, S2K = 384;
constexpr int RET_H = 4, RET_QK = 256, RET_V = 512, RET_C = 128, ODD_MIX = 2048, ODD_IN = 6144;
constexpr int XH = 4, XHD = 256;

DI int opaque_tid() { int t = threadIdx.x; asm volatile("" : "+v"(t)); return t; }
DI unsigned cvt_pk_bf16(float lo, float hi) { unsigned r; asm volatile("v_cvt_pk_bf16_f32 %0, %1, %2" : "=v"(r) : "v"(lo), "v"(hi)); return r; }
DI float bf_lo(unsigned w) { return __uint_as_float(w << 16); }
DI float bf_hi(unsigned w) { return __uint_as_float(w & 0xffff0000u); }
DI float fast_exp2(float x) { return __builtin_amdgcn_exp2f(x); }
DI float fast_rcp(float x) { return __builtin_amdgcn_rcpf(x); }
DI float fast_rsq(float x) { return __builtin_amdgcn_rsqf(x); }
DI float sigmoidf_(float x) { return fast_rcp(1.0f + fast_exp2(-x * LOG2E)); }
DI float wave_sum(float v) {
#pragma unroll
    for (int o = 1; o < 64; o <<= 1) v += __shfl_xor(v, o);
    return v;
}
DI void sincos_turns(float ang, float& s, float& c) {
    float t = ang * 0.15915494309189535f; t = t - rintf(t);
    s = __builtin_amdgcn_sinf(t); c = __builtin_amdgcn_cosf(t);
}

namespace pg8 {
constexpr int BM = 256, BK = 64, HALF = 128, HTB = HALF * BK * 2, STAGE_BYTES = 8 * HTB, NXCD = 8, WGM = 8;
__host__ __device__ __forceinline__ int lds_byte(int r, int c) { const int st = (r >> 4) * 2 + (c >> 5), rr = r & 15, cc = c & 31, ob = rr * 64 + cc * 2; return st * 1024 + (ob ^ (((ob >> 9) & 1) << 5)); }
__host__ __device__ __forceinline__ void stage_rc(int b, int& R, int& C) { const int st = b / 1024, sb = b % 1024, swz = sb ^ (((sb >> 9) & 1) << 5); R = (st >> 1) * 16 + swz / 64; C = (st & 1) * 32 + (swz % 64) / 2; }
__host__ __device__ __forceinline__ int perm32(int rho) { const int n = rho >> 4, i = rho & 15; return 8 * (i >> 2) + 4 * n + (i & 3); }

struct Unit { int pm, pn; long aoff, boff; };
struct Gemm { const bf16_t* A; const bf16_t* Bt; };

template <int NM_, int NN_, int LDA_, int LDB_, int K_, int AMASK_, int ASH_, long A_PM_, long A_HI_, long A_PN_, int BSH_, long B_HI_, long B_PN_, bool REV_ = false>
struct Cfg { static constexpr int NM = NM_, NN = NN_, LDA = LDA_, LDB = LDB_, K = K_, AMASK = AMASK_, ASH = ASH_, BSH = BSH_; static constexpr long A_PM = A_PM_, A_HI = A_HI_, A_PN = A_PN_, B_HI = B_HI_, B_PN = B_PN_; static constexpr bool REV = REV_; };
template <int MROWS, int NCOLS, int LDA_, int LDB_, int K_> using CfgStd = Cfg<MROWS / 256, NCOLS / 256, LDA_, LDB_, K_, -1, 31, 256L * LDA_, 0, 0, 31, 0, 256L * LDB_>;
template <int MROWS, int NCOLS, int LDA_, int LDB_, int K_> using CfgStdRev = Cfg<MROWS / 256, NCOLS / 256, LDA_, LDB_, K_, -1, 31, 256L * LDA_, 0, 0, 31, 0, 256L * LDB_, true>;

template <class C> struct Order {
    int G, c, rev;
    DI bool next(int i, Unit& u) const {
        constexpr int nM = C::NM, nN = C::NN, nwg = nM * nN;
        const int L = i * G + c; if (L >= nwg) return false;
        int wgid = L; { constexpr int q = nwg / NXCD, r = nwg % NXCD; const int xcd = wgid % NXCD, off = wgid / NXCD; wgid = (xcd < r ? xcd * (q + 1) : r * (q + 1) + (xcd - r) * q) + off; }
        constexpr int nig = WGM * nN; const int gid = wgid / nig, fm = gid * WGM, gsz = (nM - fm) < WGM ? (nM - fm) : WGM;
        u.pm = fm + ((wgid % nig) % gsz); u.pn = (wgid % nig) / gsz;
        if constexpr (nM % NXCD == 0 && nwg % NXCD == 0) { if (rev) { constexpr int P = nM / NXCD; const int x = u.pm / P; u.pm = x * P + (P - 1 - (u.pm - x * P)); } }
        u.aoff = (long)(u.pm & C::AMASK) * C::A_PM + (long)(u.pm >> C::ASH) * C::A_HI + (long)u.pn * C::A_PN;
        u.boff = (long)(u.pm >> C::BSH) * C::B_HI + (long)u.pn * C::B_PN;
        return true;
    }
};

template <class E, class = void> struct EpiNst { static constexpr int value = 0; };
template <class E> struct EpiNst<E, decltype((void)E::NST)> { static constexpr int value = E::NST; };
template <int N> DI void pg8_waitv() { asm volatile("s_waitcnt vmcnt(%0)" :: "n"(N) : "memory"); }
struct NoHook { DI void operator()() const {} };
template <class C, class Epi, class Hook = NoHook>
DI void gemm_phase(LAS unsigned char* lds, const Gemm g, const int G_, const int c_, const Epi& E, const int rev_ = 0, const Hook& hk = Hook()) {
    int cq = c_; asm volatile("" : "+s"(cq));
    Order<C> S; S.G = G_; S.c = cq; S.rev = rev_;
    const int tid = opaque_tid(), wid = __builtin_amdgcn_readfirstlane(tid >> 6), lane = tid & 63, wr = wid >> 2, wc = wid & 3, fr = lane & 15, fq = lane >> 4;
    constexpr int K = C::K, nt = K / BK; static_assert(K % 128 == 0 && K >= 256, "K");
    unsigned voffA[2], voffB[2];
#pragma unroll
    for (int i = 0; i < 2; ++i) { int R, Cc; stage_rc(tid * 16 + i * 8192, R, Cc); const int Rb = Epi::PERM ? ((R & ~31) + perm32(R & 31)) : R;
        voffA[i] = (unsigned)(R * C::LDA + Cc) * 2u; voffB[i] = (unsigned)(Rb * C::LDB + Cc) * 2u; }
    constexpr size_t kstep = (size_t)(BK * 2);
    constexpr size_t hstepA = (size_t)HALF * C::LDA * 2, hstepB = (size_t)HALF * C::LDB * 2;
    const unsigned ldsw = (unsigned)wid * 1024u;
    const int aoff = lds_byte(wr * 64 + fr, fq * 8), boff = lds_byte(wc * 32 + fr, fq * 8);
#define PG8_SA(b, h) (((b) * 2 + (h)) * HTB)
#define PG8_SB(b, h) ((4 + (b) * 2 + (h)) * HTB)
#define PG8_STAGE(bufoff, gbase, voff) do { _Pragma("unroll") for (int _i = 0; _i < 2; ++_i) \
        __builtin_amdgcn_global_load_lds((const unsigned*)((const char*)(gbase) + (voff)[_i]), (LAS unsigned*)(lds + (bufoff) + ldsw + _i * 8192), 16, 0, 0); } while (0)
#define PG8_LDA(dst, b, h) do { _Pragma("unroll") for (int m = 0; m < 4; ++m) _Pragma("unroll") for (int k = 0; k < 2; ++k) dst[m][k] = *(const LAS bf16x8*)(lds + PG8_SA(b, h) + aoff + m * 2048 + k * 1024); } while (0)
#define PG8_LDB(dst, b, h) do { _Pragma("unroll") for (int n = 0; n < 2; ++n) _Pragma("unroll") for (int k = 0; k < 2; ++k) dst[n][k] = *(const LAS bf16x8*)(lds + PG8_SB(b, h) + boff + n * 2048 + k * 1024); } while (0)
#define PG8_MMA(ai, bj, At, Bt) do { __builtin_amdgcn_s_setprio(1); _Pragma("unroll") for (int m = 0; m < 4; ++m) _Pragma("unroll") for (int n = 0; n < 2; ++n) _Pragma("unroll") for (int k = 0; k < 2; ++k) \
        acc[ai][bj][m][n] = __builtin_amdgcn_mfma_f32_16x16x32_bf16(Bt[n][k], At[m][k], acc[ai][bj][m][n], 0, 0, 0); __builtin_amdgcn_s_setprio(0); } while (0)
#define PG8_WAIT_V(n) asm volatile("s_waitcnt vmcnt(" #n ")" ::: "memory")
#define PG8_WAIT_L(n) asm volatile("s_waitcnt lgkmcnt(" #n ")" ::: "memory")
#define PG8_BAR __builtin_amdgcn_s_barrier()
#define PG8_SCHED __builtin_amdgcn_sched_barrier(0)
    Unit cur, nxt; int ui = 0; bool after_epi = false;
    if (!S.next(0, cur)) return;
    f32x4 acc[2][2][4][2];
#pragma unroll
    for (int a = 0; a < 2; ++a)
#pragma unroll
        for (int b = 0; b < 2; ++b)
#pragma unroll
            for (int m = 0; m < 4; ++m)
#pragma unroll
                for (int n = 0; n < 2; ++n) acc[a][b][m][n] = (f32x4){0.f, 0.f, 0.f, 0.f};
    bf16x8 At[4][2], B0[2][2], B1[2][2];
    const char* cA = (const char*)(g.A + cur.aoff); const char* cB = (const char*)(g.Bt + cur.boff);
    PG8_STAGE(PG8_SB(0, 0), cB, voffB); PG8_STAGE(PG8_SB(0, 1), cB + hstepB, voffB); PG8_STAGE(PG8_SA(0, 0), cA, voffA); PG8_STAGE(PG8_SA(0, 1), cA + hstepA, voffA);
    hk();
    if (wr == 1) PG8_BAR;
    PG8_WAIT_V(2); PG8_BAR;
    PG8_STAGE(PG8_SB(1, 0), cB + kstep, voffB); PG8_STAGE(PG8_SA(1, 0), cA + kstep, voffA); PG8_STAGE(PG8_SB(1, 1), cB + hstepB + kstep, voffB);
    PG8_WAIT_V(6); PG8_BAR;
    for (;;) {
        const bool has_next = S.next(ui + 1, nxt);
        constexpr int NST = EpiNst<Epi>::value;
        const char* nA = has_next ? (const char*)(g.A + nxt.aoff) : cA; const char* nB = has_next ? (const char*)(g.Bt + nxt.boff) : cB;
#pragma nounroll
        for (int t = 0; t < nt; t += 2) {
            const bool last = (t == nt - 2); const bool fst = (NST > 0) && after_epi && (t == 0);
            const char* a1 = cA + (size_t)(t + 1) * kstep;
            const char* a2 = last ? nA : cA + (size_t)(t + 2) * kstep; const char* b2 = last ? nB : cB + (size_t)(t + 2) * kstep;
            const char* a3 = a2 + kstep; const char* b3 = b2 + kstep;
            PG8_LDB(B0, 0, 0); PG8_LDB(B1, 0, 1); PG8_SCHED; PG8_LDA(At, 0, 0); PG8_STAGE(PG8_SA(1, 1), a1 + hstepA, voffA);
            if (fst) pg8_waitv<8 + NST>(); else PG8_WAIT_V(8);
            PG8_WAIT_L(0); PG8_BAR; PG8_MMA(0, 0, At, B0); PG8_MMA(0, 1, At, B1); PG8_BAR; PG8_SCHED;
            PG8_LDA(At, 0, 1); PG8_STAGE(PG8_SB(0, 0), b2, voffB); PG8_STAGE(PG8_SB(0, 1), b2 + hstepB, voffB); PG8_STAGE(PG8_SA(0, 0), a2, voffA);
            if (fst) pg8_waitv<8 + NST>(); else PG8_WAIT_V(8);
            PG8_WAIT_L(0); PG8_BAR; PG8_MMA(1, 0, At, B0); PG8_MMA(1, 1, At, B1); PG8_BAR; PG8_SCHED;
            PG8_LDB(B0, 1, 0); PG8_LDB(B1, 1, 1); PG8_SCHED; PG8_LDA(At, 1, 0); PG8_STAGE(PG8_SA(0, 1), a2 + hstepA, voffA);
            PG8_WAIT_V(8); PG8_WAIT_L(0); PG8_BAR; PG8_MMA(0, 0, At, B0); PG8_MMA(0, 1, At, B1); PG8_BAR; PG8_SCHED;
            PG8_LDA(At, 1, 1); PG8_STAGE(PG8_SB(1, 0), b3, voffB); PG8_STAGE(PG8_SB(1, 1), b3 + hstepB, voffB); PG8_STAGE(PG8_SA(1, 0), a3, voffA);
            PG8_WAIT_V(8); PG8_WAIT_L(0); PG8_BAR; PG8_MMA(1, 0, At, B0); PG8_MMA(1, 1, At, B1); PG8_BAR; PG8_SCHED;
        }
        if (wr == 0) PG8_BAR;
        E(acc, cur, wr, wc, fr, fq);
        if (!has_next) break;
#pragma unroll
        for (int a = 0; a < 2; ++a)
#pragma unroll
            for (int b = 0; b < 2; ++b)
#pragma unroll
                for (int m = 0; m < 4; ++m)
#pragma unroll
                    for (int n = 0; n < 2; ++n) acc[a][b][m][n] = (f32x4){0.f, 0.f, 0.f, 0.f};
        cur = nxt; cA = nA; cB = nB; ++ui; after_epi = true;
        if (wr == 1) PG8_BAR;
    }
    PG8_WAIT_V(0);
    PG8_BAR;
#undef PG8_SA
#undef PG8_SB
#undef PG8_STAGE
#undef PG8_LDA
#undef PG8_LDB
#undef PG8_MMA
#undef PG8_WAIT_V
#undef PG8_WAIT_L
#undef PG8_BAR
#undef PG8_SCHED
}
}
using pg8::Unit;

constexpr size_t MiB = 1u << 20;
constexpr size_t WS_CTL = 0, CTL_ZERO_BYTES = 1 * MiB;
constexpr size_t WS_SSQ = 1 * MiB;
constexpr size_t WS_QSS = 5 * MiB;
constexpr size_t WS_LS = 9 * MiB;
constexpr size_t WS_ZS = 13 * MiB;
constexpr size_t WS_GNS = 15 * MiB;
constexpr size_t WS_KSS = 23 * MiB;
constexpr size_t WS_RMEM = 24 * MiB;
constexpr size_t WS_MEMB = 25 * MiB;
constexpr size_t WS_KP = 33 * MiB;
constexpr size_t WS_VT = 65 * MiB;
constexpr size_t WS_W = 97 * MiB;
constexpr size_t W_LAYER = 37 * MiB;
constexpr size_t WO_GU1 = 0, WO_D1 = 11 * MiB, WO_GU2 = 16 * MiB + MiB / 2, WO_D2 = 27 * MiB + MiB / 2, WO_Q = 33 * MiB, WO_O = 35 * MiB;
constexpr size_t WS_WE = WS_W + 4 * W_LAYER;
constexpr size_t W_EVEN = 6 * MiB + MiB / 2, WE_IN = 0, WE_S2 = 3 * MiB, WE_OUT = 4 * MiB + MiB / 2;
constexpr size_t WS_WO = WS_WE + 2 * W_EVEN;
constexpr size_t W_ODD = 16 * MiB, WOD_IN = 0, WOD_OUT = 12 * MiB;
constexpr size_t WS_XB = WS_WO + 2 * W_ODD;
constexpr size_t WS_ACT = WS_XB + 128 * MiB;
constexpr size_t WS_VW = WS_ACT + 512 * MiB;
constexpr size_t WS_END = WS_VW + 32 * MiB;
static_assert(WS_XB == 290 * MiB && WS_END == 962 * MiB, "ws map");
constexpr size_t A_H = 0;
constexpr size_t A_AB = 0, A_ZC = 64 * MiB, A_KR = 112 * MiB, A_QH = 116 * MiB, A_KN = 212 * MiB, A_VB = 276 * MiB, A_MIX = 340 * MiB;
constexpr size_t A_RQ = 0, A_RK = 128 * MiB, A_RV = 256 * MiB;
constexpr size_t A_XQ = 0, A_XP = 128 * MiB, A_XO = 256 * MiB;
constexpr size_t A_WK = 0, A_WV = 8 * MiB;
constexpr int CW_BAR = 4096;
constexpr int CW_KMAX = 16384;
constexpr int CW_SHE = 16384 + 512;
constexpr int CW_TAB = 32768;
DI const float* inp_ptr(const unsigned char* ws, int i) {
    const unsigned long long v = ((const unsigned long long*)(ws + WS_CTL + CW_TAB * 4))[i];
    const unsigned lo = __builtin_amdgcn_readfirstlane((unsigned)v), hi = __builtin_amdgcn_readfirstlane((unsigned)(v >> 32));
    return (const float*)(GAS const float*)(((unsigned long long)hi << 32) | lo); }
#define INP(i) inp_ptr(ws, (i))

constexpr int RING_BYTES = 131072;
constexpr int LDSCTL_OFF = RING_BYTES + 16384;
constexpr int LDS_BYTES = LDSCTL_OFF + 256;
static_assert(LDS_BYTES <= 160 * 1024 && LDS_BYTES > 80 * 1024, "LDS");

#define XB_TMO      128
#define XB_XCNT(j)  (256  + 64 * (j))
#define XB_XSUB(j)  (1280 + 64 * (j))
#define XB_XGEN(j)  (2304 + 64 * (j))
#define XB_TOP      3328
#define XB_TOPGEN   3392
#define XCD_BAR_WORDS 3456
#define XB_SPIN_CAP (1u << 22)
DI unsigned xb_ld(unsigned* p)              { return __hip_atomic_load(p, __ATOMIC_RELAXED, __HIP_MEMORY_SCOPE_AGENT); }
DI unsigned xb_add(unsigned* p, unsigned v) { return __hip_atomic_fetch_add(p, v, __ATOMIC_RELAXED, __HIP_MEMORY_SCOPE_AGENT); }
DI unsigned xb_xcc_id() { return (unsigned)__builtin_amdgcn_s_getreg((3 << 11) | 20) & 0xFu; }
#define XB_SPIN(cond, bar) do { unsigned _sp = 0; while (cond) { __builtin_amdgcn_s_sleep(1); \
    if ((++_sp & 255u) == 0u) { if (xb_ld(&(bar)[XB_TMO])) break; if (_sp > XB_SPIN_CAP) { atomicAdd(&(bar)[XB_TMO], 1u); break; } } } } while (0)
struct XcdBarrier { unsigned* bar; unsigned x; volatile LAS unsigned* st; };
DI XcdBarrier xcd_barrier_post(unsigned* bar, volatile LAS unsigned* st) {
    XcdBarrier b; b.bar = bar; b.x = xb_xcc_id(); b.st = st;
    if (threadIdx.x == 0) st[2] = xb_add(&bar[XB_XCNT(b.x)], 1u);
    return b;
}
#define XL_SUB(j)   (XCD_BAR_WORDS + 64 * (j))
#define XL_GEN(j)   (XCD_BAR_WORDS + 1024 + 64 * (j))
DI void xcd_local_barrier(const XcdBarrier& b) {
    asm volatile("s_waitcnt vmcnt(0)" ::: "memory");
    __syncthreads();
    if (threadIdx.x == 0) {
        unsigned* bar = b.bar;
        unsigned bx = b.x; asm volatile("" : "+s"(bx));
        __builtin_amdgcn_s_waitcnt(0);
        const unsigned target = b.st[4] + b.st[0]; b.st[4] = target;
        (void)__hip_atomic_fetch_add(&bar[XL_SUB(bx)], 1u, __ATOMIC_RELAXED, __HIP_MEMORY_SCOPE_AGENT);
        XB_SPIN(xb_ld(&bar[XL_SUB(bx)]) < target, bar);
        __builtin_amdgcn_fence(__ATOMIC_ACQUIRE, "agent");
        asm volatile("s_waitcnt vmcnt(0)" ::: "memory");
    }
    __syncthreads();
}
DI void cu_local_seam() {
    asm volatile("s_waitcnt vmcnt(0)" ::: "memory");
    __syncthreads();
    if (threadIdx.x == 0) { __builtin_amdgcn_fence(__ATOMIC_ACQUIRE, "agent"); asm volatile("s_waitcnt vmcnt(0)" ::: "memory"); }
    __syncthreads();
}
DI void xcd_barrier_complete(unsigned* bar, unsigned x, unsigned& nloc, unsigned& nx) {
    const unsigned G = gridDim.x * gridDim.y * gridDim.z;
    unsigned sum, cnt, mine, sp = 0u;
    for (;;) {
        sum = 0u; cnt = 0u; mine = 0u;
#pragma unroll
        for (unsigned j = 0; j < 16; ++j) { const unsigned c = xb_ld(&bar[XB_XCNT(j)]); sum += c; cnt += (c > 0u) ? 1u : 0u; mine = (j == x) ? c : mine; }
        if (sum == G) break;
        __builtin_amdgcn_s_sleep(1);
        if ((++sp & 255u) == 0u) { if (xb_ld(&bar[XB_TMO])) break; if (sp > XB_SPIN_CAP) { atomicAdd(&bar[XB_TMO], 1u); break; } }
    }
    nloc = mine > 0u ? mine : 1u; nx = cnt > 0u ? cnt : 1u;
}
DI void xcd_barrier(const XcdBarrier& b) {
    asm volatile("s_waitcnt vmcnt(0)" ::: "memory");
    __syncthreads();
    if (threadIdx.x == 0) {
        unsigned* bar = b.bar;
        unsigned bx = b.x; asm volatile("" : "+s"(bx));
        __builtin_amdgcn_s_waitcnt(0);
        unsigned nloc = b.st[0], nx = b.st[1];
        if (nloc == 0u) { xcd_barrier_complete(bar, bx, nloc, nx); b.st[0] = nloc; b.st[1] = nx; }
        const unsigned old = xb_add(&bar[XB_XSUB(bx)], 1u);
        const unsigned gen = old / nloc;
        if (old + 1u == (gen + 1u) * nloc) {
            __builtin_amdgcn_fence(__ATOMIC_RELEASE, "agent");
            asm volatile("s_waitcnt vmcnt(0)" ::: "memory");
            const unsigned og = xb_add(&bar[XB_TOP], 1u);
            const unsigned tg = og / nx;
            if (og + 1u == (tg + 1u) * nx) xb_add(&bar[XB_TOPGEN], 1u);
            else XB_SPIN(xb_ld(&bar[XB_TOPGEN]) == tg, bar);
            __builtin_amdgcn_fence(__ATOMIC_ACQUIRE, "agent");
            xb_add(&bar[XB_XGEN(bx)], 1u);
            asm volatile("s_waitcnt vmcnt(0)" ::: "memory");
        } else {
            XB_SPIN(xb_ld(&bar[XB_XGEN(bx)]) == gen, bar);
            __builtin_amdgcn_fence(__ATOMIC_ACQUIRE, "agent");
            asm volatile("s_waitcnt vmcnt(0)" ::: "memory");
        }
    }
    __syncthreads();
}

#define EPI_FENCE() do { asm volatile("" ::: "memory"); __builtin_amdgcn_sched_barrier(0); } while (0)
#define EPI_ROW(u, ai, m) ((u).pm * 256 + (ai) * 128 + wr * 64 + (m) * 16 + fr)
DI float sum4(f32x4 a) { return (a.x + a.y) + (a.z + a.w); }
DI float dot4(f32x4 a) { return (a.x * a.x + a.y * a.y) + (a.z * a.z + a.w * a.w); }
DI float rstd16(const float* p16, float invn) {
    const f32x4* p = (const f32x4*)p16; const f32x4 a = p[0], b = p[1], c = p[2], d = p[3];
    return fast_rsq(((sum4(a) + sum4(b)) + (sum4(c) + sum4(d))) * invn + EPS);
}
DI float rstd4(const float* p4, float invn) { const f32x4 a = *(const f32x4*)p4; return fast_rsq(sum4(a) * invn + EPS); }
DI float red_fq(float s) { s += __shfl_xor(s, 16); s += __shfl_xor(s, 32); return s; }
DI u32x4 pack8(f32x4 a, f32x4 b) { u32x4 w; w.x = cvt_pk_bf16(a.x, a.y); w.y = cvt_pk_bf16(a.z, a.w); w.z = cvt_pk_bf16(b.x, b.y); w.w = cvt_pk_bf16(b.z, b.w); return w; }
DI u32x2 pack4(f32x4 a) { u32x2 w; w.x = cvt_pk_bf16(a.x, a.y); w.y = cvt_pk_bf16(a.z, a.w); return w; }
DI f32x4 silu4(f32x4 g) { f32x4 o; o.x = g.x * sigmoidf_(g.x); o.y = g.y * sigmoidf_(g.y); o.z = g.z * sigmoidf_(g.z); o.w = g.w * sigmoidf_(g.w); return o; }
DI f32x4 sig4(f32x4 g) { f32x4 o; o.x = sigmoidf_(g.x); o.y = sigmoidf_(g.y); o.z = sigmoidf_(g.z); o.w = sigmoidf_(g.w); return o; }
typedef f32x4 AccT[2][2][4][2];

#define EPI_OPAQUE() int fr = fr_, fq = fq_; asm volatile("" : "+v"(fr), "+v"(fq))
#define EPI_ROWK(u, k) EPI_ROW(u, (k) >> 2, (k) & 3)
DI void rstd_rows16(const float* ssq, const Unit& u, int wr, int fr, int fq, float (&r)[8]) {
    f32x4 p[8];
#pragma unroll
    for (int k = 0; k < 8; ++k) p[k] = *(const f32x4*)(ssq + (size_t)EPI_ROWK(u, k) * 16 + fq * 4);
#pragma unroll
    for (int k = 0; k < 8; ++k) r[k] = fast_rsq(red_fq(sum4(p[k])) * (1.0f / D) + EPS);
}
DI void sum4_rows(const float* base, int stride, int off, const Unit& u, int wr, int fr, float (&r)[8]) {
    f32x4 p[8];
#pragma unroll
    for (int k = 0; k < 8; ++k) p[k] = *(const f32x4*)(base + (size_t)EPI_ROWK(u, k) * stride + off);
#pragma unroll
    for (int k = 0; k < 8; ++k) r[k] = sum4(p[k]);
}
DI void pos_rows(const int* pos, const Unit& u, int wr, int fr, float (&r)[8]) {
    int p[8];
#pragma unroll
    for (int k = 0; k < 8; ++k) p[k] = pos[EPI_ROWK(u, k)];
#pragma unroll
    for (int k = 0; k < 8; ++k) r[k] = (float)p[k];
}
constexpr int RT_OFF = 131072 + 4096, PT_OFF = RT_OFF + 4096;
DI void row_tables(LAS unsigned char* lds, const float* ssq, const int* pos, int x, int j, int rev) {
    const int tid = opaque_tid(); LAS float* rt = (LAS float*)(lds + RT_OFF); LAS float* pt = (LAS float*)(lds + PT_OFF);
    const int pin = rev ? 7 - (j & 7) : (j & 7);
#pragma unroll
    for (int i = 0; i < 2; ++i) { const int ri = tid + 512 * i, s = ri >> 8, rl = ri & 255; const size_t row = (size_t)(32 * x + 8 * s + pin) * 256 + rl;
        const f32x4* p = (const f32x4*)(ssq + row * 16); const f32x4 a = p[0], b = p[1], c = p[2], d = p[3];
        rt[ri] = fast_rsq(((sum4(a) + sum4(b)) + (sum4(c) + sum4(d))) * (1.0f / D) + EPS);
        if (pos) pt[ri] = (float)pos[row]; }
    asm volatile("s_waitcnt lgkmcnt(0)\n\ts_barrier" ::: "memory");
}
DI void score_tables(LAS unsigned char* lds, const float* qss, const unsigned* kmax, int x, int j, int rev) {
    const int tid = opaque_tid(); LAS float* t1 = (LAS float*)(lds + RT_OFF); const int hd = j >> 3;
    const int pin = rev ? 7 - (j & 7) : (j & 7);
#pragma unroll
    for (int i = 0; i < 2; ++i) { const int ri = tid + 512 * i, s = ri >> 8, rl = ri & 255; const size_t row = (size_t)(32 * x + 8 * s + pin) * 256 + rl;
        t1[ri] = sum4(*(const f32x4*)(qss + row * 16 + hd * 4)); }
    if (tid < 4) t1[1024 + tid] = 16.0f * __uint_as_float(kmax[((32 * x + 8 * tid) >> 4) * 4 + hd]);
    asm volatile("s_waitcnt lgkmcnt(0)\n\ts_barrier" ::: "memory");
}
DI void tab_rows(const LAS float* t, const Unit& u, int wr, int fr, float (&r)[8]) {
    const LAS float* b = t + ((u.pm >> 3) & 3) * 256 + wr * 64 + fr;
#pragma unroll
    for (int k = 0; k < 8; ++k) r[k] = b[(k >> 2) * 128 + (k & 3) * 16];
}
#define EPI_GROUPS() _Pragma("unroll") for (int k = 0; k < 8; ++k)
#define EPI_K() const int ai = k >> 2, m = k & 3; __builtin_amdgcn_sched_barrier(0); const int row = EPI_ROW(u, ai, m)

struct EpiSwiGLU { static constexpr bool PERM = true; static constexpr int NST = 8; bf16_t* H; const float* ssq; const LAS float* rt = nullptr;
    DI float one(float ag, float au, float nr, float c) const { asm volatile("" : "+v"(ag), "+v"(au));
        const float e = fast_exp2(ag * nr), d = __builtin_fmaf(e, c, c); return (ag * au) * fast_rcp(d); }
    DI void operator()(const AccT& acc, const Unit& u, int wr, int wc, int fr_, int fq_) const { EPI_OPAQUE();
        float r[8]; if (rt) tab_rows(rt, u, wr, fr, r); else rstd_rows16(ssq, u, wr, fr, fq, r);
        EPI_GROUPS() { EPI_K();
            const float nr = -LOG2E * r[k], c = fast_rcp(r[k] * r[k]);
            f32x4 h0, h1;
#pragma unroll
            for (int j = 0; j < 4; ++j) { h0[j] = one(acc[ai][0][m][0][j], acc[ai][1][m][0][j], nr, c); h1[j] = one(acc[ai][0][m][1][j], acc[ai][1][m][1][j], nr, c); }
            *(u32x4*)(H + (size_t)row * DFF + u.pn * 128 + wc * 32 + 8 * fq) = pack8(h0, h1); }
    }
};
template <bool FINAL> struct EpiResid { static constexpr bool PERM = true; static constexpr int NST = 16; bf16_t* xb; float* ssq; float* out;
    DI void operator()(const AccT& acc, const Unit& u, int wr, int wc, int fr_, int fq_) const { EPI_OPAQUE();
#pragma unroll
        for (int ai = 0; ai < 2; ++ai) {
            u32x4 w[4][2];
#pragma unroll
            for (int m = 0; m < 4; ++m)
#pragma unroll
                for (int bj = 0; bj < 2; ++bj) w[m][bj] = *(const u32x4*)(xb + (size_t)EPI_ROW(u, ai, m) * D + u.pn * 256 + wc * 32 + 8 * fq + bj * 128);
#pragma unroll
            for (int m = 0; m < 4; ++m) { __builtin_amdgcn_sched_barrier(0); const int row = EPI_ROW(u, ai, m); float s = 0.f; const size_t ro = (size_t)row * D + u.pn * 256 + wc * 32 + 8 * fq;
#pragma unroll
                for (int bj = 0; bj < 2; ++bj) { const size_t o = ro + bj * 128; const u32x4 ww = w[m][bj];
                    const f32x4 x0 = (f32x4){bf_lo(ww.x), bf_hi(ww.x), bf_lo(ww.y), bf_hi(ww.y)} + acc[ai][bj][m][0], x1 = (f32x4){bf_lo(ww.z), bf_hi(ww.z), bf_lo(ww.w), bf_hi(ww.w)} + acc[ai][bj][m][1];
                    if (FINAL) { *(f32x4*)(out + o) = x0; *(f32x4*)(out + o + 4) = x1; }
                    else { *(u32x4*)(xb + o) = pack8(x0, x1); s += dot4(x0) + dot4(x1); } }
                if (!FINAL) { s = red_fq(s); if (fq == 0) ssq[(size_t)row * 16 + u.pn * 4 + wc] = s; } }
        }
    }
};
struct EpiQraw { static constexpr bool PERM = true; static constexpr int NST = 16; bf16_t* Q; const float* ssq; float* qss; const LAS float* rt = nullptr;
    DI void operator()(const AccT& acc, const Unit& u, int wr, int wc, int fr_, int fq_) const { EPI_OPAQUE();
        float r[8]; if (rt) tab_rows(rt, u, wr, fr, r); else rstd_rows16(ssq, u, wr, fr, fq, r);
        EPI_GROUPS() { EPI_K(); float s = 0.f;
#pragma unroll
            for (int bj = 0; bj < 2; ++bj) { const f32x4 v0 = acc[ai][bj][m][0] * r[k], v1 = acc[ai][bj][m][1] * r[k]; s += dot4(v0) + dot4(v1);
                *(u32x4*)(Q + (size_t)row * D + u.pn * 256 + bj * 128 + wc * 32 + 8 * fq) = pack8(v0, v1); }
            s = red_fq(s); if (fq == 0) qss[(size_t)row * 16 + u.pn * 4 + wc] = s; }
    }
};
struct EpiScoresN { static constexpr bool PERM = true; static constexpr int NST = 16; bf16_t* P; const LAS float* qt; LAS float* tab;
    DI void operator()(const AccT& acc, const Unit& u, int wr, int wc, int fr_, int fq_) const { EPI_OPAQUE();
        const float sh = qt[1024 + ((u.pm >> 3) & 3)];
        float rq[8]; tab_rows(qt, u, wr, fr, rq);
        u32x4 w[8][2];
        EPI_GROUPS() { const int ai = k >> 2, m = k & 3; __builtin_amdgcn_sched_barrier(0);
            const float rqk = fast_rsq(rq[k] * (1.0f / XHD) + EPS); float sm = 0.f;
#pragma unroll
            for (int bj = 0; bj < 2; ++bj) { f32x4 p0, p1;
#pragma unroll
                for (int j = 0; j < 4; ++j) { p0[j] = fast_exp2(acc[ai][bj][m][0][j] * rqk - sh); p1[j] = fast_exp2(acc[ai][bj][m][1][j] * rqk - sh); }
                const u32x4 ww = pack8(p0, p1); w[k][bj] = ww;
                sm += ((bf_lo(ww.x) + bf_hi(ww.x)) + (bf_lo(ww.y) + bf_hi(ww.y))) + ((bf_lo(ww.z) + bf_hi(ww.z)) + (bf_lo(ww.w) + bf_hi(ww.w))); }
            sm = red_fq(sm); if (fq == 0) tab[(ai * 128 + wr * 64 + m * 16 + fr) * 4 + wc] = sm; }
        asm volatile("s_waitcnt lgkmcnt(0)\n\ts_barrier" ::: "memory");
        EPI_GROUPS() { const int ai = k >> 2, m = k & 3; __builtin_amdgcn_sched_barrier(0); const int row = EPI_ROW(u, ai, m);
            const float li = fast_rcp(sum4(*(const LAS f32x4*)(tab + (ai * 128 + wr * 64 + m * 16 + fr) * 4)));
#pragma unroll
            for (int bj = 0; bj < 2; ++bj) { const u32x4 ww = w[k][bj];
                const f32x4 a = (f32x4){bf_lo(ww.x), bf_hi(ww.x), bf_lo(ww.y), bf_hi(ww.y)} * li, b = (f32x4){bf_lo(ww.z), bf_hi(ww.z), bf_lo(ww.w), bf_hi(ww.w)} * li;
                *(u32x4*)(P + (size_t)row * D + u.pn * 256 + bj * 128 + wc * 32 + 8 * fq) = pack8(a, b); } }
    }
};
struct EpiVW { static constexpr bool PERM = true; bf16_t* VW;
    DI void operator()(const AccT& acc, const Unit& u, int wr, int wc, int fr_, int fq_) const { EPI_OPAQUE();
        bf16_t* base = VW + ((size_t)(u.pm >> 2) * D + (u.pm & 3) * 256) * (XH * MEMLEN) + u.pn * MEMLEN + wc * 32 + 8 * fq;
        EPI_GROUPS() { const int ai = k >> 2, m = k & 3; __builtin_amdgcn_sched_barrier(0); const int r = ai * 128 + wr * 64 + m * 16 + fr;
#pragma unroll
            for (int bj = 0; bj < 2; ++bj) *(u32x4*)(base + (size_t)r * (XH * MEMLEN) + bj * 128) = pack8(acc[ai][bj][m][0], acc[ai][bj][m][1]); }
    }
};
struct EpiMemK { static constexpr bool PERM = true; bf16_t* KP; const float* rmem; float* kss; const float* knorm; const float* qnorm;
    DI void operator()(const AccT& acc, const Unit& u, int wr, int wc, int fr_, int fq_) const { EPI_OPAQUE();
        const int l = u.pm >> 4; f32x4 g[2][2];
#pragma unroll
        for (int bj = 0; bj < 2; ++bj)
#pragma unroll
            for (int n = 0; n < 2; ++n) { const int d = bj * 128 + wc * 32 + 8 * fq + 4 * n; g[bj][n] = *(const f32x4*)(knorm + l * XHD + d) * *(const f32x4*)(qnorm + l * XHD + d) * (LOG2E / 16.0f); }
        float rr[8];
#pragma unroll
        for (int k = 0; k < 8; ++k) rr[k] = rmem[EPI_ROWK(u, k) & (MM - 1)];
        EPI_GROUPS() { EPI_K(); const float r = rr[k]; float s = 0.f;
#pragma unroll
            for (int bj = 0; bj < 2; ++bj) { const f32x4 v0 = acc[ai][bj][m][0] * r, v1 = acc[ai][bj][m][1] * r; s += dot4(v0) + dot4(v1);
                *(u32x4*)(KP + (size_t)row * D + u.pn * 256 + bj * 128 + wc * 32 + 8 * fq) = pack8(v0 * g[bj][0], v1 * g[bj][1]); }
            s = red_fq(s); if (fq == 0) kss[(size_t)row * 16 + u.pn * 4 + wc] = s; }
    }
};
struct EpiMemV { static constexpr bool PERM = true; bf16_t* V; const float* rmem;
    DI void operator()(const AccT& acc, const Unit& u, int wr, int wc, int fr_, int fq_) const { EPI_OPAQUE();
        float rr[8];
#pragma unroll
        for (int k = 0; k < 8; ++k) rr[k] = rmem[EPI_ROWK(u, k) & (MM - 1)];
        EPI_GROUPS() { EPI_K(); const float r = rr[k];
#pragma unroll
            for (int bj = 0; bj < 2; ++bj) *(u32x4*)(V + (size_t)row * D + u.pn * 256 + bj * 128 + wc * 32 + 8 * fq) = pack8(acc[ai][bj][m][0] * r, acc[ai][bj][m][1] * r); }
    }
};
constexpr float LOG2_THETA = 13.287712379549449f;
DI void rope_mla(f32x4& x1, f32x4& x2, float pos, int fq) {
#pragma unroll
    for (int j = 0; j < 4; ++j) { const float inv = fast_exp2(-(float)(4 * fq + j) * (LOG2_THETA / 16.0f)); float s, c; sincos_turns(pos * inv, s, c);
        const float a = x1[j], b = x2[j]; x1[j] = a * c - b * s; x2[j] = a * s + b * c; }
}
struct EpiEven1 { static constexpr bool PERM = true; bf16_t* AB; bf16_t* ZC; bf16_t* KR; const float* ssq; float* zs; const float* gkr; const int* pos; const LAS float* rt = nullptr; const LAS float* pt = nullptr;
    DI void operator()(const AccT& acc, const Unit& u, int wr, int wc, int fr_, int fq_) const { EPI_OPAQUE();
        float rr[8]; if (rt) tab_rows(rt, u, wr, fr, rr); else rstd_rows16(ssq, u, wr, fr, fq, rr);
        float pp[8];
        if (u.pn == 5 && wc == 0) { if (pt) tab_rows(pt, u, wr, fr, pp); else pos_rows(pos, u, wr, fr, pp); }
        EPI_GROUPS() { EPI_K(); const float r = rr[k];
            if (u.pn < 4) {
                const f32x4 a0 = (acc[ai][0][m][0] * r) * sig4(acc[ai][1][m][0] * r), a1 = (acc[ai][0][m][1] * r) * sig4(acc[ai][1][m][1] * r);
                *(u32x4*)(AB + (size_t)row * CONV_DIM + u.pn * 128 + wc * 32 + 8 * fq) = pack8(a0, a1);
            } else if (u.pn == 4) {
                float s = 0.f;
#pragma unroll
                for (int bj = 0; bj < 2; ++bj) { const f32x4 v0 = acc[ai][bj][m][0] * r, v1 = acc[ai][bj][m][1] * r; s += dot4(v0) + dot4(v1);
                    *(u32x4*)(ZC + (size_t)row * S2K + bj * 128 + wc * 32 + 8 * fq) = pack8(v0, v1); }
                s = red_fq(s); if (fq == 0) zs[(size_t)row * 8 + wc] = s;
            } else {
                { const f32x4 v0 = acc[ai][0][m][0] * r, v1 = acc[ai][0][m][1] * r; float s = red_fq(dot4(v0) + dot4(v1));
                  *(u32x4*)(ZC + (size_t)row * S2K + 256 + wc * 32 + 8 * fq) = pack8(v0, v1); if (fq == 0) zs[(size_t)row * 8 + 4 + wc] = s; }
                if (wc == 0) {
                    f32x4 x1 = acc[ai][1][m][0] * r, x2 = acc[ai][1][m][1] * r; const float ss = red_fq(dot4(x1) + dot4(x2));
                    const float rn = fast_rsq(ss * (1.0f / QK_ROPE) + EPS);
                    x1 = x1 * rn * *(const f32x4*)(gkr + 4 * fq); x2 = x2 * rn * *(const f32x4*)(gkr + 16 + 4 * fq);
                    rope_mla(x1, x2, pp[k], fq);
                    *(u32x2*)(KR + (size_t)row * QK_ROPE + 4 * fq) = pack4(x1); *(u32x2*)(KR + (size_t)row * QK_ROPE + 16 + 4 * fq) = pack4(x2);
                }
            }
        }
    }
};
struct EpiEven2 { static constexpr bool PERM = true; bf16_t* QH; bf16_t* KN; bf16_t* VB; const float* zs; const float* gqn; const float* gqr; const float* gkn; const int* pos; float qscale;
    DI void operator()(const AccT& acc, const Unit& u, int wr, int wc, int fr_, int fq_) const { EPI_OPAQUE();
        const bool isq = u.pn < 3; const int ws = (isq ? u.pn : u.pn - 3) * 4 + wc;
        float zz[8]; sum4_rows(zs, 8, isq ? 0 : 4, u, wr, fr, zz);
        float pp[8];
        if (isq && ws >= 8) pos_rows(pos, u, wr, fr, pp);
        EPI_GROUPS() { EPI_K();
            const float rz = fast_rsq(zz[k] * (isq ? 1.0f / QLORA : 1.0f / KVLORA) + EPS);
            if (ws < 8) {
                f32x4 v[2][2]; float s = 0.f;
#pragma unroll
                for (int bj = 0; bj < 2; ++bj)
#pragma unroll
                    for (int n = 0; n < 2; ++n) { v[bj][n] = acc[ai][bj][m][n] * rz; s += dot4(v[bj][n]); }
                s = red_fq(s); const float rn = fast_rsq(s * (1.0f / QK_NOPE) + EPS) * (isq ? qscale : 1.0f);
                const float* g = isq ? gqn : gkn; bf16_t* dst = isq ? QH + (size_t)row * 768 + ws * 96 : KN + (size_t)row * 512 + ws * 64;
#pragma unroll
                for (int bj = 0; bj < 2; ++bj) { const int d = 32 * bj + 8 * fq;
                    *(u32x4*)(dst + d) = pack8(v[bj][0] * rn * *(const f32x4*)(g + d), v[bj][1] * rn * *(const f32x4*)(g + d + 4)); }
            } else if (isq) {
#pragma unroll
                for (int bj = 0; bj < 2; ++bj) { const int head = 2 * (ws - 8) + bj;
                    f32x4 x1 = acc[ai][bj][m][0] * rz, x2 = acc[ai][bj][m][1] * rz; const float ss = red_fq(dot4(x1) + dot4(x2));
                    const float rn = fast_rsq(ss * (1.0f / QK_ROPE) + EPS);
                    x1 = x1 * rn * *(const f32x4*)(gqr + 4 * fq); x2 = x2 * rn * *(const f32x4*)(gqr + 16 + 4 * fq);
                    rope_mla(x1, x2, pp[k], fq);
                    bf16_t* dst = QH + (size_t)row * 768 + head * 96 + 64;
                    *(u32x2*)(dst + 4 * fq) = pack4(x1 * qscale); *(u32x2*)(dst + 16 + 4 * fq) = pack4(x2 * qscale); }
            } else {
#pragma unroll
                for (int bj = 0; bj < 2; ++bj) *(u32x4*)(VB + (size_t)row * 512 + (ws - 8) * 64 + 32 * bj + 8 * fq) = pack8(acc[ai][bj][m][0] * rz, acc[ai][bj][m][1] * rz);
            }
        }
    }
};
struct EpiOdd1 { static constexpr bool PERM = true; static constexpr int NST = 16; bf16_t* Q; bf16_t* Kk; bf16_t* V; const float* ssq; const int* pos; const LAS float* rt = nullptr; const LAS float* pt = nullptr;
    DI void operator()(const AccT& acc, const Unit& u, int wr, int wc, int fr_, int fq_) const { EPI_OPAQUE();
        float rr[8]; if (rt) tab_rows(rt, u, wr, fr, rr); else rstd_rows16(ssq, u, wr, fr, fq, rr);
        if (u.pn < 8) {
            float pp[8]; if (pt) tab_rows(pt, u, wr, fr, pp); else pos_rows(pos, u, wr, fr, pp);
            float inv[2][4];
#pragma unroll
            for (int n = 0; n < 2; ++n)
#pragma unroll
                for (int j = 0; j < 4; ++j) inv[n][j] = fast_exp2(-(float)(32 * wc + 8 * fq + 4 * n + j) * (LOG2_THETA / 128.0f));
            const bool isk = u.pn >= 4; const float osc = isk ? (1.0f / 16.0f) : 1.0f; bf16_t* base = (isk ? Kk : Q) + (u.pn & 3) * 256 + 32 * wc + 8 * fq;
            const float l2gk = __builtin_log2f(1.0f - fast_exp2(-5.0f - (float)(u.pn & 3)));
            EPI_GROUPS() { EPI_K(); const float r = rr[k] * (isk ? osc * fast_exp2(-(float)(16 * m + fr + 1) * l2gk) : 1.0f); const float p = pp[k];
                f32x4 o1[2], o2[2];
#pragma unroll
                for (int n = 0; n < 2; ++n)
#pragma unroll
                    for (int j = 0; j < 4; ++j) { float s, c; sincos_turns(p * inv[n][j], s, c); const float a = acc[ai][0][m][n][j] * r, b = acc[ai][1][m][n][j] * r; o1[n][j] = a * c - b * s; o2[n][j] = a * s + b * c; }
                *(u32x4*)(base + (size_t)row * 1024) = pack8(o1[0], o1[1]); *(u32x4*)(base + (size_t)row * 1024 + 128) = pack8(o2[0], o2[1]); }
        } else {
            EPI_GROUPS() { EPI_K(); const float r = rr[k];
#pragma unroll
                for (int bj = 0; bj < 2; ++bj) *(u32x4*)(V + (size_t)row * ODD_MIX + (u.pn - 8) * 256 + bj * 128 + wc * 32 + 8 * fq) = pack8(acc[ai][bj][m][0] * r, acc[ai][bj][m][1] * r); }
        }
    }
};
struct EpiGate { static constexpr bool PERM = true; static constexpr int NST = 16; bf16_t* O; const float* gns; const LAS float* rt; const LAS float* gt;
    DI void operator()(const AccT& acc, const Unit& u, int wr, int wc, int fr_, int fq_) const { EPI_OPAQUE();
        const int head = u.pn >> 1; const int c0 = u.pn * 256 + wc * 32 + 8 * fq; const int t0 = ((u.pn >> 2) & 1) * 256 + wc * 32 + 8 * fq;
        float rr[8]; tab_rows(rt, u, wr, fr, rr);
#pragma unroll
        for (int ai = 0; ai < 2; ++ai) { EPI_FENCE();
            f32x2 st[4]; u32x4 w[4][2];
#pragma unroll
            for (int m = 0; m < 4; ++m) { const size_t row = EPI_ROW(u, ai, m); st[m] = *(const f32x2*)(gns + row * 32 + head * 8 + fq * 2);
                w[m][0] = *(const u32x4*)(O + row * ODD_MIX + c0); w[m][1] = *(const u32x4*)(O + row * ODD_MIX + c0 + 128); }
            float ga[4], gc[4];
#pragma unroll
            for (int m = 0; m < 4; ++m) {
                const float mean = red_fq(st[m].x) * (1.0f / RET_V), var = red_fq(st[m].y) * (1.0f / RET_V) - mean * mean; ga[m] = fast_rsq(fmaxf(var, 0.f) + EPS); gc[m] = -mean * ga[m]; }
#pragma unroll
            for (int bj = 0; bj < 2; ++bj) { __builtin_amdgcn_sched_barrier(0);
                const int c = c0 + bj * 128, t = t0 + bj * 128;
                const f32x4 G0 = *(const LAS f32x4*)(gt + t), G1 = *(const LAS f32x4*)(gt + t + 4), B0 = *(const LAS f32x4*)(gt + 512 + t), B1 = *(const LAS f32x4*)(gt + 512 + t + 4);
#pragma unroll
                for (int m = 0; m < 4; ++m) { const u32x4 ww = w[m][bj]; const float r = rr[ai * 4 + m];
                    f32x4 o0 = (f32x4){bf_lo(ww.x), bf_hi(ww.x), bf_lo(ww.y), bf_hi(ww.y)}, o1 = (f32x4){bf_lo(ww.z), bf_hi(ww.z), bf_lo(ww.w), bf_hi(ww.w)};
                    o0 = (o0 * ga[m] + gc[m]) * G0 + B0; o1 = (o1 * ga[m] + gc[m]) * G1 + B1;
                    *(u32x4*)(O + (size_t)EPI_ROW(u, ai, m) * ODD_MIX + c) = pack8(silu4(acc[ai][bj][m][0] * r) * o0, silu4(acc[ai][bj][m][1] * r) * o1); }
            }
        }
    }
};
DI void lds_barrier() { asm volatile("s_waitcnt lgkmcnt(0)\n\ts_barrier" ::: "memory"); }
typedef short v4i16_t __attribute__((ext_vector_type(4)));
DI int crow(int r, int hi) { return (r & 3) + 8 * (r >> 2) + 4 * hi; }
#define MFMA32(a, b, c) __builtin_amdgcn_mfma_f32_32x32x16_bf16((a), (b), (c), 0, 0, 0)
#define MFMA16(a, b, c) __builtin_amdgcn_mfma_f32_16x16x32_bf16((a), (b), (c), 0, 0, 0)
constexpr int AT_KP = 208, AT_VP = 144;
constexpr int AT_KB = 64 * AT_KP, AT_VB = 64 * AT_VP;
DI bf16x8 pack_frag(const f32x16& x, int s) {
    u32x4 p; p.x = cvt_pk_bf16(x[8 * s], x[8 * s + 1]); p.y = cvt_pk_bf16(x[8 * s + 2], x[8 * s + 3]); p.z = cvt_pk_bf16(x[8 * s + 4], x[8 * s + 5]); p.w = cvt_pk_bf16(x[8 * s + 6], x[8 * s + 7]);
    return __builtin_bit_cast(bf16x8, p);
}
DI void attn_unit(LAS unsigned char* lds, const bf16_t* QH, const bf16_t* KN, const bf16_t* KR, const bf16_t* VB, bf16_t* MIX, int b, int h, int qb, float shift) {
    const int tid = opaque_tid(), wid = __builtin_amdgcn_readfirstlane(tid >> 6), lane = tid & 63, r32 = lane & 31, hi = lane >> 5;
    const int q0 = qb * 256, ntile = 4 * (qb + 1);
    const size_t rowb = (size_t)b * SEQ;
    if (wid >= 4) __builtin_amdgcn_s_setprio(1);
    LAS unsigned char* Kb = lds; LAS unsigned char* Vb = lds + 2 * AT_KB;
    bf16x8 qf[6];
    { const bf16_t* qp = QH + (rowb + q0 + wid * 32 + r32) * 768 + h * 96 + 8 * hi;
#pragma unroll
      for (int s = 0; s < 6; ++s) qf[s] = *(const bf16x8*)(qp + 16 * s); }
    f32x16 o0, o1;
#pragma unroll
    for (int i = 0; i < 16; ++i) { o0[i] = 0.f; o1[i] = 0.f; }
    float lsum = 0.f;
    const int skey = tid >> 3, sch = tid & 7;
    const int rkey = (tid & 255) >> 2, rch = tid & 3;
    struct Stg { u32x4 k, r, v; };
    Stg RA, RB;
    auto gload = [&](Stg& R, int kt) {
        const size_t row = rowb + (size_t)kt * 64;
        R.k = *(const u32x4*)(KN + (row + skey) * 512 + h * 64 + sch * 8);
        R.v = *(const u32x4*)(VB + (row + skey) * 512 + h * 64 + sch * 8);
        if (tid < 256) R.r = *(const u32x4*)(KR + (row + rkey) * 32 + rch * 8);
    };
    auto swrite = [&](const Stg& R, int buf) {
        *(LAS u32x4*)(Kb + buf * AT_KB + skey * AT_KP + sch * 16) = R.k;
        if (tid < 256) *(LAS u32x4*)(Kb + buf * AT_KB + rkey * AT_KP + 128 + rch * 16) = R.r;
        *(LAS u32x4*)(Vb + buf * AT_VB + skey * AT_VP + sch * 16) = R.v;
    };
    const int qrow = q0 + wid * 32 + r32;
    auto compute = [&](int buf, int kt) {
        const bool active = (64 * kt <= q0 + wid * 32 + 31);
        if (active) {
            const bool needmask = (64 * kt + 63 > q0 + wid * 32);
            const LAS unsigned char* kb = Kb + buf * AT_KB + r32 * AT_KP + 16 * hi;
            const LAS unsigned char* vb = Vb + buf * AT_VB + (4 * hi + ((lane & 15) >> 2)) * AT_VP + (16 * ((lane >> 4) & 1) + 4 * (lane & 3)) * 2;
            bf16x8 kf[12];
#pragma unroll
            for (int s = 0; s < 6; ++s) { kf[2 * s] = *(const LAS bf16x8*)(kb + 32 * s); kf[2 * s + 1] = *(const LAS bf16x8*)(kb + 32 * AT_KP + 32 * s); }
            __builtin_amdgcn_sched_barrier(0);
            f32x16 s0, s1;
#pragma unroll
            for (int i = 0; i < 16; ++i) { s0[i] = -shift; s1[i] = -shift; }
#pragma unroll
            for (int s = 0; s < 6; ++s) { s0 = MFMA32(kf[2 * s], qf[s], s0); s1 = MFMA32(kf[2 * s + 1], qf[s], s1); }
            s16x4 va[4][2], vc[4][2];
#pragma unroll
            for (int f = 0; f < 4; ++f) { const int ko = (32 * (f >> 1) + 16 * (f & 1)) * AT_VP;
                va[f][0] = __builtin_amdgcn_ds_read_tr16_b64_v4i16((LAS v4i16_t*)(vb + ko)); va[f][1] = __builtin_amdgcn_ds_read_tr16_b64_v4i16((LAS v4i16_t*)(vb + ko + 8 * AT_VP));
                vc[f][0] = __builtin_amdgcn_ds_read_tr16_b64_v4i16((LAS v4i16_t*)(vb + ko + 64)); vc[f][1] = __builtin_amdgcn_ds_read_tr16_b64_v4i16((LAS v4i16_t*)(vb + ko + 8 * AT_VP + 64)); }
            __builtin_amdgcn_sched_barrier(0);
#pragma unroll
            for (int i = 0; i < 16; ++i) { s0[i] = fast_exp2(s0[i]); s1[i] = fast_exp2(s1[i]); }
            if (needmask) {
                const int kbase = 64 * kt;
#pragma unroll
                for (int i = 0; i < 16; ++i) { const int kg = kbase + crow(i, hi); if (kg > qrow) s0[i] = 0.f; if (kg + 32 > qrow) s1[i] = 0.f; }
            }
            bf16x8 pf[2][2];
#pragma unroll
            for (int s2 = 0; s2 < 2; ++s2) { pf[0][s2] = pack_frag(s0, s2); pf[1][s2] = pack_frag(s1, s2); }
            { f32x16 t = s0 + s1; lsum += (((t[0] + t[1]) + (t[2] + t[3])) + ((t[4] + t[5]) + (t[6] + t[7]))) + (((t[8] + t[9]) + (t[10] + t[11])) + ((t[12] + t[13]) + (t[14] + t[15]))); }
            __builtin_amdgcn_sched_barrier(0);
#pragma unroll
            for (int f = 0; f < 4; ++f) {
                const bf16x8 v0 = __builtin_shufflevector(va[f][0], va[f][1], 0, 1, 2, 3, 4, 5, 6, 7), v1 = __builtin_shufflevector(vc[f][0], vc[f][1], 0, 1, 2, 3, 4, 5, 6, 7);
                o0 = MFMA32(v0, pf[f >> 1][f & 1], o0); o1 = MFMA32(v1, pf[f >> 1][f & 1], o1);
            }
        }
    };
    gload(RA, 0); gload(RB, 1); swrite(RA, 0); lds_barrier();
    for (int kt = 0; kt < ntile; kt += 2) {
        if (kt + 2 < ntile) gload(RA, kt + 2);
        compute(0, kt);
        swrite(RB, 1);
        lds_barrier();
        if (kt + 3 < ntile) gload(RB, kt + 3);
        compute(1, kt + 1);
        if (kt + 2 < ntile) swrite(RA, 0);
        lds_barrier();
    }
    lsum += __shfl_xor(lsum, 32);
    const float li = 1.0f / lsum;
    bf16_t* op = MIX + (rowb + qrow) * 1024 + 512 + h * 64 + 8 * hi;
    auto store_pair = [&](const f32x16& o, int g, bf16_t* p) {
        u32x2 a = pack4((f32x4){o[4 * g] * li, o[4 * g + 1] * li, o[4 * g + 2] * li, o[4 * g + 3] * li}), c = pack4((f32x4){o[4 * g + 4] * li, o[4 * g + 5] * li, o[4 * g + 6] * li, o[4 * g + 7] * li});
        { const auto r = __builtin_amdgcn_permlane32_swap(a.x, c.x, false, false); a.x = r[0]; c.x = r[1]; }
        { const auto r = __builtin_amdgcn_permlane32_swap(a.y, c.y, false, false); a.y = r[0]; c.y = r[1]; }
        *(u32x4*)(p + 8 * g) = (u32x4){a.x, a.y, c.x, c.y}; };
    store_pair(o0, 0, op); store_pair(o0, 2, op); store_pair(o1, 0, op + 32); store_pair(o1, 2, op + 32);
    __builtin_amdgcn_s_setprio(0);
}

DI void conv_tile(LAS unsigned char* lds, const bf16_t* AB, bf16_t* MIX, const float* cw, const float* cb, const float* lng, const float* lnb, int tile) {
    const int tid = opaque_tid(), wid = tid >> 6, lane = tid & 63;
    const int b = tile >> 7, t0 = (tile & 127) * 32; const size_t rowb = (size_t)b * SEQ;
#pragma unroll
    for (int i = 0; i < 8; ++i) { const int idx = tid + 512 * i;
        if (idx < 62 * 64) { const int r = idx >> 6, ch = idx & 63, tok = t0 - 30 + r; u32x4 v = (u32x4){0u, 0u, 0u, 0u};
            if (tok >= 0) v = *(const u32x4*)(AB + (rowb + tok) * CONV_DIM + ch * 8);
            *(LAS u32x4*)(lds + r * 1024 + ch * 16) = v; } }
    float w[CONV_W];
#pragma unroll
    for (int j = 0; j < CONV_W; ++j) w[j] = cw[j * CONV_DIM + tid];
    const float bias = cb[tid];
    __syncthreads();
    f32x2 xp[31], we[15], wo[15];
#pragma unroll
    for (int r = 0; r < 31; ++r) { xp[r].x = __uint_as_float(((unsigned)*(const LAS unsigned short*)(lds + (2 * r) * 1024 + tid * 2)) << 16); xp[r].y = __uint_as_float(((unsigned)*(const LAS unsigned short*)(lds + (2 * r + 1) * 1024 + tid * 2)) << 16); }
#pragma unroll
    for (int k = 0; k < 15; ++k) { we[k] = (f32x2){w[2 * k], w[2 * k + 1]}; wo[k] = (f32x2){w[2 * k + 1], w[2 * k + 2]}; }
    LAS float* yb = (LAS float*)(lds + 65536);
#pragma unroll
    for (int s = 0; s < 16; ++s) {
        f32x2 ae = (f32x2){bias, 0.f}, ao = (f32x2){bias, 0.f};
#pragma unroll
        for (int k = 0; k < 15; ++k) { ae = __builtin_elementwise_fma(we[k], xp[s + k], ae); ao = __builtin_elementwise_fma(wo[k], xp[s + 1 + k], ao); }
        yb[(2 * s) * CONV_DIM + tid] = (ae.x + ae.y) + w[30] * xp[s + 15].x;
        yb[(2 * s + 1) * CONV_DIM + tid] = (ao.x + ao.y) + w[0] * xp[s].y; }
    __syncthreads();
#pragma unroll
    for (int rr = 0; rr < 4; ++rr) { const int t = wid * 4 + rr;
        const f32x4 a = *(const LAS f32x4*)(yb + t * CONV_DIM + 8 * lane), c = *(const LAS f32x4*)(yb + t * CONV_DIM + 8 * lane + 4);
        const float mean = wave_sum(sum4(a) + sum4(c)) * (1.0f / CONV_DIM);
        const f32x4 da = a - mean, dc = c - mean;
        const float rs = fast_rsq(wave_sum(dot4(da) + dot4(dc)) * (1.0f / CONV_DIM) + EPS);
        const f32x4 ya = da * rs * *(const f32x4*)(lng + 8 * lane) + *(const f32x4*)(lnb + 8 * lane), yc = dc * rs * *(const f32x4*)(lng + 8 * lane + 4) + *(const f32x4*)(lnb + 8 * lane + 4);
        *(u32x4*)(MIX + (rowb + t0 + t) * 1024 + 8 * lane) = pack8(silu4(ya), silu4(yc)); }
    __syncthreads();
}

constexpr int RC = 64;
constexpr int R_SLOT = 32768, R_KO = 16384, R_V = 65536, R_VSZ = 16384, R_P = 98304, R_PP = 144, R_TAB = R_P + RC * R_PP;
static_assert(R_TAB + 4096 <= RING_BYTES, "retention LDS");
DI int r_f(int r) { return ((r & 3) << 1) | (r & 8) | ((r >> 2) & 1); }
DI bf16x8 tr_pair(unsigned a, unsigned a2, int off) {
    u32x2 x, y;
    asm volatile("ds_read_b64_tr_b16 %0, %1 offset:%2" : "=v"(x) : "v"(a), "i"(off) : "memory");
    asm volatile("ds_read_b64_tr_b16 %0, %1 offset:%2" : "=v"(y) : "v"(a2), "i"(off) : "memory");
    u32x4 w; w.x = x.x; w.y = x.y; w.z = y.x; w.w = y.y; return __builtin_bit_cast(bf16x8, w);
}
DI bf16x8 r64_pair(unsigned a, unsigned a2, int off) {
    u32x2 x, y;
    asm volatile("ds_read_b64 %0, %1 offset:%2" : "=v"(x) : "v"(a), "i"(off) : "memory");
    asm volatile("ds_read_b64 %0, %1 offset:%2" : "=v"(y) : "v"(a2), "i"(off) : "memory");
    u32x4 w; w.x = x.x; w.y = x.y; w.z = y.x; w.w = y.y; return __builtin_bit_cast(bf16x8, w);
}
#define R_LGKM2(a, b) asm volatile("s_waitcnt lgkmcnt(0)" : "+v"(a), "+v"(b) :: "memory")
#define R_LGKM8(a, b, c, d, e, f, g_, h_) asm volatile("s_waitcnt lgkmcnt(0)" : "+v"(a), "+v"(b), "+v"(c), "+v"(d), "+v"(e), "+v"(f), "+v"(g_), "+v"(h_) :: "memory")
#define R_LGKM9(a, b, c, d, e, f, g_, h_, i_) asm volatile("s_waitcnt lgkmcnt(0)" : "+v"(a), "+v"(b), "+v"(c), "+v"(d), "+v"(e), "+v"(f), "+v"(g_), "+v"(h_), "+v"(i_) :: "memory")
#define R_WAITV() asm volatile("s_waitcnt vmcnt(0)" ::: "memory")
#define R_PIN(x) asm volatile("" : "+v"(x))
DI void retention_unit(LAS unsigned char* lds, const bf16_t* Q, const bf16_t* Kk, bf16_t* V, float* gns, int b, int h, int vs) {
    const int tid0 = opaque_tid(), wid = __builtin_amdgcn_readfirstlane(tid0 >> 6);
    const float l2g = __builtin_log2f(1.0f - fast_exp2(-5.0f - (float)h));
    const float gC = fast_exp2((float)RC * l2g);
    const size_t rowb = (size_t)b * SEQ;
    const bf16_t* Qh = Q + rowb * 1024 + h * 256; const bf16_t* Kh = Kk + rowb * 1024 + h * 256; bf16_t* Vh = V + rowb * ODD_MIX + h * 512 + vs * 128;
    float* gnh = gns + rowb * 32 + h * 8 + vs * 2;
    const int ib_a = wid & 3, jb_a = 2 * (wid >> 2);
    LAS float* tab = (LAS float*)(lds + R_TAB);
    unsigned aT[8], aT2[8], aV, aV2, aQ[4], aP[4][2];
    { const int lane = tid0 & 63, i16 = lane & 15, g = lane >> 4, fi = r_f(i16);
      const unsigned lb = (unsigned)(uintptr_t)lds;
      const int xq = (g ^ fi) << 4;
      const int xp = (((g >> 1) ^ fi) << 4) | ((g & 1) << 3);
      const int xt = ((((i16 >> 1) & 1) ^ ((i16 >> 2) << 1) ^ ((g & 1) << 3)) << 4) | ((i16 & 1) << 3);
      const int rowtr = (8 * g + (i16 >> 2)) * 256;
#pragma unroll
      for (int t = 0; t < 8; ++t) { aT[t] = lb + rowtr + (xt ^ (32 * t)); aT2[t] = lb + rowtr + 1024 + ((xt ^ (32 * t)) ^ 16); R_PIN(aT[t]); R_PIN(aT2[t]); }
      aV = lb + R_V + rowtr + (xt ^ (32 * wid)); aV2 = lb + R_V + rowtr + 1024 + ((xt ^ (32 * wid)) ^ 16); R_PIN(aV); R_PIN(aV2);
#pragma unroll
      for (int s = 0; s < 4; ++s) { aQ[s] = lb + i16 * 256 + (xq ^ (64 * s)); R_PIN(aQ[s]); aP[s][0] = lb + i16 * 256 + (xp ^ (64 * s)); aP[s][1] = lb + i16 * 256 + (xp ^ (64 * s + 32)); R_PIN(aP[s][0]); R_PIN(aP[s][1]); }
    }
    f32x4 st[16];
#pragma unroll
    for (int t = 0; t < 16; ++t) st[t] = (f32x4){0.f, 0.f, 0.f, 0.f};
    for (int c = 0; c < SEQ / RC; ++c) {
    int tid = tid0; asm volatile("" : "+v"(tid));
    const int lane = tid & 63, i16 = lane & 15, g = lane >> 4;
    auto dma_img = [&](int ldsoff, const bf16_t* src, int pitch) {
#pragma unroll
        for (int i = 0; i < 2; ++i) { const int q = wid + 8 * i, row = 4 * q + g, ch = i16 ^ r_f(row & 15);
            __builtin_amdgcn_global_load_lds((const unsigned*)(src + (size_t)row * pitch + ch * 8), (LAS unsigned*)(lds + ldsoff + q * 1024), 16, 0, 0); }
    };
    auto dma_qk = [&](int slot, int chunk, int half) { dma_img(slot * R_SLOT, Qh + (size_t)chunk * RC * 1024 + half * 128, 1024); dma_img(slot * R_SLOT + R_KO, Kh + (size_t)chunk * RC * 1024 + half * 128, 1024); };
    auto dma_v = [&](int chunk) { dma_img(R_V + (chunk & 1) * R_VSZ, Vh + (size_t)chunk * RC * ODD_MIX, ODD_MIX); };
    auto tab_reduce = [&](int chunk) {
        if (tid < RC) { float s1 = 0.f, s2 = 0.f;
#pragma unroll
            for (int w = 0; w < 8; ++w) { const f32x2 v = *(const LAS f32x2*)(tab + (tid * 8 + w) * 2); s1 += v.x; s2 += v.y; }
            *(f32x2*)(gnh + (size_t)(chunk * RC + tid) * 32) = (f32x2){s1, s2}; }
    };
    if (c == 0) { dma_qk(0, 0, 0); dma_v(0); }
    if (c == 0) R_WAITV(); else asm volatile("s_waitcnt vmcnt(4)" ::: "memory");
    lds_barrier();
    if (c > 0) tab_reduce(c - 1);
    dma_qk(1, c, 1);
    {
        const unsigned vo = (unsigned)((c & 1) * R_VSZ), aVc = aV + vo, aVc2 = aV2 + vo;
        f32x4 sacc[2], oacc[4];
#pragma unroll
        for (int j = 0; j < 2; ++j) sacc[j] = (f32x4){0.f, 0.f, 0.f, 0.f};
#pragma unroll
        for (int j = 0; j < 4; ++j) oacc[j] = (f32x4){0.f, 0.f, 0.f, 0.f};
#pragma unroll
        for (int half = 0; half < 2; ++half) {
            if (half == 1) {
                R_WAITV(); lds_barrier();
                if (c + 1 < SEQ / RC) { dma_qk(0, c + 1, 0); dma_v(c + 1); }
            }
            const int qo = half * R_SLOT, ko = qo + R_KO;
            if (jb_a <= ib_a) { __builtin_amdgcn_sched_barrier(0);
                bf16x8 qn[4], k0[4], k1[4];
#pragma unroll
                for (int s = 0; s < 4; ++s) { qn[s] = *(const LAS bf16x8*)(uintptr_t)(aQ[s] + qo + 16 * ib_a * 256); k0[s] = *(const LAS bf16x8*)(uintptr_t)(aQ[s] + ko + 16 * jb_a * 256);
                    if (jb_a + 1 <= ib_a) k1[s] = *(const LAS bf16x8*)(uintptr_t)(aQ[s] + ko + (16 * jb_a + 16) * 256); }
                __builtin_amdgcn_sched_barrier(0);
#pragma unroll
                for (int s = 0; s < 4; ++s) { sacc[0] = MFMA16(k0[s], qn[s], sacc[0]); if (jb_a + 1 <= ib_a) sacc[1] = MFMA16(k1[s], qn[s], sacc[1]); }
            }
#pragma unroll
            for (int u0 = 0; u0 < 4; u0 += 2) { __builtin_amdgcn_sched_barrier(0);
                bf16x8 qf[2][4];
#pragma unroll
                for (int uu = 0; uu < 2; ++uu)
#pragma unroll
                    for (int i = 0; i < 4; ++i) qf[uu][i] = r64_pair(aP[u0 + uu][0], aP[u0 + uu][1], qo + 16 * i * 256);
                R_LGKM8(qf[0][0], qf[0][1], qf[0][2], qf[0][3], qf[1][0], qf[1][1], qf[1][2], qf[1][3]);
                __builtin_amdgcn_sched_barrier(0);
#pragma unroll
                for (int uu = 0; uu < 2; ++uu) { const int u = u0 + uu;
                    const f32x4 x0 = st[8 * half + 2 * u], x1 = st[8 * half + 2 * u + 1];
                    u32x4 pw; pw.x = cvt_pk_bf16(x0.x, x0.y); pw.y = cvt_pk_bf16(x0.z, x0.w); pw.z = cvt_pk_bf16(x1.x, x1.y); pw.w = cvt_pk_bf16(x1.z, x1.w);
                    const bf16x8 sf = __builtin_bit_cast(bf16x8, pw);
#pragma unroll
                    for (int i = 0; i < 4; ++i) oacc[i] = MFMA16(sf, qf[uu][i], oacc[i]); }
            }
#pragma unroll
            for (int s = 0; s < 2; ++s) { __builtin_amdgcn_sched_barrier(0);
                bf16x8 vf = tr_pair(aVc, aVc2, s * 8192);
                bf16x8 kt[8];
#pragma unroll
                for (int t = 0; t < 8; ++t) kt[t] = tr_pair(aT[t], aT2[t], ko + s * 8192);
                R_LGKM9(vf, kt[0], kt[1], kt[2], kt[3], kt[4], kt[5], kt[6], kt[7]);
                __builtin_amdgcn_sched_barrier(0);
#pragma unroll
                for (int t = 0; t < 8; ++t) st[8 * half + t] = MFMA16(kt[t], vf, st[8 * half + t]); }
            __builtin_amdgcn_sched_barrier(0);
#pragma unroll
            for (int t = 0; t < 8; ++t) st[8 * half + t] = st[8 * half + t] * gC;
        }
#pragma unroll
        for (int jj = 0; jj < 2; ++jj) { const int jb = jb_a + jj;
            f32x4 p = sacc[jj];
            if (jb > ib_a) p = (f32x4){0.f, 0.f, 0.f, 0.f};
            else if (jb == ib_a) {
#pragma unroll
                for (int e = 0; e < 4; ++e) if (4 * g + e > i16) p[e] = 0.f; }
            *(LAS u32x2*)(lds + R_P + (16 * ib_a + i16) * R_PP + (16 * jb + 4 * g) * 2) = pack4(p);
        }
        lds_barrier();
        {
            __builtin_amdgcn_sched_barrier(0);
            bf16x8 v0 = tr_pair(aVc, aVc2, 0), v1 = tr_pair(aVc, aVc2, 8192);
            bf16x8 p0[4], p1[2];
#pragma unroll
            for (int i = 0; i < 4; ++i) p0[i] = *(const LAS bf16x8*)(lds + R_P + (16 * i + i16) * R_PP + 16 * g);
#pragma unroll
            for (int i = 0; i < 2; ++i) p1[i] = *(const LAS bf16x8*)(lds + R_P + (16 * (i + 2) + i16) * R_PP + 64 + 16 * g);
            R_LGKM2(v0, v1);
            __builtin_amdgcn_sched_barrier(0);
#pragma unroll
            for (int i = 0; i < 4; ++i) oacc[i] = MFMA16(v0, p0[i], oacc[i]);
#pragma unroll
            for (int i = 0; i < 2; ++i) oacc[i + 2] = MFMA16(v1, p1[i], oacc[i + 2]);
        }
#pragma unroll
        for (int ib = 0; ib < 4; ++ib) {
            __builtin_amdgcn_sched_barrier(0);
            const f32x4 o = oacc[ib] * fast_exp2((float)(16 * ib + i16 + 1) * l2g);
            *(u32x2*)(Vh + (size_t)(c * RC + 16 * ib + i16) * ODD_MIX + 16 * wid + 4 * g) = pack4(o);
            const float s1 = red_fq(sum4(o)), s2 = red_fq(dot4(o));
            if (g == 0) *(LAS f32x2*)(tab + ((16 * ib + i16) * 8 + wid) * 2) = (f32x2){s1, s2};
        }
    }
    }
    lds_barrier();
    { int tid = tid0; asm volatile("" : "+v"(tid));
      if (tid < RC) { float s1 = 0.f, s2 = 0.f;
#pragma unroll
          for (int w = 0; w < 8; ++w) { const f32x2 v = *(const LAS f32x2*)(tab + (tid * 8 + w) * 2); s1 += v.x; s2 += v.y; }
          *(f32x2*)(gnh + (size_t)((SEQ / RC - 1) * RC + tid) * 32) = (f32x2){s1, s2}; } }
    lds_barrier();
}

enum { MAP_ID = 0, MAP_GU = 1, MAP_E1 = 2, MAP_S2Q = 3, MAP_S2KV = 4 };
template <int MAP> DI int map_src(int n, int& sel) {
    sel = 0;
    if (MAP == MAP_ID) return n;
    const int t = n >> 8, r = n & 255, bj = r >> 7, wc = (r & 127) >> 5, p = r & 31, fq = p >> 3, nn = (p >> 2) & 1, j = p & 3;
    const int rl = 16 * nn + 4 * fq + j;
    if (MAP == MAP_GU) { sel = bj; return t * 128 + (r & 127); }
    if (MAP == MAP_E1) {
        if (t < 4) return (bj ? CONV_DIM : 0) + t * 128 + (r & 127);
        if (t == 4) return 2 * CONV_DIM + r;
        if (r < 128) return 2 * CONV_DIM + QLORA + r;
        if (r < 160) return 2 * CONV_DIM + QLORA + KVLORA + rl;
        return -1;
    }
    const int ws = t * 4 + wc;
    if (MAP == MAP_S2Q) { if (ws < 8) return ws * 96 + 32 * bj + p; return (2 * (ws - 8) + bj) * 96 + 64 + rl; }
      if (ws < 8) return ws * 128 + 32 * bj + p; return (ws - 8) * 128 + 64 + 32 * bj + p;
}
template <int MAP> DI void cvt_matrix(const float* W0, const float* W1, int ldw, int krows, int koff, bf16_t* dst, int ldd, int nrows, const float* gain, float scale, int gw, int NGW, int lane, int& rot) {
    const int nkb = ldd >> 6, nitems = (nrows >> 6) * nkb;
    int first = (gw - rot % NGW + NGW) % NGW; rot += nitems;
    for (int it = first; it < nitems; it += NGW) {
        const int nb = it / nkb, kb = it - nb * nkb, n = nb * 64 + lane; int sel; const int src = map_src<MAP>(n, sel);
        const float* W = sel ? W1 : W0; bf16_t* drow = dst + (size_t)n * ldd + kb * 64;
        float v[64];
#pragma unroll
        for (int i = 0; i < 64; ++i) { const int k = kb * 64 + i - koff; const bool ok = (src >= 0) && (k >= 0) && (k < krows); const int kk = ok ? k : 0;
            const float wv = W[(size_t)kk * ldw + (src >= 0 ? src : 0)]; const float gv = gain ? gain[kk] : 1.0f; v[i] = ok ? wv * gv * scale : 0.f; }
#pragma unroll
        for (int kc = 0; kc < 8; ++kc) { u32x4 o; o.x = cvt_pk_bf16(v[8 * kc], v[8 * kc + 1]); o.y = cvt_pk_bf16(v[8 * kc + 2], v[8 * kc + 3]); o.z = cvt_pk_bf16(v[8 * kc + 4], v[8 * kc + 5]); o.w = cvt_pk_bf16(v[8 * kc + 6], v[8 * kc + 7]);
            *(u32x4*)(drow + kc * 8) = o; }
    }
}

struct Args { const float* in[38]; float* out; unsigned char* ws; };
struct Frame {
    LAS unsigned char* lds; int tid, lane, wave, vcu, G;
    int c, x, j, local; mutable int dir;
};

DI void p0_prologue(const Args& a, const Frame& F) {
    unsigned char* ws = a.ws;
    const int gw = F.vcu * 8 + F.wave, NGW = F.G * 8, lane = F.lane; int rot = 0;
    const size_t DD = (size_t)D * D, DF = (size_t)D * DFF;
    for (int l = 0; l < DEPTH; ++l) {
        bf16_t* wl = (bf16_t*)(ws + WS_W + l * W_LAYER);
        cvt_matrix<MAP_GU>(a.in[4] + l * DF, a.in[5] + l * DF, DFF, D, 0, (bf16_t*)((char*)wl + WO_GU1), D, 2 * DFF, a.in[3] + l * D, 1.0f, gw, NGW, lane, rot);
        cvt_matrix<MAP_ID>(a.in[6] + l * DF, nullptr, D, DFF, 0, (bf16_t*)((char*)wl + WO_D1), DFF, D, nullptr, 0.5f, gw, NGW, lane, rot);
        cvt_matrix<MAP_GU>(a.in[8] + l * DF, a.in[9] + l * DF, DFF, D, 0, (bf16_t*)((char*)wl + WO_GU2), D, 2 * DFF, a.in[7] + l * D, 1.0f, gw, NGW, lane, rot);
        cvt_matrix<MAP_ID>(a.in[10] + l * DF, nullptr, D, DFF, 0, (bf16_t*)((char*)wl + WO_D2), DFF, D, nullptr, 0.5f, gw, NGW, lane, rot);
        cvt_matrix<MAP_ID>(a.in[14] + l * DD, nullptr, D, D, 0, (bf16_t*)((char*)wl + WO_Q), D, D, a.in[12] + l * D, 1.0f, gw, NGW, lane, rot);
        cvt_matrix<MAP_ID>(a.in[17] + l * DD, nullptr, D, D, 0, (bf16_t*)((char*)wl + WO_O), D, D, nullptr, 1.0f, gw, NGW, lane, rot);
        cvt_matrix<MAP_ID>(a.in[15] + l * DD, nullptr, D, D, 0, (bf16_t*)(ws + WS_ACT + A_WK) + l * DD, D, D, a.in[13] + l * D, 1.0f, gw, NGW, lane, rot);
        cvt_matrix<MAP_ID>(a.in[16] + l * DD, nullptr, D, D, 0, (bf16_t*)(ws + WS_ACT + A_WV) + l * DD, D, D, a.in[13] + l * D, 1.0f, gw, NGW, lane, rot);
    }
    for (int e = 0; e < 2; ++e) {
        char* we = (char*)(ws + WS_WE + e * W_EVEN);
        cvt_matrix<MAP_E1>(a.in[20] + (size_t)e * D * EVEN_IN, nullptr, EVEN_IN, D, 0, (bf16_t*)(we + WE_IN), D, EVEN_INP, a.in[11] + (2 * e) * D, 1.0f, gw, NGW, lane, rot);
        cvt_matrix<MAP_S2Q>(a.in[26] + (size_t)e * QLORA * 768, nullptr, 768, QLORA, 0, (bf16_t*)(we + WE_S2), S2K, 768, a.in[25] + e * QLORA, 1.0f, gw, NGW, lane, rot);
        cvt_matrix<MAP_S2KV>(a.in[28] + (size_t)e * KVLORA * 1024, nullptr, 1024, KVLORA, QLORA, (bf16_t*)(we + WE_S2) + (size_t)768 * S2K, S2K, 1024, a.in[27] + e * KVLORA, 1.0f, gw, NGW, lane, rot);
        cvt_matrix<MAP_ID>(a.in[33] + (size_t)e * DD, nullptr, D, D, 0, (bf16_t*)(we + WE_OUT), D, D, nullptr, 1.0f, gw, NGW, lane, rot);
    }
    for (int o = 0; o < 2; ++o) {
        char* wo = (char*)(ws + WS_WO + o * W_ODD);
        cvt_matrix<MAP_ID>(a.in[34] + (size_t)o * D * ODD_IN, nullptr, ODD_IN, D, 0, (bf16_t*)(wo + WOD_IN), D, ODD_IN, a.in[11] + (2 * o + 1) * D, 1.0f, gw, NGW, lane, rot);
        cvt_matrix<MAP_ID>(a.in[37] + (size_t)o * ODD_MIX * D, nullptr, D, ODD_MIX, 0, (bf16_t*)(wo + WOD_OUT), ODD_MIX, D, nullptr, 1.0f, gw, NGW, lane, rot);
    }
    { const float* x = a.in[0]; bf16_t* xb = (bf16_t*)(ws + WS_XB); float* ssq = (float*)(ws + WS_SSQ);
      for (int m0 = gw * 4; m0 < M; m0 += NGW * 4) { f32x4 v[4][4];
#pragma unroll
          for (int r = 0; r < 4; ++r)
#pragma unroll
              for (int j = 0; j < 4; ++j) v[r][j] = ((const f32x4*)(x + (size_t)(m0 + r) * D) + lane)[64 * j];
#pragma unroll
          for (int r = 0; r < 4; ++r) { float s = 0.f;
#pragma unroll
              for (int j = 0; j < 4; ++j) { s += dot4(v[r][j]); *(u32x2*)(xb + (size_t)(m0 + r) * D + 256 * j + 4 * lane) = pack4(v[r][j]); }
              s = wave_sum(s); if (lane < 16) ssq[(size_t)(m0 + r) * 16 + lane] = lane == 0 ? s : 0.f; } } }
    { const float* x = a.in[1]; bf16_t* xb = (bf16_t*)(ws + WS_MEMB); float* rm = (float*)(ws + WS_RMEM);
      for (int m = gw; m < MM; m += NGW) { const f32x4* xr = (const f32x4*)(x + (size_t)m * D) + lane; float s = 0.f;
#pragma unroll
          for (int j = 0; j < 4; ++j) { const f32x4 v = xr[64 * j]; s += dot4(v); *(u32x2*)(xb + (size_t)m * D + 256 * j + 4 * lane) = pack4(v); }
          s = wave_sum(s); if (lane == 0) rm[m] = 1.0f / sqrtf(s * (1.0f / D) + EPS); } }
    if (gw == 0 && lane < 2) { const int e = lane; float mqn = 0.f, mkn = 0.f, mqr = 0.f, mkr = 0.f;
        for (int i = 0; i < QK_NOPE; ++i) { mqn = fmaxf(mqn, fabsf(a.in[29][e * QK_NOPE + i])); mkn = fmaxf(mkn, fabsf(a.in[30][e * QK_NOPE + i])); }
        for (int i = 0; i < QK_ROPE; ++i) { mqr = fmaxf(mqr, fabsf(a.in[31][e * QK_ROPE + i])); mkr = fmaxf(mkr, fabsf(a.in[32][e * QK_ROPE + i])); }
        const float bq = sqrtf(64.f * mqn * mqn + 32.f * mqr * mqr), bk = sqrtf(64.f * mkn * mkn + 32.f * mkr * mkr);
        ((float*)(ws + WS_CTL))[CW_SHE + e] = bq * bk * (LOG2E / sqrtf(96.0f)); }
}
DI void p2_finalize(const Args& a, const Frame& F) {
    unsigned char* ws = a.ws; bf16_t* kp = (bf16_t*)(ws + WS_KP); const float* kss = (const float*)(ws + WS_KSS); unsigned* kmax = (unsigned*)(ws + WS_CTL) + CW_KMAX;
    const int gw = F.vcu * 8 + F.wave, NGW = F.G * 8, lane = F.lane;
    for (int it = gw; it < DEPTH * MM * XH; it += NGW) { const int hh = it & 3, row = it >> 2;
        const float rk = rstd4(kss + (size_t)row * 16 + hh * 4, 1.0f / XHD);
        u32x2* p = (u32x2*)(kp + (size_t)row * D + hh * 256 + 4 * lane); const u32x2 w = *p;
        const u32x2 o = (u32x2){cvt_pk_bf16(bf_lo(w.x) * rk, bf_hi(w.x) * rk), cvt_pk_bf16(bf_lo(w.y) * rk, bf_hi(w.y) * rk)};
        *p = o;
        float s = bf_lo(o.x) * bf_lo(o.x) + bf_hi(o.x) * bf_hi(o.x) + bf_lo(o.y) * bf_lo(o.y) + bf_hi(o.y) * bf_hi(o.y);
        s = wave_sum(s);
        if (lane == 0) { const int l = row / MM, bb = (row % MM) / MEMLEN; __hip_atomic_fetch_max(kmax + l * 64 + bb * 4 + hh, __float_as_uint(sqrtf(s) * 1.0001f), __ATOMIC_RELAXED, __HIP_MEMORY_SCOPE_AGENT); } }
}

#define WSP(T, off) ((T*)(ws + (off)))
#define WS_LOCAL() GAS unsigned char* wsg_ = (GAS unsigned char*)ws_; asm volatile("" : "+s"(wsg_)); unsigned char* ws = (unsigned char*)wsg_
#ifndef SITE
#define SITE 0
#endif
#define SITE_ON(k) (SITE == 0 || SITE == (k))
using pg8::Cfg; using pg8::CfgStd; using pg8::CfgStdRev;
typedef CfgStd<M, 2 * DFF, D, D, D> CfgF1;
typedef CfgStd<M, D, DFF, DFF, DFF> CfgF2;
typedef CfgStd<M, D, D, D, D> CfgDD;
typedef CfgStd<M, EVEN_INP, D, D, D> CfgE1;
typedef CfgStd<M, S2N, S2K, S2K, S2K> CfgE2;
typedef CfgStd<M, 4096, D, D, D> CfgO1;
typedef CfgStd<M, ODD_MIX, D, D, D> CfgO3;
typedef CfgStd<M, D, ODD_MIX, ODD_MIX, ODD_MIX> CfgO4;
typedef Cfg<M / 256, XH, D, D, XHD, -1, 31, 256L * D, 0, 256, 4, 256L * D, 256> CfgXS;
typedef Cfg<NB * 4, XH, D, D, XHD, 3, 31, 256L * D, 0, 256, 2, 256L * D, 256> CfgVW;
typedef Cfg<M / 256, XH, D, D, D, -1, 31, 256L * D, 0, 0, 4, (long)D * D, 256L * D> CfgXF;
typedef Cfg<DEPTH * (MM / 256), XH, D, D, D, 15, 31, 256L * D, 0, 0, 4, (long)D * D, 256L * D> CfgMK;

constexpr size_t SLAB = 64 * MiB; constexpr int XROWS = M / 8;
#define ACTP(off, pitch) ((bf16_t*)(ws + WS_ACT + (size_t)F.x * SLAB + (off) / 8) - (size_t)F.x * XROWS * (pitch))
#define PBAR() do { if (__builtin_amdgcn_readfirstlane((int)bar.st[3])) xcd_local_barrier(bar); else xcd_barrier(bar); } while (0)

DI void ffn_block(const Args& a, const Frame& F, const XcdBarrier& bar, int l, int half, bool final) {
    unsigned char* ws_ = a.ws; const int c = F.c;
#define wgu ((const bf16_t*)(ws + WS_W + l * W_LAYER + (half ? WO_GU2 : WO_GU1)))
#define wd ((const bf16_t*)(ws + WS_W + l * W_LAYER + (half ? WO_D2 : WO_D1)))
    if (SITE_ON(1)) { WS_LOCAL(); pg8::Gemm g{WSP(const bf16_t, WS_XB), wgu};
      const int d = (F.dir ^= 1); constexpr bool tb = true;     auto hk = [&]() { row_tables(F.lds, WSP(const float, WS_SSQ), nullptr, F.x, F.j, d); };
      EpiSwiGLU E{ACTP(A_H, DFF), WSP(const float, WS_SSQ), tb ? (const LAS float*)(F.lds + RT_OFF) : nullptr}; pg8::gemm_phase<CfgF1>(F.lds, g, F.G, c, E, d, hk); }
    PBAR();
    if (SITE_ON(2)) { WS_LOCAL(); pg8::Gemm g{ACTP(A_H, DFF), wd};
      if (final) { EpiResid<true> E{WSP(bf16_t, WS_XB), WSP(float, WS_SSQ), a.out}; pg8::gemm_phase<CfgF2>(F.lds, g, F.G, c, E, (F.dir ^= 1)); }
      else { EpiResid<false> E{WSP(bf16_t, WS_XB), WSP(float, WS_SSQ), a.out}; pg8::gemm_phase<CfgF2>(F.lds, g, F.G, c, E, (F.dir ^= 1)); } }
    PBAR();
}
DI void even_block(const Args& a, const Frame& F, const XcdBarrier& bar, int l) {
    unsigned char* ws_ = a.ws; const int c = F.c, e = l >> 1;
#define pos ((const int*)INP(2))
#define we (ws + WS_WE + e * W_EVEN)
    if (SITE_ON(3)) { WS_LOCAL(); pg8::Gemm g{WSP(const bf16_t, WS_XB), (const bf16_t*)(we + WE_IN)};
      const int d = (F.dir ^= 1); constexpr bool tb = true;     auto hk = [&]() { row_tables(F.lds, WSP(const float, WS_SSQ), pos, F.x, F.j, d); };
      EpiEven1 E{ACTP(A_AB, CONV_DIM), ACTP(A_ZC, S2K), ACTP(A_KR, QK_ROPE), WSP(const float, WS_SSQ), WSP(float, WS_ZS), INP(32) + e * QK_ROPE, pos, tb ? (const LAS float*)(F.lds + RT_OFF) : nullptr, tb ? (const LAS float*)(F.lds + PT_OFF) : nullptr};
      pg8::gemm_phase<CfgE1>(F.lds, g, F.G, c, E, d, hk); }
    PBAR();
    if (SITE_ON(4)) { WS_LOCAL(); pg8::Gemm g{ACTP(A_ZC, S2K), (const bf16_t*)(we + WE_S2)};
      EpiEven2 E{ACTP(A_QH, 768), ACTP(A_KN, 512), ACTP(A_VB, 512), WSP(const float, WS_ZS), INP(29) + e * QK_NOPE, INP(31) + e * QK_ROPE, INP(30) + e * QK_NOPE, pos, LOG2E * 0.10206207261596575f};
      pg8::gemm_phase<CfgE2>(F.lds, g, F.G, c, E, (F.dir ^= 1)); }
    if (SITE_ON(5)) { WS_LOCAL(); for (int q = c; q < M / 32; q += F.G) { const int n = q >> 3;
        conv_tile(F.lds, ACTP(A_AB, CONV_DIM), ACTP(A_MIX, 1024), INP(21) + e * CONV_W * CONV_DIM, INP(22) + e * CONV_DIM, INP(23) + e * CONV_DIM, INP(24) + e * CONV_DIM, F.x * (M / 32 / 8) + n); } }
    PBAR();
    if (SITE_ON(6)) { WS_LOCAL(); const float shift = WSP(const float, WS_CTL)[CW_SHE + e];
      for (int q = c; q < NB * MLA_H * 8; q += F.G) { const int n = q >> 3, b = 2 * F.x + (n >> 6), h = (n >> 3) & 7, pr = n & 7;
          attn_unit(F.lds, ACTP(A_QH, 768), ACTP(A_KN, 512), ACTP(A_KR, QK_ROPE), ACTP(A_VB, 512), ACTP(A_MIX, 1024), b, h, pr, shift);
          attn_unit(F.lds, ACTP(A_QH, 768), ACTP(A_KN, 512), ACTP(A_KR, QK_ROPE), ACTP(A_VB, 512), ACTP(A_MIX, 1024), b, h, 15 - pr, shift); } }
    PBAR();
    if (SITE_ON(7)) { WS_LOCAL(); pg8::Gemm g{ACTP(A_MIX, 1024), (const bf16_t*)(we + WE_OUT)};
      EpiResid<false> E{WSP(bf16_t, WS_XB), WSP(float, WS_SSQ), a.out}; pg8::gemm_phase<CfgDD>(F.lds, g, F.G, c, E, (F.dir ^= 1)); }
    PBAR();
}
DI void odd_block(const Args& a, const Frame& F, const XcdBarrier& bar, int l) {
    unsigned char* ws_ = a.ws; const int c = F.c, o = l >> 1;
#define wo (ws + WS_WO + o * W_ODD)
    if (SITE_ON(8)) { WS_LOCAL(); pg8::Gemm g{WSP(const bf16_t, WS_XB), (const bf16_t*)(wo + WOD_IN)};
      const int d = (F.dir ^= 1); constexpr bool tb = true;     auto hk = [&]() { row_tables(F.lds, WSP(const float, WS_SSQ), pos, F.x, F.j, d); };
      EpiOdd1 E{ACTP(A_RQ, 1024), ACTP(A_RK, 1024), ACTP(A_RV, ODD_MIX), WSP(const float, WS_SSQ), pos, tb ? (const LAS float*)(F.lds + RT_OFF) : nullptr, tb ? (const LAS float*)(F.lds + PT_OFF) : nullptr}; pg8::gemm_phase<CfgO1>(F.lds, g, F.G, c, E, d, hk); }
    PBAR();
    if (SITE_ON(9)) { WS_LOCAL(); for (int q = c; q < NB * RET_H * 4; q += F.G) { const int n = q >> 3;
        retention_unit(F.lds, ACTP(A_RQ, 1024), ACTP(A_RK, 1024), ACTP(A_RV, ODD_MIX), WSP(float, WS_GNS), 2 * F.x + (n >> 4), (n >> 2) & 3, n & 3); } }
    PBAR();
    if (SITE_ON(10)) { WS_LOCAL(); pg8::Gemm g{WSP(const bf16_t, WS_XB), (const bf16_t*)(wo + WOD_IN) + (size_t)4096 * D};
      const int d = (F.dir ^= 1);
      auto hk = [&]() { { const int t = opaque_tid(); const int gcol = ((F.j >> 3) + 4 * (t >> 8)) * 256 + (t & 255); LAS float* gt = (LAS float*)(F.lds + PT_OFF);
                          gt[t] = (INP(35) + o * ODD_MIX)[gcol]; gt[512 + t] = (INP(36) + o * ODD_MIX)[gcol]; }
                        row_tables(F.lds, WSP(const float, WS_SSQ), nullptr, F.x, F.j, d); };
      EpiGate E{ACTP(A_RV, ODD_MIX), WSP(const float, WS_GNS), (const LAS float*)(F.lds + RT_OFF), (const LAS float*)(F.lds + PT_OFF)}; pg8::gemm_phase<CfgO3>(F.lds, g, F.G, c, E, d, hk); }
    PBAR();
    if (SITE_ON(11)) { WS_LOCAL(); pg8::Gemm g{ACTP(A_RV, ODD_MIX), (const bf16_t*)(wo + WOD_OUT)};
      EpiResid<false> E{WSP(bf16_t, WS_XB), WSP(float, WS_SSQ), a.out}; pg8::gemm_phase<CfgO4>(F.lds, g, F.G, c, E, (F.dir ^= 1)); }
    PBAR();
}
DI void xattn_block(const Args& a, const Frame& F, const XcdBarrier& bar, int l) {
    unsigned char* ws_ = a.ws; const int c = F.c;
#define wl (ws + WS_W + l * W_LAYER)
    if (SITE_ON(12)) { WS_LOCAL(); pg8::Gemm g{WSP(const bf16_t, WS_XB), (const bf16_t*)(wl + WO_Q)};
      const int d = (F.dir ^= 1); constexpr bool tb = true;     auto hk = [&]() { row_tables(F.lds, WSP(const float, WS_SSQ), nullptr, F.x, F.j, d); };
      EpiQraw E{ACTP(A_XQ, 1024), WSP(const float, WS_SSQ), WSP(float, WS_QSS), tb ? (const LAS float*)(F.lds + RT_OFF) : nullptr}; pg8::gemm_phase<CfgDD>(F.lds, g, F.G, c, E, d, hk); }
    if (SITE_ON(14)) { WS_LOCAL(); pg8::Gemm g{(const bf16_t*)(wl + WO_O), WSP(const bf16_t, WS_VT) + (size_t)l * MM * D};
      EpiVW E{WSP(bf16_t, WS_VW)}; pg8::gemm_phase<CfgVW>(F.lds, g, F.G, c, E, 0); }
    cu_local_seam();
    if (SITE_ON(13)) { WS_LOCAL(); pg8::Gemm g{ACTP(A_XQ, 1024), WSP(const bf16_t, WS_KP) + (size_t)l * MM * D};
      auto hk = [&]() { score_tables(F.lds, WSP(const float, WS_QSS), WSP(const unsigned, WS_CTL) + CW_KMAX + l * 64, F.x, F.j, F.dir); };
      EpiScoresN E{ACTP(A_XP, 1024), (const LAS float*)(F.lds + RT_OFF), (LAS float*)(F.lds + RING_BYTES)}; pg8::gemm_phase<CfgXS>(F.lds, g, F.G, c, E, F.dir, hk); }
    PBAR();
    if (SITE_ON(15)) { WS_LOCAL(); pg8::Gemm g{ACTP(A_XP, 1024), WSP(const bf16_t, WS_VW)};
      EpiResid<false> E{WSP(bf16_t, WS_XB), WSP(float, WS_SSQ), a.out}; pg8::gemm_phase<CfgXF>(F.lds, g, F.G, c, E, (F.dir ^= 1)); }
    PBAR();
}

__global__ void __launch_bounds__(512, 2) fwd_kernel(Args a) {
    extern __shared__ __attribute__((aligned(16))) unsigned char lds_raw[];
    Frame F; F.lds = (LAS unsigned char*)lds_raw; F.tid = threadIdx.x; F.lane = F.tid & 63; F.wave = __builtin_amdgcn_readfirstlane(F.tid >> 6);
    F.G = gridDim.x; { const int bx = blockIdx.x; F.vcu = (F.G % 8 == 0) ? (bx % 8) * (F.G / 8) + bx / 8 : bx; }
    F.c = blockIdx.x; F.x = 0; F.j = 0; F.local = 0; F.dir = 1;
    unsigned char* ws_ = a.ws; unsigned char* ws = ws_;
    if (F.tid < 64) ((LAS unsigned*)(F.lds + LDSCTL_OFF))[F.tid] = 0u;
    if (F.tid < 38) ((const float**)(ws + WS_CTL + CW_TAB * 4))[F.tid] = a.in[F.tid];
    __syncthreads();
    const XcdBarrier bar = xcd_barrier_post(WSP(unsigned, WS_CTL) + CW_BAR, (volatile LAS unsigned*)(F.lds + LDSCTL_OFF));
    if (SITE_ON(16)) p0_prologue(a, F);
    xcd_barrier(bar);
    if (SITE_ON(17)) { WS_LOCAL(); pg8::Gemm g{WSP(const bf16_t, WS_MEMB), WSP(const bf16_t, WS_ACT + A_WK)};
      EpiMemK E{WSP(bf16_t, WS_KP), WSP(const float, WS_RMEM), WSP(float, WS_KSS), INP(19), INP(18)}; pg8::gemm_phase<CfgMK>(F.lds, g, F.G, blockIdx.x, E); }
    if (SITE_ON(18)) { WS_LOCAL(); pg8::Gemm g{WSP(const bf16_t, WS_MEMB), WSP(const bf16_t, WS_ACT + A_WV)};
      EpiMemV E{WSP(bf16_t, WS_VT), WSP(const float, WS_RMEM)}; pg8::gemm_phase<CfgMK>(F.lds, g, F.G, blockIdx.x, E); }
    xcd_barrier(bar);
    if (SITE_ON(19)) p2_finalize(a, F);
    { volatile LAS unsigned* st = (volatile LAS unsigned*)(F.lds + LDSCTL_OFF);
      if (F.tid == 0) { unsigned ok = (F.G % 8 == 0) ? 1u : 0u; unsigned* bw = WSP(unsigned, WS_CTL) + CW_BAR;
#pragma unroll
          for (unsigned jx = 0; jx < 16; ++jx) { const unsigned cnt = xb_ld(&bw[XB_XCNT(jx)]); ok &= (jx < 8u) ? (cnt == (unsigned)F.G / 8u) : (cnt == 0u); }
          ok &= (xb_ld(&bw[XB_TMO]) == 0u) ? 1u : 0u;
          st[3] = ok; st[4] = 0u; }
      __syncthreads();
      if (st[3] != 0u) { F.local = 1; F.x = (int)bar.x; F.j = (int)st[2]; F.c = 8 * F.j + F.x; }
      else { F.local = 0; F.c = blockIdx.x; F.x = F.c & 7; F.j = F.c >> 3; }
      F.x = __builtin_amdgcn_readfirstlane(F.x); F.j = __builtin_amdgcn_readfirstlane(F.j); F.c = __builtin_amdgcn_readfirstlane(F.c); F.local = __builtin_amdgcn_readfirstlane(F.local); }
    xcd_barrier(bar);
    for (int l = 0; l < DEPTH; ++l) {
        ffn_block(a, F, bar, l, 0, false);
        if (l & 1) odd_block(a, F, bar, l); else even_block(a, F, bar, l);
        xattn_block(a, F, bar, l);
        ffn_block(a, F, bar, l, 1, l == DEPTH - 1);
    }
}

extern "C" void kernel_launch(void* const* d_in, const int* in_sizes, int n_in, void* d_out, int out_size, void* d_ws, size_t ws_size, hipStream_t stream) {
    static int grid = 0;
    if (grid == 0) {
        if (n_in != 38 || out_size != M * D || ws_size < WS_END) { fprintf(stderr, "kernel_launch: unexpected problem (n_in %d, out %d, ws %zu < %zu)\n", n_in, out_size, ws_size, (size_t)WS_END); grid = -1; return; }
        int dev = 0, cus = 0, per_cu = 0;
        if (hipGetDevice(&dev) != hipSuccess || hipDeviceGetAttribute(&cus, hipDeviceAttributeMultiprocessorCount, dev) != hipSuccess) { grid = -1; return; }
        if (cus != 256) { fprintf(stderr, "kernel_launch: this build needs 256 compute units (one workgroup each; the per-phase row tables assume it), found %d\n", cus); grid = -1; return; }
        if (hipFuncSetAttribute((const void*)fwd_kernel, hipFuncAttributeMaxDynamicSharedMemorySize, LDS_BYTES) != hipSuccess) { fprintf(stderr, "kernel_launch: hipFuncSetAttribute failed\n"); grid = -1; return; }
        if (hipOccupancyMaxActiveBlocksPerMultiprocessor(&per_cu, (const void*)fwd_kernel, 512, LDS_BYTES) != hipSuccess || per_cu < 1) fprintf(stderr, "kernel_launch: occupancy query reports %d blocks per CU\n", per_cu);
        (void)hipGetLastError();
        grid = cus;
    }
    if (grid < 0) return;
    if (hipMemsetAsync((char*)d_ws + WS_CTL, 0, CTL_ZERO_BYTES, stream) != hipSuccess) return;
    Args a{};
    for (int i = 0; i < 38; ++i) a.in[i] = (const float*)d_in[i];
    a.out = (float*)d_out; a.ws = (unsigned char*)d_ws;
    hipLaunchKernelGGL(fwd_kernel, dim3(grid), dim3(512), LDS_BYTES, stream, a);
}
```

```cpp
#include <hip/hip_runtime.h>
#include <cstdio>
#include <cstdint>

#define LAS __attribute__((address_space(3)))
#define GAS __attribute__((address_space(1)))
typedef unsigned short bf16_t;
typedef short bf16x8 __attribute__((ext_vector_type(8)));
typedef short s16x4 __attribute__((ext_vector_type(4)));
typedef float f32x4 __attribute__((ext_vector_type(4)));
typedef float f32x2 __attribute__((ext_vector_type(2)));
typedef float f32x16 __attribute__((ext_vector_type(16)));
typedef unsigned u32x4 __attribute__((ext_vector_type(4)));
typedef unsigned u32x2 __attribute__((ext_vector_type(2)));
#define DI __device__ __forceinline__

constexpr int D = 1024, NB = 16, SEQ = 4096, DEPTH = 4, MEMLEN = 256, DFF = 2816;
constexpr int M = NB * SEQ;
constexpr int MM = NB * MEMLEN;
constexpr float EPS = 1e-6f;
constexpr float LOG2E = 1.4426950408889634f;
constexpr int CONV_DIM = 512, CONV_W = 31, MLA_H = 8, QLORA = 256, KVLORA = 128, QK_NOPE = 64, QK_ROPE = 32, VHEAD = 64;
constexpr int EVEN_IN = 1440, EVEN_INP = 1536, S2N = 1792, S2K = 384;
constexpr int RET_H = 4, RET_QK = 256, RET_V = 512, RET_C = 128, ODD_MIX = 2048, ODD_IN = 6144;
constexpr int XH = 4, XHD = 256;

DI int opaque_tid() { int t = threadIdx.x; asm volatile("" : "+v"(t)); return t; }
DI unsigned cvt_pk_bf16(float lo, float hi) { unsigned r; asm volatile("v_cvt_pk_bf16_f32 %0, %1, %2" : "=v"(r) : "v"(lo), "v"(hi)); return r; }
DI float bf_lo(unsigned w) { return __uint_as_float(w << 16); }
DI float bf_hi(unsigned w) { return __uint_as_float(w & 0xffff0000u); }
DI float fast_exp2(float x) { return __builtin_amdgcn_exp2f(x); }
DI float fast_rcp(float x) { return __builtin_amdgcn_rcpf(x); }
DI float fast_rsq(float x) { return __builtin_amdgcn_rsqf(x); }
DI float sigmoidf_(float x) { return fast_rcp(1.0f + fast_exp2(-x * LOG2E)); }
DI float wave_sum(float v) {
#pragma unroll
    for (int o = 1; o < 64; o <<= 1) v += __shfl_xor(v, o);
    return v;
}
DI void sincos_turns(float ang, float& s, float& c) {
    float t = ang * 0.15915494309189535f; t = t - rintf(t);
    s = __builtin_amdgcn_sinf(t); c = __builtin_amdgcn_cosf(t);
}

namespace pg8 {
constexpr int BM = 256, BK = 64, HALF = 128, HTB = HALF * BK * 2, STAGE_BYTES = 8 * HTB, NXCD = 8, WGM = 8;
__host__ __device__ __forceinline__ int lds_byte(int r, int c) { const int st = (r >> 4) * 2 + (c >> 5), rr = r & 15, cc = c & 31, ob = rr * 64 + cc * 2; return st * 1024 + (ob ^ (((ob >> 9) & 1) << 5)); }
__host__ __device__ __forceinline__ void stage_rc(int b, int& R, int& C) { const int st = b / 1024, sb = b % 1024, swz = sb ^ (((sb >> 9) & 1) << 5); R = (st >> 1) * 16 + swz / 64; C = (st & 1) * 32 + (swz % 64) / 2; }
__host__ __device__ __forceinline__ int perm32(int rho) { const int n = rho >> 4, i = rho & 15; return 8 * (i >> 2) + 4 * n + (i & 3); }

struct Unit { int pm, pn; long aoff, boff; };
struct Gemm { const bf16_t* A; const bf16_t* Bt; };

template <int NM_, int NN_, int LDA_, int LDB_, int K_, int AMASK_, int ASH_, long A_PM_, long A_HI_, long A_PN_, int BSH_, long B_HI_, long B_PN_, bool REV_ = false>
struct Cfg { static constexpr int NM = NM_, NN = NN_, LDA = LDA_, LDB = LDB_, K = K_, AMASK = AMASK_, ASH = ASH_, BSH = BSH_; static constexpr long A_PM = A_PM_, A_HI = A_HI_, A_PN = A_PN_, B_HI = B_HI_, B_PN = B_PN_; static constexpr bool REV = REV_; };
template <int MROWS, int NCOLS, int LDA_, int LDB_, int K_> using CfgStd = Cfg<MROWS / 256, NCOLS / 256, LDA_, LDB_, K_, -1, 31, 256L * LDA_, 0, 0, 31, 0, 256L * LDB_>;
template <int MROWS, int NCOLS, int LDA_, int LDB_, int K_> using CfgStdRev = Cfg<MROWS / 256, NCOLS / 256, LDA_, LDB_, K_, -1, 31, 256L * LDA_, 0, 0, 31, 0, 256L * LDB_, true>;

template <class C> struct Order {
    int G, c, rev;
    DI bool next(int i, Unit& u) const {
        constexpr int nM = C::NM, nN = C::NN, nwg = nM * nN;
        const int L = i * G + c; if (L >= nwg) return false;
        int wgid = L; { constexpr int q = nwg / NXCD, r = nwg % NXCD; const int xcd = wgid % NXCD, off = wgid / NXCD; wgid = (xcd < r ? xcd * (q + 1) : r * (q + 1) + (xcd - r) * q) + off; }
        constexpr int nig = WGM * nN; const int gid = wgid / nig, fm = gid * WGM, gsz = (nM - fm) < WGM ? (nM - fm) : WGM;
        u.pm = fm + ((wgid % nig) % gsz); u.pn = (wgid % nig) / gsz;
        if constexpr (nM % NXCD == 0 && nwg % NXCD == 0) { if (rev) { constexpr int P = nM / NXCD; const int x = u.pm / P; u.pm = x * P + (P - 1 - (u.pm - x * P)); } }
        u.aoff = (long)(u.pm & C::AMASK) * C::A_PM + (long)(u.pm >> C::ASH) * C::A_HI + (long)u.pn * C::A_PN;
        u.boff = (long)(u.pm >> C::BSH) * C::B_HI + (long)u.pn * C::B_PN;
        return true;
    }
};

template <class E, class = void> struct EpiNst { static constexpr int value = 0; };
template <class E> struct EpiNst<E, decltype((void)E::NST)> { static constexpr int value = E::NST; };
template <int N> DI void pg8_waitv() { asm volatile("s_waitcnt vmcnt(%0)" :: "n"(N) : "memory"); }
DI f32x4 zero4() { f32x2 a, b; asm volatile("v_mov_b64 %0, 0" : "=v"(a)); asm volatile("v_mov_b64 %0, 0" : "=v"(b)); return __builtin_shufflevector(a, b, 0, 1, 2, 3); }
struct NoHook { DI void operator()() const {} };
template <class C, class Epi, class Hook = NoHook>
DI void gemm_phase(LAS unsigned char* lds, const Gemm g, const int G_, const int c_, const Epi& E, const int rev_ = 0, const Hook& hk = Hook()) {
    int cq = c_; asm volatile("" : "+s"(cq));
    Order<C> S; S.G = G_; S.c = cq; S.rev = rev_;
    const int tid = opaque_tid(), wid = __builtin_amdgcn_readfirstlane(tid >> 6), lane = tid & 63, wr = wid >> 2, wc = wid & 3, fr = lane & 15, fq = lane >> 4;
    constexpr int K = C::K, nt = K / BK; static_assert(K % 128 == 0 && K >= 256, "K");
    unsigned voffA[2], voffB[2];
#pragma unroll
    for (int i = 0; i < 2; ++i) { int R, Cc; stage_rc(tid * 16 + i * 8192, R, Cc); const int Rb = Epi::PERM ? ((R & ~31) + perm32(R & 31)) : R;
        voffA[i] = (unsigned)(R * C::LDA + Cc) * 2u; voffB[i] = (unsigned)(Rb * C::LDB + Cc) * 2u; }
    constexpr size_t kstep = (size_t)(BK * 2);
    constexpr size_t hstepA = (size_t)HALF * C::LDA * 2, hstepB = (size_t)HALF * C::LDB * 2;
    const unsigned ldsw = (unsigned)wid * 1024u;
    const int aoff = lds_byte(wr * 64 + fr, fq * 8), boff = lds_byte(wc * 32 + fr, fq * 8);
#define PG8_SA(b, h) (((b) * 2 + (h)) * HTB)
#define PG8_SB(b, h) ((4 + (b) * 2 + (h)) * HTB)
#define PG8_STAGE(bufoff, gbase, voff) do { _Pragma("unroll") for (int _i = 0; _i < 2; ++_i) \
        __builtin_amdgcn_global_load_lds((const unsigned*)((const char*)(gbase) + (voff)[_i]), (LAS unsigned*)(lds + (bufoff) + ldsw + _i * 8192), 16, 0, 0); } while (0)
#define PG8_LDA(dst, b, h) do { _Pragma("unroll") for (int m = 0; m < 4; ++m) _Pragma("unroll") for (int k = 0; k < 2; ++k) dst[m][k] = *(const LAS bf16x8*)(lds + PG8_SA(b, h) + aoff + m * 2048 + k * 1024); } while (0)
#define PG8_LDB(dst, b, h) do { _Pragma("unroll") for (int n = 0; n < 2; ++n) _Pragma("unroll") for (int k = 0; k < 2; ++k) dst[n][k] = *(const LAS bf16x8*)(lds + PG8_SB(b, h) + boff + n * 2048 + k * 1024); } while (0)
#define PG8_MMA(ai, bj, At, Bt) do { __builtin_amdgcn_s_setprio(1); _Pragma("unroll") for (int m = 0; m < 4; ++m) _Pragma("unroll") for (int n = 0; n < 2; ++n) _Pragma("unroll") for (int k = 0; k < 2; ++k) \
        acc[ai][bj][m][n] = __builtin_amdgcn_mfma_f32_16x16x32_bf16(Bt[n][k], At[m][k], acc[ai][bj][m][n], 0, 0, 0); __builtin_amdgcn_s_setprio(0); } while (0)
#define PG8_WAIT_V(n) asm volatile("s_waitcnt vmcnt(" #n ")" ::: "memory")
#define PG8_WAIT_L(n) asm volatile("s_waitcnt lgkmcnt(" #n ")" ::: "memory")
#define PG8_BAR __builtin_amdgcn_s_barrier()
#define PG8_SCHED __builtin_amdgcn_sched_barrier(0)
    Unit cur, nxt; int ui = 0; bool after_epi = false;
    if (!S.next(0, cur)) return;
    f32x4 acc[2][2][4][2];
#pragma unroll
    for (int a = 0; a < 2; ++a)
#pragma unroll
        for (int b = 0; b < 2; ++b)
#pragma unroll
            for (int m = 0; m < 4; ++m)
#pragma unroll
                for (int n = 0; n < 2; ++n) acc[a][b][m][n] = (f32x4){0.f, 0.f, 0.f, 0.f};
    bf16x8 At[4][2], B0[2][2], B1[2][2];
    const char* cA = (const char*)(g.A + cur.aoff); const char* cB = (const char*)(g.Bt + cur.boff);
    PG8_STAGE(PG8_SB(0, 0), cB, voffB); PG8_STAGE(PG8_SB(0, 1), cB + hstepB, voffB); PG8_STAGE(PG8_SA(0, 0), cA, voffA); PG8_STAGE(PG8_SA(0, 1), cA + hstepA, voffA);
    hk();
    if (wr == 1) PG8_BAR;
    PG8_WAIT_V(2); PG8_BAR;
    PG8_STAGE(PG8_SB(1, 0), cB + kstep, voffB); PG8_STAGE(PG8_SA(1, 0), cA + kstep, voffA); PG8_STAGE(PG8_SB(1, 1), cB + hstepB + kstep, voffB);
    PG8_WAIT_V(6); PG8_BAR;
    for (;;) {
        const bool has_next = S.next(ui + 1, nxt);
        constexpr int NST = EpiNst<Epi>::value;
        const char* nA = has_next ? (const char*)(g.A + nxt.aoff) : cA; const char* nB = has_next ? (const char*)(g.Bt + nxt.boff) : cB;
#pragma nounroll
        for (int t = 0; t < nt; t += 2) {
            const bool last = (t == nt - 2); const bool fst = (NST > 0) && after_epi && (t == 0);
            const char* a1 = cA + (size_t)(t + 1) * kstep;
            const char* a2 = last ? nA : cA + (size_t)(t + 2) * kstep; const char* b2 = last ? nB : cB + (size_t)(t + 2) * kstep;
            const char* a3 = a2 + kstep; const char* b3 = b2 + kstep;
            PG8_LDB(B0, 0, 0); PG8_LDB(B1, 0, 1); PG8_SCHED; PG8_LDA(At, 0, 0); PG8_STAGE(PG8_SA(1, 1), a1 + hstepA, voffA);
            if (fst) pg8_waitv<8 + NST>(); else PG8_WAIT_V(8);
            PG8_WAIT_L(0); PG8_BAR; PG8_MMA(0, 0, At, B0); PG8_MMA(0, 1, At, B1); PG8_BAR; PG8_SCHED;
            PG8_LDA(At, 0, 1); PG8_STAGE(PG8_SB(0, 0), b2, voffB); PG8_STAGE(PG8_SB(0, 1), b2 + hstepB, voffB); PG8_STAGE(PG8_SA(0, 0), a2, voffA);
            if (fst) pg8_waitv<8 + NST>(); else PG8_WAIT_V(8);
            PG8_WAIT_L(0); PG8_BAR; PG8_MMA(1, 0, At, B0); PG8_MMA(1, 1, At, B1); PG8_BAR; PG8_SCHED;
            PG8_LDB(B0, 1, 0); PG8_LDB(B1, 1, 1); PG8_SCHED; PG8_LDA(At, 1, 0); PG8_STAGE(PG8_SA(0, 1), a2 + hstepA, voffA);
            PG8_WAIT_V(8); PG8_WAIT_L(0); PG8_BAR; PG8_MMA(0, 0, At, B0); PG8_MMA(0, 1, At, B1); PG8_BAR; PG8_SCHED;
            PG8_LDA(At, 1, 1); PG8_STAGE(PG8_SB(1, 0), b3, voffB); PG8_STAGE(PG8_SB(1, 1), b3 + hstepB, voffB); PG8_STAGE(PG8_SA(1, 0), a3, voffA);
            PG8_WAIT_V(8); PG8_WAIT_L(0); PG8_BAR; PG8_MMA(1, 0, At, B0); PG8_MMA(1, 1, At, B1); PG8_BAR; PG8_SCHED;
        }
        if (wr == 0) PG8_BAR;
        E(acc, cur, wr, wc, fr, fq);
        if (!has_next) break;
#pragma unroll
        for (int a = 0; a < 2; ++a)
#pragma unroll
            for (int b = 0; b < 2; ++b)
#pragma unroll
                for (int m = 0; m < 4; ++m)
#pragma unroll
                    for (int n = 0; n < 2; ++n) acc[a][b][m][n] = zero4();
        cur = nxt; cA = nA; cB = nB; ++ui; after_epi = true;
        if (wr == 1) PG8_BAR;
    }
    PG8_WAIT_V(0);
    PG8_BAR;
#undef PG8_SA
#undef PG8_SB
#undef PG8_STAGE
#undef PG8_LDA
#undef PG8_LDB
#undef PG8_MMA
#undef PG8_WAIT_V
#undef PG8_WAIT_L
#undef PG8_BAR
#undef PG8_SCHED
}
}
using pg8::Unit;

constexpr size_t MiB = 1u << 20;
constexpr size_t WS_CTL = 0, CTL_ZERO_BYTES = 1 * MiB;
constexpr size_t WS_SSQ = 1 * MiB;
constexpr size_t WS_QSS = 5 * MiB;
constexpr size_t WS_LS = 9 * MiB;
constexpr size_t WS_ZS = 13 * MiB;
constexpr size_t WS_GNS = 15 * MiB;
constexpr size_t WS_KSS = 23 * MiB;
constexpr size_t WS_RMEM = 24 * MiB;
constexpr size_t WS_MEMB = 25 * MiB;
constexpr size_t WS_KP = 33 * MiB;
constexpr size_t WS_VT = 65 * MiB;
constexpr size_t WS_W = 97 * MiB;
constexpr size_t W_LAYER = 37 * MiB;
constexpr size_t WO_GU1 = 0, WO_D1 = 11 * MiB, WO_GU2 = 16 * MiB + MiB / 2, WO_D2 = 27 * MiB + MiB / 2, WO_Q = 33 * MiB, WO_O = 35 * MiB;
constexpr size_t WS_WE = WS_W + 4 * W_LAYER;
constexpr size_t W_EVEN = 6 * MiB + MiB / 2, WE_IN = 0, WE_S2 = 3 * MiB, WE_OUT = 4 * MiB + MiB / 2;
constexpr size_t WS_WO = WS_WE + 2 * W_EVEN;
constexpr size_t W_ODD = 16 * MiB, WOD_IN = 0, WOD_OUT = 12 * MiB;
constexpr size_t WS_XB = WS_WO + 2 * W_ODD;
constexpr size_t WS_ACT = WS_XB + 128 * MiB;
constexpr size_t WS_VW = WS_ACT + 512 * MiB;
constexpr size_t WS_END = WS_VW + 32 * MiB;
static_assert(WS_XB == 290 * MiB && WS_END == 962 * MiB, "ws map");
constexpr size_t A_H = 0;
constexpr size_t A_AB = 0, A_ZC = 64 * MiB, A_KR = 112 * MiB, A_QH = 116 * MiB, A_KN = 212 * MiB, A_VB = 276 * MiB, A_MIX = 340 * MiB;
constexpr size_t A_RQ = 0, A_RK = 128 * MiB, A_RV = 256 * MiB;
constexpr size_t A_XQ = 0, A_XP = 128 * MiB, A_XO = 256 * MiB;
constexpr size_t A_WK = 0, A_WV = 8 * MiB;
constexpr int CW_BAR = 4096;
constexpr int CW_KMAX = 16384;
constexpr int CW_SHE = 16384 + 512;
constexpr int CW_TAB = 32768;
DI const float* inp_ptr(const unsigned char* ws, int i) {
    const unsigned long long v = ((const unsigned long long*)(ws + WS_CTL + CW_TAB * 4))[i];
    const unsigned lo = __builtin_amdgcn_readfirstlane((unsigned)v), hi = __builtin_amdgcn_readfirstlane((unsigned)(v >> 32));
    return (const float*)(GAS const float*)(((unsigned long long)hi << 32) | lo); }
#define INP(i) inp_ptr(ws, (i))

constexpr int RING_BYTES = 131072;
constexpr int LDSCTL_OFF = RING_BYTES + 16384;
constexpr int LDS_BYTES = LDSCTL_OFF + 256;
static_assert(LDS_BYTES <= 160 * 1024 && LDS_BYTES > 80 * 1024, "LDS");

#define XB_TMO      128
#define XB_XCNT(j)  (256  + 64 * (j))
#define XB_XSUB(j)  (1280 + 64 * (j))
#define XB_XGEN(j)  (2304 + 64 * (j))
#define XB_TOP      3328
#define XB_TOPGEN   3392
#define XCD_BAR_WORDS 3456
#define XB_SPIN_CAP (1u << 22)
DI unsigned xb_ld(unsigned* p)              { return __hip_atomic_load(p, __ATOMIC_RELAXED, __HIP_MEMORY_SCOPE_AGENT); }
DI unsigned xb_add(unsigned* p, unsigned v) { return __hip_atomic_fetch_add(p, v, __ATOMIC_RELAXED, __HIP_MEMORY_SCOPE_AGENT); }
DI unsigned xb_xcc_id() { return (unsigned)__builtin_amdgcn_s_getreg((3 << 11) | 20) & 0xFu; }
#define XB_SPIN(cond, bar) do { unsigned _sp = 0; while (cond) { __builtin_amdgcn_s_sleep(1); \
    if ((++_sp & 255u) == 0u) { if (xb_ld(&(bar)[XB_TMO])) break; if (_sp > XB_SPIN_CAP) { atomicAdd(&(bar)[XB_TMO], 1u); break; } } } } while (0)
struct XcdBarrier { unsigned* bar; unsigned x; volatile LAS unsigned* st; };
DI XcdBarrier xcd_barrier_post(unsigned* bar, volatile LAS unsigned* st) {
    XcdBarrier b; b.bar = bar; b.x = xb_xcc_id(); b.st = st;
    if (threadIdx.x == 0) st[2] = xb_add(&bar[XB_XCNT(b.x)], 1u);
    return b;
}
#define XL_SUB(j)   (XCD_BAR_WORDS + 64 * (j))
#define XL_GEN(j)   (XCD_BAR_WORDS + 1024 + 64 * (j))
DI void xcd_local_barrier(const XcdBarrier& b) {
    asm volatile("s_waitcnt vmcnt(0)" ::: "memory");
    __syncthreads();
    if (threadIdx.x == 0) {
        unsigned* bar = b.bar;
        unsigned bx = b.x; asm volatile("" : "+s"(bx));
        __builtin_amdgcn_s_waitcnt(0);
        const unsigned target = b.st[4] + b.st[0]; b.st[4] = target;
        (void)__hip_atomic_fetch_add(&bar[XL_SUB(bx)], 1u, __ATOMIC_RELAXED, __HIP_MEMORY_SCOPE_AGENT);
        XB_SPIN(xb_ld(&bar[XL_SUB(bx)]) < target, bar);
        __builtin_amdgcn_fence(__ATOMIC_ACQUIRE, "agent");
        asm volatile("s_waitcnt vmcnt(0)" ::: "memory");
    }
    __syncthreads();
}
DI void cu_local_seam() {
    asm volatile("s_waitcnt vmcnt(0)" ::: "memory");
    __syncthreads();
    if (threadIdx.x == 0) { __builtin_amdgcn_fence(__ATOMIC_ACQUIRE, "agent"); asm volatile("s_waitcnt vmcnt(0)" ::: "memory"); }
    __syncthreads();
}
DI void xcd_barrier_complete(unsigned* bar, unsigned x, unsigned& nloc, unsigned& nx) {
    const unsigned G = gridDim.x * gridDim.y * gridDim.z;
    unsigned sum, cnt, mine, sp = 0u;
    for (;;) {
        sum = 0u; cnt = 0u; mine = 0u;
#pragma unroll
        for (unsigned j = 0; j < 16; ++j) { const unsigned c = xb_ld(&bar[XB_XCNT(j)]); sum += c; cnt += (c > 0u) ? 1u : 0u; mine = (j == x) ? c : mine; }
        if (sum == G) break;
        __builtin_amdgcn_s_sleep(1);
        if ((++sp & 255u) == 0u) { if (xb_ld(&bar[XB_TMO])) break; if (sp > XB_SPIN_CAP) { atomicAdd(&bar[XB_TMO], 1u); break; } }
    }
    nloc = mine > 0u ? mine : 1u; nx = cnt > 0u ? cnt : 1u;
}
DI void xcd_barrier(const XcdBarrier& b) {
    asm volatile("s_waitcnt vmcnt(0)" ::: "memory");
    __syncthreads();
    if (threadIdx.x == 0) {
        unsigned* bar = b.bar;
        unsigned bx = b.x; asm volatile("" : "+s"(bx));
        __builtin_amdgcn_s_waitcnt(0);
        unsigned nloc = b.st[0], nx = b.st[1];
        if (nloc == 0u) { xcd_barrier_complete(bar, bx, nloc, nx); b.st[0] = nloc; b.st[1] = nx; }
        const unsigned old = xb_add(&bar[XB_XSUB(bx)], 1u);
        const unsigned gen = old / nloc;
        if (old + 1u == (gen + 1u) * nloc) {
            __builtin_amdgcn_fence(__ATOMIC_RELEASE, "agent");
            asm volatile("s_waitcnt vmcnt(0)" ::: "memory");
            const unsigned og = xb_add(&bar[XB_TOP], 1u);
            const unsigned tg = og / nx;
            if (og + 1u == (tg + 1u) * nx) xb_add(&bar[XB_TOPGEN], 1u);
            else XB_SPIN(xb_ld(&bar[XB_TOPGEN]) == tg, bar);
            __builtin_amdgcn_fence(__ATOMIC_ACQUIRE, "agent");
            xb_add(&bar[XB_XGEN(bx)], 1u);
            asm volatile("s_waitcnt vmcnt(0)" ::: "memory");
        } else {
            XB_SPIN(xb_ld(&bar[XB_XGEN(bx)]) == gen, bar);
            __builtin_amdgcn_fence(__ATOMIC_ACQUIRE, "agent");
            asm volatile("s_waitcnt vmcnt(0)" ::: "memory");
        }
    }
    __syncthreads();
}

#define EPI_FENCE() do { asm volatile("" ::: "memory"); __builtin_amdgcn_sched_barrier(0); } while (0)
#define EPI_ROW(u, ai, m) ((u).pm * 256 + (ai) * 128 + wr * 64 + (m) * 16 + fr)
DI float sum4(f32x4 a) { return (a.x + a.y) + (a.z + a.w); }
DI float dot4(f32x4 a) { return (a.x * a.x + a.y * a.y) + (a.z * a.z + a.w * a.w); }
DI float rstd16(const float* p16, float invn) {
    const f32x4* p = (const f32x4*)p16; const f32x4 a = p[0], b = p[1], c = p[2], d = p[3];
    return fast_rsq(((sum4(a) + sum4(b)) + (sum4(c) + sum4(d))) * invn + EPS);
}
DI float rstd4(const float* p4, float invn) { const f32x4 a = *(const f32x4*)p4; return fast_rsq(sum4(a) * invn + EPS); }
DI float red_fq(float s) { s += __shfl_xor(s, 16); s += __shfl_xor(s, 32); return s; }
DI u32x4 pack8(f32x4 a, f32x4 b) { u32x4 w; w.x = cvt_pk_bf16(a.x, a.y); w.y = cvt_pk_bf16(a.z, a.w); w.z = cvt_pk_bf16(b.x, b.y); w.w = cvt_pk_bf16(b.z, b.w); return w; }
DI u32x2 pack4(f32x4 a) { u32x2 w; w.x = cvt_pk_bf16(a.x, a.y); w.y = cvt_pk_bf16(a.z, a.w); return w; }
DI f32x4 silu4(f32x4 g) { f32x4 o; o.x = g.x * sigmoidf_(g.x); o.y = g.y * sigmoidf_(g.y); o.z = g.z * sigmoidf_(g.z); o.w = g.w * sigmoidf_(g.w); return o; }
DI f32x4 sig4(f32x4 g) { f32x4 o; o.x = sigmoidf_(g.x); o.y = sigmoidf_(g.y); o.z = sigmoidf_(g.z); o.w = sigmoidf_(g.w); return o; }
typedef f32x4 AccT[2][2][4][2];

#define EPI_OPAQUE() int fr = fr_, fq = fq_; asm volatile("" : "+v"(fr), "+v"(fq))
#define EPI_ROWK(u, k) EPI_ROW(u, (k) >> 2, (k) & 3)
DI void rstd_rows16(const float* ssq, const Unit& u, int wr, int fr, int fq, float (&r)[8]) {
    f32x4 p[8];
#pragma unroll
    for (int k = 0; k < 8; ++k) p[k] = *(const f32x4*)(ssq + (size_t)EPI_ROWK(u, k) * 16 + fq * 4);
#pragma unroll
    for (int k = 0; k < 8; ++k) r[k] = fast_rsq(red_fq(sum4(p[k])) * (1.0f / D) + EPS);
}
DI void sum4_rows(const float* base, int stride, int off, const Unit& u, int wr, int fr, float (&r)[8]) {
    f32x4 p[8];
#pragma unroll
    for (int k = 0; k < 8; ++k) p[k] = *(const f32x4*)(base + (size_t)EPI_ROWK(u, k) * stride + off);
#pragma unroll
    for (int k = 0; k < 8; ++k) r[k] = sum4(p[k]);
}
DI void pos_rows(const int* pos, const Unit& u, int wr, int fr, float (&r)[8]) {
    int p[8];
#pragma unroll
    for (int k = 0; k < 8; ++k) p[k] = pos[EPI_ROWK(u, k)];
#pragma unroll
    for (int k = 0; k < 8; ++k) r[k] = (float)p[k];
}
constexpr int RT_OFF = 131072 + 4096, PT_OFF = RT_OFF + 4096;
DI void row_tables(LAS unsigned char* lds, const float* ssq, const int* pos, int x, int j, int rev) {
    const int tid = opaque_tid(); LAS float* rt = (LAS float*)(lds + RT_OFF); LAS float* pt = (LAS float*)(lds + PT_OFF);
    const int pin = rev ? 7 - (j & 7) : (j & 7);
#pragma unroll
    for (int i = 0; i < 2; ++i) { const int ri = tid + 512 * i, s = ri >> 8, rl = ri & 255; const size_t row = (size_t)(32 * x + 8 * s + pin) * 256 + rl;
        const f32x4* p = (const f32x4*)(ssq + row * 16); const f32x4 a = p[0], b = p[1], c = p[2], d = p[3];
        rt[ri] = fast_rsq(((sum4(a) + sum4(b)) + (sum4(c) + sum4(d))) * (1.0f / D) + EPS);
        if (pos) pt[ri] = (float)pos[row]; }
    asm volatile("s_waitcnt lgkmcnt(0)\n\ts_barrier" ::: "memory");
}
DI void score_tables(LAS unsigned char* lds, const float* qss, const unsigned* kmax, int x, int j, int rev) {
    const int tid = opaque_tid(); LAS float* t1 = (LAS float*)(lds + RT_OFF); const int hd = j >> 3;
    const int pin = rev ? 7 - (j & 7) : (j & 7);
#pragma unroll
    for (int i = 0; i < 2; ++i) { const int ri = tid + 512 * i, s = ri >> 8, rl = ri & 255; const size_t row = (size_t)(32 * x + 8 * s + pin) * 256 + rl;
        t1[ri] = sum4(*(const f32x4*)(qss + row * 16 + hd * 4)); }
    if (tid < 4) t1[1024 + tid] = 16.0f * __uint_as_float(kmax[((32 * x + 8 * tid) >> 4) * 4 + hd]);
    asm volatile("s_waitcnt lgkmcnt(0)\n\ts_barrier" ::: "memory");
}
DI void tab_rows(const LAS float* t, const Unit& u, int wr, int fr, float (&r)[8]) {
    const LAS float* b = t + ((u.pm >> 3) & 3) * 256 + wr * 64 + fr;
#pragma unroll
    for (int k = 0; k < 8; ++k) r[k] = b[(k >> 2) * 128 + (k & 3) * 16];
}
#define EPI_GROUPS() _Pragma("unroll") for (int k = 0; k < 8; ++k)
#define EPI_K() const int ai = k >> 2, m = k & 3; __builtin_amdgcn_sched_barrier(0); const int row = EPI_ROW(u, ai, m)

struct EpiSwiGLU { static constexpr bool PERM = true; static constexpr int NST = 8; bf16_t* H; const float* ssq; const LAS float* rt = nullptr;
    DI float one(float ag, float au, float nr, float c) const { asm volatile("" : "+v"(ag), "+v"(au));
        const float e = fast_exp2(ag * nr), d = __builtin_fmaf(e, c, c); return (ag * au) * fast_rcp(d); }
    DI void operator()(const AccT& acc, const Unit& u, int wr, int wc, int fr_, int fq_) const { EPI_OPAQUE();
        float r[8]; if (rt) tab_rows(rt, u, wr, fr, r); else rstd_rows16(ssq, u, wr, fr, fq, r);
        EPI_GROUPS() { EPI_K();
            const float nr = -LOG2E * r[k], c = fast_rcp(r[k] * r[k]);
            f32x4 h0, h1;
#pragma unroll
            for (int j = 0; j < 4; ++j) { h0[j] = one(acc[ai][0][m][0][j], acc[ai][1][m][0][j], nr, c); h1[j] = one(acc[ai][0][m][1][j], acc[ai][1][m][1][j], nr, c); }
            *(u32x4*)(H + (size_t)row * DFF + u.pn * 128 + wc * 32 + 8 * fq) = pack8(h0, h1); }
    }
};
template <bool FINAL> struct EpiResid { static constexpr bool PERM = true; static constexpr int NST = 16; bf16_t* xb; float* ssq; float* out;
    DI void operator()(const AccT& acc, const Unit& u, int wr, int wc, int fr_, int fq_) const { EPI_OPAQUE();
#pragma unroll
        for (int ai = 0; ai < 2; ++ai) {
            u32x4 w[4][2];
#pragma unroll
            for (int m = 0; m < 4; ++m)
#pragma unroll
                for (int bj = 0; bj < 2; ++bj) w[m][bj] = *(const u32x4*)(xb + (size_t)EPI_ROW(u, ai, m) * D + u.pn * 256 + wc * 32 + 8 * fq + bj * 128);
#pragma unroll
            for (int m = 0; m < 4; ++m) { __builtin_amdgcn_sched_barrier(0); const int row = EPI_ROW(u, ai, m); float s = 0.f; const size_t ro = (size_t)row * D + u.pn * 256 + wc * 32 + 8 * fq;
#pragma unroll
                for (int bj = 0; bj < 2; ++bj) { const size_t o = ro + bj * 128; const u32x4 ww = w[m][bj];
                    const f32x4 x0 = (f32x4){bf_lo(ww.x), bf_hi(ww.x), bf_lo(ww.y), bf_hi(ww.y)} + acc[ai][bj][m][0], x1 = (f32x4){bf_lo(ww.z), bf_hi(ww.z), bf_lo(ww.w), bf_hi(ww.w)} + acc[ai][bj][m][1];
                    if (FINAL) { *(f32x4*)(out + o) = x0; *(f32x4*)(out + o + 4) = x1; }
                    else { *(u32x4*)(xb + o) = pack8(x0, x1); s += dot4(x0) + dot4(x1); } }
                if (!FINAL) { s = red_fq(s); if (fq == 0) ssq[(size_t)row * 16 + u.pn * 4 + wc] = s; } }
        }
    }
};
struct EpiQraw { static constexpr bool PERM = true; static constexpr int NST = 16; bf16_t* Q; const float* ssq; float* qss; const LAS float* rt = nullptr;
    DI void operator()(const AccT& acc, const Unit& u, int wr, int wc, int fr_, int fq_) const { EPI_OPAQUE();
        float r[8]; if (rt) tab_rows(rt, u, wr, fr, r); else rstd_rows16(ssq, u, wr, fr, fq, r);
        EPI_GROUPS() { EPI_K(); float s = 0.f;
#pragma unroll
            for (int bj = 0; bj < 2; ++bj) { const f32x4 v0 = acc[ai][bj][m][0] * r[k], v1 = acc[ai][bj][m][1] * r[k]; s += dot4(v0) + dot4(v1);
                *(u32x4*)(Q + (size_t)row * D + u.pn * 256 + bj * 128 + wc * 32 + 8 * fq) = pack8(v0, v1); }
            s = red_fq(s); if (fq == 0) qss[(size_t)row * 16 + u.pn * 4 + wc] = s; }
    }
};
struct EpiScoresN { static constexpr bool PERM = true; static constexpr int NST = 16; bf16_t* P; const LAS float* qt; LAS float* tab;
    DI void operator()(const AccT& acc, const Unit& u, int wr, int wc, int fr_, int fq_) const { EPI_OPAQUE();
        const float sh = qt[1024 + ((u.pm >> 3) & 3)];
        float rq[8]; tab_rows(qt, u, wr, fr, rq);
        u32x4 w[8][2];
        EPI_GROUPS() { const int ai = k >> 2, m = k & 3; __builtin_amdgcn_sched_barrier(0);
            const float rqk = fast_rsq(rq[k] * (1.0f / XHD) + EPS); float sm = 0.f;
#pragma unroll
            for (int bj = 0; bj < 2; ++bj) { f32x4 p0, p1;
#pragma unroll
                for (int j = 0; j < 4; ++j) { p0[j] = fast_exp2(acc[ai][bj][m][0][j] * rqk - sh); p1[j] = fast_exp2(acc[ai][bj][m][1][j] * rqk - sh); }
                const u32x4 ww = pack8(p0, p1); w[k][bj] = ww;
                sm += ((bf_lo(ww.x) + bf_hi(ww.x)) + (bf_lo(ww.y) + bf_hi(ww.y))) + ((bf_lo(ww.z) + bf_hi(ww.z)) + (bf_lo(ww.w) + bf_hi(ww.w))); }
            sm = red_fq(sm); if (fq == 0) tab[(ai * 128 + wr * 64 + m * 16 + fr) * 4 + wc] = sm; }
        asm volatile("s_waitcnt lgkmcnt(0)\n\ts_barrier" ::: "memory");
        EPI_GROUPS() { const int ai = k >> 2, m = k & 3; __builtin_amdgcn_sched_barrier(0); const int row = EPI_ROW(u, ai, m);
            const float li = fast_rcp(sum4(*(const LAS f32x4*)(tab + (ai * 128 + wr * 64 + m * 16 + fr) * 4)));
#pragma unroll
            for (int bj = 0; bj < 2; ++bj) { const u32x4 ww = w[k][bj];
                const f32x4 a = (f32x4){bf_lo(ww.x), bf_hi(ww.x), bf_lo(ww.y), bf_hi(ww.y)} * li, b = (f32x4){bf_lo(ww.z), bf_hi(ww.z), bf_lo(ww.w), bf_hi(ww.w)} * li;
                *(u32x4*)(P + (size_t)row * D + u.pn * 256 + bj * 128 + wc * 32 + 8 * fq) = pack8(a, b); } }
    }
};
struct EpiVW { static constexpr bool PERM = true; bf16_t* VW;
    DI void operator()(const AccT& acc, const Unit& u, int wr, int wc, int fr_, int fq_) const { EPI_OPAQUE();
        bf16_t* base = VW + ((size_t)(u.pm >> 2) * D + (u.pm & 3) * 256) * (XH * MEMLEN) + u.pn * MEMLEN + wc * 32 + 8 * fq;
        EPI_GROUPS() { const int ai = k >> 2, m = k & 3; __builtin_amdgcn_sched_barrier(0); const int r = ai * 128 + wr * 64 + m * 16 + fr;
#pragma unroll
            for (int bj = 0; bj < 2; ++bj) *(u32x4*)(base + (size_t)r * (XH * MEMLEN) + bj * 128) = pack8(acc[ai][bj][m][0], acc[ai][bj][m][1]); }
    }
};
struct EpiMemK { static constexpr bool PERM = true; bf16_t* KP; const float* rmem; float* kss; const float* knorm; const float* qnorm;
    DI void operator()(const AccT& acc, const Unit& u, int wr, int wc, int fr_, int fq_) const { EPI_OPAQUE();
        const int l = u.pm >> 4; f32x4 g[2][2];
#pragma unroll
        for (int bj = 0; bj < 2; ++bj)
#pragma unroll
            for (int n = 0; n < 2; ++n) { const int d = bj * 128 + wc * 32 + 8 * fq + 4 * n; g[bj][n] = *(const f32x4*)(knorm + l * XHD + d) * *(const f32x4*)(qnorm + l * XHD + d) * (LOG2E / 16.0f); }
        float rr[8];
#pragma unroll
        for (int k = 0; k < 8; ++k) rr[k] = rmem[EPI_ROWK(u, k) & (MM - 1)];
        EPI_GROUPS() { EPI_K(); const float r = rr[k]; float s = 0.f;
#pragma unroll
            for (int bj = 0; bj < 2; ++bj) { const f32x4 v0 = acc[ai][bj][m][0] * r, v1 = acc[ai][bj][m][1] * r; s += dot4(v0) + dot4(v1);
                *(u32x4*)(KP + (size_t)row * D + u.pn * 256 + bj * 128 + wc * 32 + 8 * fq) = pack8(v0 * g[bj][0], v1 * g[bj][1]); }
            s = red_fq(s); if (fq == 0) kss[(size_t)row * 16 + u.pn * 4 + wc] = s; }
    }
};
struct EpiMemV { static constexpr bool PERM = true; bf16_t* V; const float* rmem;
    DI void operator()(const AccT& acc, const Unit& u, int wr, int wc, int fr_, int fq_) const { EPI_OPAQUE();
        float rr[8];
#pragma unroll
        for (int k = 0; k < 8; ++k) rr[k] = rmem[EPI_ROWK(u, k) & (MM - 1)];
        EPI_GROUPS() { EPI_K(); const float r = rr[k];
#pragma unroll
            for (int bj = 0; bj < 2; ++bj) *(u32x4*)(V + (size_t)row * D + u.pn * 256 + bj * 128 + wc * 32 + 8 * fq) = pack8(acc[ai][bj][m][0] * r, acc[ai][bj][m][1] * r); }
    }
};
constexpr float LOG2_THETA = 13.287712379549449f;
DI void rope_mla(f32x4& x1, f32x4& x2, float pos, int fq) {
#pragma unroll
    for (int j = 0; j < 4; ++j) { const float inv = fast_exp2(-(float)(4 * fq + j) * (LOG2_THETA / 16.0f)); float s, c; sincos_turns(pos * inv, s, c);
        const float a = x1[j], b = x2[j]; x1[j] = a * c - b * s; x2[j] = a * s + b * c; }
}
struct EpiEven1 { static constexpr bool PERM = true; bf16_t* AB; bf16_t* ZC; bf16_t* KR; const float* ssq; float* zs; const float* gkr; const int* pos; const LAS float* rt = nullptr; const LAS float* pt = nullptr;
    DI void operator()(const AccT& acc, const Unit& u, int wr, int wc, int fr_, int fq_) const { EPI_OPAQUE();
        float rr[8]; if (rt) tab_rows(rt, u, wr, fr, rr); else rstd_rows16(ssq, u, wr, fr, fq, rr);
        float pp[8];
        if (u.pn == 5 && wc == 0) { if (pt) tab_rows(pt, u, wr, fr, pp); else pos_rows(pos, u, wr, fr, pp); }
        EPI_GROUPS() { EPI_K(); const float r = rr[k];
            if (u.pn < 4) {
                const f32x4 a0 = (acc[ai][0][m][0] * r) * sig4(acc[ai][1][m][0] * r), a1 = (acc[ai][0][m][1] * r) * sig4(acc[ai][1][m][1] * r);
                *(u32x4*)(AB + (size_t)row * CONV_DIM + u.pn * 128 + wc * 32 + 8 * fq) = pack8(a0, a1);
            } else if (u.pn == 4) {
                float s = 0.f;
#pragma unroll
                for (int bj = 0; bj < 2; ++bj) { const f32x4 v0 = acc[ai][bj][m][0] * r, v1 = acc[ai][bj][m][1] * r; s += dot4(v0) + dot4(v1);
                    *(u32x4*)(ZC + (size_t)row * S2K + bj * 128 + wc * 32 + 8 * fq) = pack8(v0, v1); }
                s = red_fq(s); if (fq == 0) zs[(size_t)row * 8 + wc] = s;
            } else {
                { const f32x4 v0 = acc[ai][0][m][0] * r, v1 = acc[ai][0][m][1] * r; float s = red_fq(dot4(v0) + dot4(v1));
                  *(u32x4*)(ZC + (size_t)row * S2K + 256 + wc * 32 + 8 * fq) = pack8(v0, v1); if (fq == 0) zs[(size_t)row * 8 + 4 + wc] = s; }
                if (wc == 0) {
                    f32x4 x1 = acc[ai][1][m][0] * r, x2 = acc[ai][1][m][1] * r; const float ss = red_fq(dot4(x1) + dot4(x2));
                    const float rn = fast_rsq(ss * (1.0f / QK_ROPE) + EPS);
                    x1 = x1 * rn * *(const f32x4*)(gkr + 4 * fq); x2 = x2 * rn * *(const f32x4*)(gkr + 16 + 4 * fq);
                    rope_mla(x1, x2, pp[k], fq);
                    *(u32x2*)(KR + (size_t)row * QK_ROPE + 4 * fq) = pack4(x1); *(u32x2*)(KR + (size_t)row * QK_ROPE + 16 + 4 * fq) = pack4(x2);
                }
            }
        }
    }
};
struct EpiEven2 { static constexpr bool PERM = true; bf16_t* QH; bf16_t* KN; bf16_t* VB; const float* zs; const float* gqn; const float* gqr; const float* gkn; const int* pos; float qscale;
    DI void operator()(const AccT& acc, const Unit& u, int wr, int wc, int fr_, int fq_) const { EPI_OPAQUE();
        const bool isq = u.pn < 3; const int ws = (isq ? u.pn : u.pn - 3) * 4 + wc;
        float zz[8]; sum4_rows(zs, 8, isq ? 0 : 4, u, wr, fr, zz);
        float pp[8];
        if (isq && ws >= 8) pos_rows(pos, u, wr, fr, pp);
        EPI_GROUPS() { EPI_K();
            const float rz = fast_rsq(zz[k] * (isq ? 1.0f / QLORA : 1.0f / KVLORA) + EPS);
            if (ws < 8) {
                f32x4 v[2][2]; float s = 0.f;
#pragma unroll
                for (int bj = 0; bj < 2; ++bj)
#pragma unroll
                    for (int n = 0; n < 2; ++n) { v[bj][n] = acc[ai][bj][m][n] * rz; s += dot4(v[bj][n]); }
                s = red_fq(s); const float rn = fast_rsq(s * (1.0f / QK_NOPE) + EPS) * (isq ? qscale : 1.0f);
                const float* g = isq ? gqn : gkn; bf16_t* dst = isq ? QH + (size_t)row * 768 + ws * 96 : KN + (size_t)row * 512 + ws * 64;
#pragma unroll
                for (int bj = 0; bj < 2; ++bj) { const int d = 32 * bj + 8 * fq;
                    *(u32x4*)(dst + d) = pack8(v[bj][0] * rn * *(const f32x4*)(g + d), v[bj][1] * rn * *(const f32x4*)(g + d + 4)); }
            } else if (isq) {
#pragma unroll
                for (int bj = 0; bj < 2; ++bj) { const int head = 2 * (ws - 8) + bj;
                    f32x4 x1 = acc[ai][bj][m][0] * rz, x2 = acc[ai][bj][m][1] * rz; const float ss = red_fq(dot4(x1) + dot4(x2));
                    const float rn = fast_rsq(ss * (1.0f / QK_ROPE) + EPS);
                    x1 = x1 * rn * *(const f32x4*)(gqr + 4 * fq); x2 = x2 * rn * *(const f32x4*)(gqr + 16 + 4 * fq);
                    rope_mla(x1, x2, pp[k], fq);
                    bf16_t* dst = QH + (size_t)row * 768 + head * 96 + 64;
                    *(u32x2*)(dst + 4 * fq) = pack4(x1 * qscale); *(u32x2*)(dst + 16 + 4 * fq) = pack4(x2 * qscale); }
            } else {
#pragma unroll
                for (int bj = 0; bj < 2; ++bj) *(u32x4*)(VB + (size_t)row * 512 + (ws - 8) * 64 + 32 * bj + 8 * fq) = pack8(acc[ai][bj][m][0] * rz, acc[ai][bj][m][1] * rz);
            }
        }
    }
};
struct EpiOdd1 { static constexpr bool PERM = true; static constexpr int NST = 16; bf16_t* Q; bf16_t* Kk; bf16_t* V; const float* ssq; const int* pos; const LAS float* rt = nullptr; const LAS float* pt = nullptr;
    DI void operator()(const AccT& acc, const Unit& u, int wr, int wc, int fr_, int fq_) const { EPI_OPAQUE();
        float rr[8]; if (rt) tab_rows(rt, u, wr, fr, rr); else rstd_rows16(ssq, u, wr, fr, fq, rr);
        if (u.pn < 8) {
            float pp[8]; if (pt) tab_rows(pt, u, wr, fr, pp); else pos_rows(pos, u, wr, fr, pp);
            float inv[2][4];
#pragma unroll
            for (int n = 0; n < 2; ++n)
#pragma unroll
                for (int j = 0; j < 4; ++j) inv[n][j] = fast_exp2(-(float)(32 * wc + 8 * fq + 4 * n + j) * (LOG2_THETA / 128.0f));
            const bool isk = u.pn >= 4; const float osc = isk ? (1.0f / 16.0f) : 1.0f; bf16_t* base = (isk ? Kk : Q) + (u.pn & 3) * 256 + 32 * wc + 8 * fq;
            const float l2gk = __builtin_log2f(1.0f - fast_exp2(-5.0f - (float)(u.pn & 3)));
            EPI_GROUPS() { EPI_K(); const float r = rr[k] * (isk ? osc * fast_exp2(-(float)(16 * m + fr + 1) * l2gk) : 1.0f); const float p = pp[k];
                f32x4 o1[2], o2[2];
#pragma unroll
                for (int n = 0; n < 2; ++n)
#pragma unroll
                    for (int j = 0; j < 4; ++j) { float s, c; sincos_turns(p * inv[n][j], s, c); const float a = acc[ai][0][m][n][j] * r, b = acc[ai][1][m][n][j] * r; o1[n][j] = a * c - b * s; o2[n][j] = a * s + b * c; }
                *(u32x4*)(base + (size_t)row * 1024) = pack8(o1[0], o1[1]); *(u32x4*)(base + (size_t)row * 1024 + 128) = pack8(o2[0], o2[1]); }
        } else {
            EPI_GROUPS() { EPI_K(); const float r = rr[k];
#pragma unroll
                for (int bj = 0; bj < 2; ++bj) *(u32x4*)(V + (size_t)row * ODD_MIX + (u.pn - 8) * 256 + bj * 128 + wc * 32 + 8 * fq) = pack8(acc[ai][bj][m][0] * r, acc[ai][bj][m][1] * r); }
        }
    }
};
struct EpiGate { static constexpr bool PERM = true; static constexpr int NST = 16; bf16_t* O; const float* gns; const LAS float* rt; const LAS float* gt;
    DI void operator()(const AccT& acc, const Unit& u, int wr, int wc, int fr_, int fq_) const { EPI_OPAQUE();
        const int head = u.pn >> 1; const int c0 = u.pn * 256 + wc * 32 + 8 * fq; const int t0 = ((u.pn >> 2) & 1) * 256 + wc * 32 + 8 * fq;
        float rr[8]; tab_rows(rt, u, wr, fr, rr);
#pragma unroll
        for (int ai = 0; ai < 2; ++ai) { EPI_FENCE();
            f32x2 st[4]; u32x4 w[4][2];
#pragma unroll
            for (int m = 0; m < 4; ++m) { const size_t row = EPI_ROW(u, ai, m); st[m] = *(const f32x2*)(gns + row * 32 + head * 8 + fq * 2);
                w[m][0] = *(const u32x4*)(O + row * ODD_MIX + c0); w[m][1] = *(const u32x4*)(O + row * ODD_MIX + c0 + 128); }
            float ga[4], gc[4];
#pragma unroll
            for (int m = 0; m < 4; ++m) {
                const float mean = red_fq(st[m].x) * (1.0f / RET_V), var = red_fq(st[m].y) * (1.0f / RET_V) - mean * mean; ga[m] = fast_rsq(fmaxf(var, 0.f) + EPS); gc[m] = -mean * ga[m]; }
#pragma unroll
            for (int bj = 0; bj < 2; ++bj) { __builtin_amdgcn_sched_barrier(0);
                const int c = c0 + bj * 128, t = t0 + bj * 128;
                const f32x4 G0 = *(const LAS f32x4*)(gt + t), G1 = *(const LAS f32x4*)(gt + t + 4), B0 = *(const LAS f32x4*)(gt + 512 + t), B1 = *(const LAS f32x4*)(gt + 512 + t + 4);
#pragma unroll
                for (int m = 0; m < 4; ++m) { const u32x4 ww = w[m][bj]; const float r = rr[ai * 4 + m];
                    f32x4 o0 = (f32x4){bf_lo(ww.x), bf_hi(ww.x), bf_lo(ww.y), bf_hi(ww.y)}, o1 = (f32x4){bf_lo(ww.z), bf_hi(ww.z), bf_lo(ww.w), bf_hi(ww.w)};
                    o0 = (o0 * ga[m] + gc[m]) * G0 + B0; o1 = (o1 * ga[m] + gc[m]) * G1 + B1;
                    *(u32x4*)(O + (size_t)EPI_ROW(u, ai, m) * ODD_MIX + c) = pack8(silu4(acc[ai][bj][m][0] * r) * o0, silu4(acc[ai][bj][m][1] * r) * o1); }
            }
        }
    }
};
DI void lds_barrier() { asm volatile("s_waitcnt lgkmcnt(0)\n\ts_barrier" ::: "memory"); }
typedef short v4i16_t __attribute__((ext_vector_type(4)));
DI int crow(int r, int hi) { return (r & 3) + 8 * (r >> 2) + 4 * hi; }
#define MFMA32(a, b, c) __builtin_amdgcn_mfma_f32_32x32x16_bf16((a), (b), (c), 0, 0, 0)
#define MFMA16(a, b, c) __builtin_amdgcn_mfma_f32_16x16x32_bf16((a), (b), (c), 0, 0, 0)
constexpr int AT_KP = 208, AT_VP = 144;
constexpr int AT_KB = 64 * AT_KP, AT_VB = 64 * AT_VP;
DI bf16x8 pack_frag(const f32x16& x, int s) {
    u32x4 p; p.x = cvt_pk_bf16(x[8 * s], x[8 * s + 1]); p.y = cvt_pk_bf16(x[8 * s + 2], x[8 * s + 3]); p.z = cvt_pk_bf16(x[8 * s + 4], x[8 * s + 5]); p.w = cvt_pk_bf16(x[8 * s + 6], x[8 * s + 7]);
    return __builtin_bit_cast(bf16x8, p);
}
DI void attn_unit(LAS unsigned char* lds, const bf16_t* QH, const bf16_t* KN, const bf16_t* KR, const bf16_t* VB, bf16_t* MIX, int b, int h, int qb, float shift) {
    const int tid = opaque_tid(), wid = __builtin_amdgcn_readfirstlane(tid >> 6), lane = tid & 63, r32 = lane & 31, hi = lane >> 5;
    const int q0 = qb * 256, ntile = 4 * (qb + 1);
    const size_t rowb = (size_t)b * SEQ;
    if (wid >= 4) __builtin_amdgcn_s_setprio(1);
    LAS unsigned char* Kb = lds; LAS unsigned char* Vb = lds + 2 * AT_KB;
    bf16x8 qf[6];
    { const bf16_t* qp = QH + (rowb + q0 + wid * 32 + r32) * 768 + h * 96 + 8 * hi;
#pragma unroll
      for (int s = 0; s < 6; ++s) qf[s] = *(const bf16x8*)(qp + 16 * s); }
    f32x16 o0, o1;
#pragma unroll
    for (int i = 0; i < 16; ++i) { o0[i] = 0.f; o1[i] = 0.f; }
    float lsum = 0.f;
    const int skey = tid >> 3, sch = tid & 7;
    const int rkey = (tid & 255) >> 2, rch = tid & 3;
    struct Stg { u32x4 k, r, v; };
    Stg RA, RB;
    auto gload = [&](Stg& R, int kt) {
        const size_t row = rowb + (size_t)kt * 64;
        R.k = *(const u32x4*)(KN + (row + skey) * 512 + h * 64 + sch * 8);
        R.v = *(const u32x4*)(VB + (row + skey) * 512 + h * 64 + sch * 8);
        if (tid < 256) R.r = *(const u32x4*)(KR + (row + rkey) * 32 + rch * 8);
    };
    auto swrite = [&](const Stg& R, int buf) {
        *(LAS u32x4*)(Kb + buf * AT_KB + skey * AT_KP + sch * 16) = R.k;
        if (tid < 256) *(LAS u32x4*)(Kb + buf * AT_KB + rkey * AT_KP + 128 + rch * 16) = R.r;
        *(LAS u32x4*)(Vb + buf * AT_VB + skey * AT_VP + sch * 16) = R.v;
    };
    const int qrow = q0 + wid * 32 + r32;
    auto compute = [&](int buf, int kt) {
        const bool active = (64 * kt <= q0 + wid * 32 + 31);
        if (active) {
            const bool needmask = (64 * kt + 63 > q0 + wid * 32);
            const LAS unsigned char* kb = Kb + buf * AT_KB + r32 * AT_KP + 16 * hi;
            const LAS unsigned char* vb = Vb + buf * AT_VB + (4 * hi + ((lane & 15) >> 2)) * AT_VP + (16 * ((lane >> 4) & 1) + 4 * (lane & 3)) * 2;
            bf16x8 kf[12];
#pragma unroll
            for (int s = 0; s < 6; ++s) { kf[2 * s] = *(const LAS bf16x8*)(kb + 32 * s); kf[2 * s + 1] = *(const LAS bf16x8*)(kb + 32 * AT_KP + 32 * s); }
            __builtin_amdgcn_sched_barrier(0);
            f32x16 s0, s1;
#pragma unroll
            for (int i = 0; i < 16; ++i) { s0[i] = -shift; s1[i] = -shift; }
#pragma unroll
            for (int s = 0; s < 6; ++s) { s0 = MFMA32(kf[2 * s], qf[s], s0); s1 = MFMA32(kf[2 * s + 1], qf[s], s1); }
            s16x4 va[4][2], vc[4][2];
#pragma unroll
            for (int f = 0; f < 4; ++f) { const int ko = (32 * (f >> 1) + 16 * (f & 1)) * AT_VP;
                va[f][0] = __builtin_amdgcn_ds_read_tr16_b64_v4i16((LAS v4i16_t*)(vb + ko)); va[f][1] = __builtin_amdgcn_ds_read_tr16_b64_v4i16((LAS v4i16_t*)(vb + ko + 8 * AT_VP));
                vc[f][0] = __builtin_amdgcn_ds_read_tr16_b64_v4i16((LAS v4i16_t*)(vb + ko + 64)); vc[f][1] = __builtin_amdgcn_ds_read_tr16_b64_v4i16((LAS v4i16_t*)(vb + ko + 8 * AT_VP + 64)); }
            __builtin_amdgcn_sched_barrier(0);
#pragma unroll
            for (int i = 0; i < 16; ++i) { s0[i] = fast_exp2(s0[i]); s1[i] = fast_exp2(s1[i]); }
            if (needmask) {
                const int kbase = 64 * kt;
#pragma unroll
                for (int i = 0; i < 16; ++i) { const int kg = kbase + crow(i, hi); if (kg > qrow) s0[i] = 0.f; if (kg + 32 > qrow) s1[i] = 0.f; }
            }
            bf16x8 pf[2][2];
#pragma unroll
            for (int s2 = 0; s2 < 2; ++s2) { pf[0][s2] = pack_frag(s0, s2); pf[1][s2] = pack_frag(s1, s2); }
            { f32x16 t = s0 + s1; lsum += (((t[0] + t[1]) + (t[2] + t[3])) + ((t[4] + t[5]) + (t[6] + t[7]))) + (((t[8] + t[9]) + (t[10] + t[11])) + ((t[12] + t[13]) + (t[14] + t[15]))); }
            __builtin_amdgcn_sched_barrier(0);
#pragma unroll
            for (int f = 0; f < 4; ++f) {
                const bf16x8 v0 = __builtin_shufflevector(va[f][0], va[f][1], 0, 1, 2, 3, 4, 5, 6, 7), v1 = __builtin_shufflevector(vc[f][0], vc[f][1], 0, 1, 2, 3, 4, 5, 6, 7);
                o0 = MFMA32(v0, pf[f >> 1][f & 1], o0); o1 = MFMA32(v1, pf[f >> 1][f & 1], o1);
            }
        }
    };
    gload(RA, 0); gload(RB, 1); swrite(RA, 0); lds_barrier();
    for (int kt = 0; kt < ntile; kt += 2) {
        if (kt + 2 < ntile) gload(RA, kt + 2);
        compute(0, kt);
        swrite(RB, 1);
        lds_barrier();
        if (kt + 3 < ntile) gload(RB, kt + 3);
        compute(1, kt + 1);
        if (kt + 2 < ntile) swrite(RA, 0);
        lds_barrier();
    }
    lsum += __shfl_xor(lsum, 32);
    const float li = 1.0f / lsum;
    bf16_t* op = MIX + (rowb + qrow) * 1024 + 512 + h * 64 + 8 * hi;
    auto store_pair = [&](const f32x16& o, int g, bf16_t* p) {
        u32x2 a = pack4((f32x4){o[4 * g] * li, o[4 * g + 1] * li, o[4 * g + 2] * li, o[4 * g + 3] * li}), c = pack4((f32x4){o[4 * g + 4] * li, o[4 * g + 5] * li, o[4 * g + 6] * li, o[4 * g + 7] * li});
        { const auto r = __builtin_amdgcn_permlane32_swap(a.x, c.x, false, false); a.x = r[0]; c.x = r[1]; }
        { const auto r = __builtin_amdgcn_permlane32_swap(a.y, c.y, false, false); a.y = r[0]; c.y = r[1]; }
        *(u32x4*)(p + 8 * g) = (u32x4){a.x, a.y, c.x, c.y}; };
    store_pair(o0, 0, op); store_pair(o0, 2, op); store_pair(o1, 0, op + 32); store_pair(o1, 2, op + 32);
    __builtin_amdgcn_s_setprio(0);
}

DI void conv_tile(LAS unsigned char* lds, const bf16_t* AB, bf16_t* MIX, const float* cw, const float* cb, const float* lng, const float* lnb, int tile) {
    const int tid = opaque_tid(), wid = tid >> 6, lane = tid & 63;
    const int b = tile >> 7, t0 = (tile & 127) * 32; const size_t rowb = (size_t)b * SEQ;
#pragma unroll
    for (int i = 0; i < 8; ++i) { const int idx = tid + 512 * i;
        if (idx < 62 * 64) { const int r = idx >> 6, ch = idx & 63, tok = t0 - 30 + r; u32x4 v = (u32x4){0u, 0u, 0u, 0u};
            if (tok >= 0) v = *(const u32x4*)(AB + (rowb + tok) * CONV_DIM + ch * 8);
            *(LAS u32x4*)(lds + r * 1024 + ch * 16) = v; } }
    float w[CONV_W];
#pragma unroll
    for (int j = 0; j < CONV_W; ++j) w[j] = cw[j * CONV_DIM + tid];
    const float bias = cb[tid];
    __syncthreads();
    f32x2 xp[31], we[15], wo[15];
#pragma unroll
    for (int r = 0; r < 31; ++r) { xp[r].x = __uint_as_float(((unsigned)*(const LAS unsigned short*)(lds + (2 * r) * 1024 + tid * 2)) << 16); xp[r].y = __uint_as_float(((unsigned)*(const LAS unsigned short*)(lds + (2 * r + 1) * 1024 + tid * 2)) << 16); }
#pragma unroll
    for (int k = 0; k < 15; ++k) { we[k] = (f32x2){w[2 * k], w[2 * k + 1]}; wo[k] = (f32x2){w[2 * k + 1], w[2 * k + 2]}; }
    LAS float* yb = (LAS float*)(lds + 65536);
#pragma unroll
    for (int s = 0; s < 16; ++s) {
        f32x2 ae = (f32x2){bias, 0.f}, ao = (f32x2){bias, 0.f};
#pragma unroll
        for (int k = 0; k < 15; ++k) { ae = __builtin_elementwise_fma(we[k], xp[s + k], ae); ao = __builtin_elementwise_fma(wo[k], xp[s + 1 + k], ao); }
        yb[(2 * s) * CONV_DIM + tid] = (ae.x + ae.y) + w[30] * xp[s + 15].x;
        yb[(2 * s + 1) * CONV_DIM + tid] = (ao.x + ao.y) + w[0] * xp[s].y; }
    __syncthreads();
#pragma unroll
    for (int rr = 0; rr < 4; ++rr) { const int t = wid * 4 + rr;
        const f32x4 a = *(const LAS f32x4*)(yb + t * CONV_DIM + 8 * lane), c = *(const LAS f32x4*)(yb + t * CONV_DIM + 8 * lane + 4);
        const float mean = wave_sum(sum4(a) + sum4(c)) * (1.0f / CONV_DIM);
        const f32x4 da = a - mean, dc = c - mean;
        const float rs = fast_rsq(wave_sum(dot4(da) + dot4(dc)) * (1.0f / CONV_DIM) + EPS);
        const f32x4 ya = da * rs * *(const f32x4*)(lng + 8 * lane) + *(const f32x4*)(lnb + 8 * lane), yc = dc * rs * *(const f32x4*)(lng + 8 * lane + 4) + *(const f32x4*)(lnb + 8 * lane + 4);
        *(u32x4*)(MIX + (rowb + t0 + t) * 1024 + 8 * lane) = pack8(silu4(ya), silu4(yc)); }
    __syncthreads();
}

constexpr int RC = 64;
constexpr int R_SLOT = 32768, R_KO = 16384, R_V = 65536, R_VSZ = 16384, R_P = 98304, R_PP = 144, R_TAB = R_P + RC * R_PP;
static_assert(R_TAB + 4096 <= RING_BYTES, "retention LDS");
DI int r_f(int r) { return ((r & 3) << 1) | (r & 8) | ((r >> 2) & 1); }
DI bf16x8 tr_pair(unsigned a, unsigned a2, int off) {
    u32x2 x, y;
    asm volatile("ds_read_b64_tr_b16 %0, %1 offset:%2" : "=v"(x) : "v"(a), "i"(off) : "memory");
    asm volatile("ds_read_b64_tr_b16 %0, %1 offset:%2" : "=v"(y) : "v"(a2), "i"(off) : "memory");
    u32x4 w; w.x = x.x; w.y = x.y; w.z = y.x; w.w = y.y; return __builtin_bit_cast(bf16x8, w);
}
DI bf16x8 r64_pair(unsigned a, unsigned a2, int off) {
    u32x2 x, y;
    asm volatile("ds_read_b64 %0, %1 offset:%2" : "=v"(x) : "v"(a), "i"(off) : "memory");
    asm volatile("ds_read_b64 %0, %1 offset:%2" : "=v"(y) : "v"(a2), "i"(off) : "memory");
    u32x4 w; w.x = x.x; w.y = x.y; w.z = y.x; w.w = y.y; return __builtin_bit_cast(bf16x8, w);
}
#define R_LGKM2(a, b) asm volatile("s_waitcnt lgkmcnt(0)" : "+v"(a), "+v"(b) :: "memory")
#define R_LGKM8(a, b, c, d, e, f, g_, h_) asm volatile("s_waitcnt lgkmcnt(0)" : "+v"(a), "+v"(b), "+v"(c), "+v"(d), "+v"(e), "+v"(f), "+v"(g_), "+v"(h_) :: "memory")
#define R_LGKM9(a, b, c, d, e, f, g_, h_, i_) asm volatile("s_waitcnt lgkmcnt(0)" : "+v"(a), "+v"(b), "+v"(c), "+v"(d), "+v"(e), "+v"(f), "+v"(g_), "+v"(h_), "+v"(i_) :: "memory")
#define R_WAITV() asm volatile("s_waitcnt vmcnt(0)" ::: "memory")
#define R_PIN(x) asm volatile("" : "+v"(x))
DI void retention_unit(LAS unsigned char* lds, const bf16_t* Q, const bf16_t* Kk, bf16_t* V, float* gns, int b, int h, int vs) {
    const int tid0 = opaque_tid(), wid = __builtin_amdgcn_readfirstlane(tid0 >> 6);
    const float l2g = __builtin_log2f(1.0f - fast_exp2(-5.0f - (float)h));
    const float gC = fast_exp2((float)RC * l2g);
    const size_t rowb = (size_t)b * SEQ;
    const bf16_t* Qh = Q + rowb * 1024 + h * 256; const bf16_t* Kh = Kk + rowb * 1024 + h * 256; bf16_t* Vh = V + rowb * ODD_MIX + h * 512 + vs * 128;
    float* gnh = gns + rowb * 32 + h * 8 + vs * 2;
    const int ib_a = wid & 3, jb_a = 2 * (wid >> 2);
    LAS float* tab = (LAS float*)(lds + R_TAB);
    unsigned aT[8], aT2[8], aV, aV2, aQ[4], aP[4][2];
    { const int lane = tid0 & 63, i16 = lane & 15, g = lane >> 4, fi = r_f(i16);
      const unsigned lb = (unsigned)(uintptr_t)lds;
      const int xq = (g ^ fi) << 4;
      const int xp = (((g >> 1) ^ fi) << 4) | ((g & 1) << 3);
      const int xt = ((((i16 >> 1) & 1) ^ ((i16 >> 2) << 1) ^ ((g & 1) << 3)) << 4) | ((i16 & 1) << 3);
      const int rowtr = (8 * g + (i16 >> 2)) * 256;
#pragma unroll
      for (int t = 0; t < 8; ++t) { aT[t] = lb + rowtr + (xt ^ (32 * t)); aT2[t] = lb + rowtr + 1024 + ((xt ^ (32 * t)) ^ 16); R_PIN(aT[t]); R_PIN(aT2[t]); }
      aV = lb + R_V + rowtr + (xt ^ (32 * wid)); aV2 = lb + R_V + rowtr + 1024 + ((xt ^ (32 * wid)) ^ 16); R_PIN(aV); R_PIN(aV2);
#pragma unroll
      for (int s = 0; s < 4; ++s) { aQ[s] = lb + i16 * 256 + (xq ^ (64 * s)); R_PIN(aQ[s]); aP[s][0] = lb + i16 * 256 + (xp ^ (64 * s)); aP[s][1] = lb + i16 * 256 + (xp ^ (64 * s + 32)); R_PIN(aP[s][0]); R_PIN(aP[s][1]); }
    }
    f32x4 st[16];
#pragma unroll
    for (int t = 0; t < 16; ++t) st[t] = (f32x4){0.f, 0.f, 0.f, 0.f};
    for (int c = 0; c < SEQ / RC; ++c) {
    int tid = tid0; asm volatile("" : "+v"(tid));
    const int lane = tid & 63, i16 = lane & 15, g = lane >> 4;
    auto dma_img = [&](int ldsoff, const bf16_t* src, int pitch) {
#pragma unroll
        for (int i = 0; i < 2; ++i) { const int q = wid + 8 * i, row = 4 * q + g, ch = i16 ^ r_f(row & 15);
            __builtin_amdgcn_global_load_lds((const unsigned*)(src + (size_t)row * pitch + ch * 8), (LAS unsigned*)(lds + ldsoff + q * 1024), 16, 0, 0); }
    };
    auto dma_qk = [&](int slot, int chunk, int half) { dma_img(slot * R_SLOT, Qh + (size_t)chunk * RC * 1024 + half * 128, 1024); dma_img(slot * R_SLOT + R_KO, Kh + (size_t)chunk * RC * 1024 + half * 128, 1024); };
    auto dma_v = [&](int chunk) { dma_img(R_V + (chunk & 1) * R_VSZ, Vh + (size_t)chunk * RC * ODD_MIX, ODD_MIX); };
    auto tab_reduce = [&](int chunk) {
        if (tid < RC) { float s1 = 0.f, s2 = 0.f;
#pragma unroll
            for (int w = 0; w < 8; ++w) { const f32x2 v = *(const LAS f32x2*)(tab + (tid * 8 + w) * 2); s1 += v.x; s2 += v.y; }
            *(f32x2*)(gnh + (size_t)(chunk * RC + tid) * 32) = (f32x2){s1, s2}; }
    };
    if (c == 0) { dma_qk(0, 0, 0); dma_v(0); }
    if (c == 0) R_WAITV(); else asm volatile("s_waitcnt vmcnt(4)" ::: "memory");
    lds_barrier();
    if (c > 0) tab_reduce(c - 1);
    dma_qk(1, c, 1);
    {
        const unsigned vo = (unsigned)((c & 1) * R_VSZ), aVc = aV + vo, aVc2 = aV2 + vo;
        f32x4 sacc[2], oacc[4];
#pragma unroll
        for (int j = 0; j < 2; ++j) sacc[j] = (f32x4){0.f, 0.f, 0.f, 0.f};
#pragma unroll
        for (int j = 0; j < 4; ++j) oacc[j] = (f32x4){0.f, 0.f, 0.f, 0.f};
#pragma unroll
        for (int half = 0; half < 2; ++half) {
            if (half == 1) {
                R_WAITV(); lds_barrier();
                if (c + 1 < SEQ / RC) { dma_qk(0, c + 1, 0); dma_v(c + 1); }
            }
            const int qo = half * R_SLOT, ko = qo + R_KO;
            if (jb_a <= ib_a) { __builtin_amdgcn_sched_barrier(0);
                bf16x8 qn[4], k0[4], k1[4];
#pragma unroll
                for (int s = 0; s < 4; ++s) { qn[s] = *(const LAS bf16x8*)(uintptr_t)(aQ[s] + qo + 16 * ib_a * 256); k0[s] = *(const LAS bf16x8*)(uintptr_t)(aQ[s] + ko + 16 * jb_a * 256);
                    if (jb_a + 1 <= ib_a) k1[s] = *(const LAS bf16x8*)(uintptr_t)(aQ[s] + ko + (16 * jb_a + 16) * 256); }
                __builtin_amdgcn_sched_barrier(0);
#pragma unroll
                for (int s = 0; s < 4; ++s) { sacc[0] = MFMA16(k0[s], qn[s], sacc[0]); if (jb_a + 1 <= ib_a) sacc[1] = MFMA16(k1[s], qn[s], sacc[1]); }
            }
#pragma unroll
            for (int u0 = 0; u0 < 4; u0 += 2) { __builtin_amdgcn_sched_barrier(0);
                bf16x8 qf[2][4];
#pragma unroll
                for (int uu = 0; uu < 2; ++uu)
#pragma unroll
                    for (int i = 0; i < 4; ++i) qf[uu][i] = r64_pair(aP[u0 + uu][0], aP[u0 + uu][1], qo + 16 * i * 256);
                R_LGKM8(qf[0][0], qf[0][1], qf[0][2], qf[0][3], qf[1][0], qf[1][1], qf[1][2], qf[1][3]);
                __builtin_amdgcn_sched_barrier(0);
#pragma unroll
                for (int uu = 0; uu < 2; ++uu) { const int u = u0 + uu;
                    const f32x4 x0 = st[8 * half + 2 * u], x1 = st[8 * half + 2 * u + 1];
                    u32x4 pw; pw.x = cvt_pk_bf16(x0.x, x0.y); pw.y = cvt_pk_bf16(x0.z, x0.w); pw.z = cvt_pk_bf16(x1.x, x1.y); pw.w = cvt_pk_bf16(x1.z, x1.w);
                    const bf16x8 sf = __builtin_bit_cast(bf16x8, pw);
#pragma unroll
                    for (int i = 0; i < 4; ++i) oacc[i] = MFMA16(sf, qf[uu][i], oacc[i]); }
            }
#pragma unroll
            for (int s = 0; s < 2; ++s) { __builtin_amdgcn_sched_barrier(0);
                bf16x8 vf = tr_pair(aVc, aVc2, s * 8192);
                bf16x8 kt[8];
#pragma unroll
                for (int t = 0; t < 8; ++t) kt[t] = tr_pair(aT[t], aT2[t], ko + s * 8192);
                R_LGKM9(vf, kt[0], kt[1], kt[2], kt[3], kt[4], kt[5], kt[6], kt[7]);
                __builtin_amdgcn_sched_barrier(0);
#pragma unroll
                for (int t = 0; t < 8; ++t) st[8 * half + t] = MFMA16(kt[t], vf, st[8 * half + t]); }
            __builtin_amdgcn_sched_barrier(0);
#pragma unroll
            for (int t = 0; t < 8; ++t) st[8 * half + t] = st[8 * half + t] * gC;
        }
#pragma unroll
        for (int jj = 0; jj < 2; ++jj) { const int jb = jb_a + jj;
            f32x4 p = sacc[jj];
            if (jb > ib_a) p = (f32x4){0.f, 0.f, 0.f, 0.f};
            else if (jb == ib_a) {
#pragma unroll
                for (int e = 0; e < 4; ++e) if (4 * g + e > i16) p[e] = 0.f; }
            *(LAS u32x2*)(lds + R_P + (16 * ib_a + i16) * R_PP + (16 * jb + 4 * g) * 2) = pack4(p);
        }
        lds_barrier();
        {
            __builtin_amdgcn_sched_barrier(0);
            bf16x8 v0 = tr_pair(aVc, aVc2, 0), v1 = tr_pair(aVc, aVc2, 8192);
            bf16x8 p0[4], p1[2];
#pragma unroll
            for (int i = 0; i < 4; ++i) p0[i] = *(const LAS bf16x8*)(lds + R_P + (16 * i + i16) * R_PP + 16 * g);
#pragma unroll
            for (int i = 0; i < 2; ++i) p1[i] = *(const LAS bf16x8*)(lds + R_P + (16 * (i + 2) + i16) * R_PP + 64 + 16 * g);
            R_LGKM2(v0, v1);
            __builtin_amdgcn_sched_barrier(0);
#pragma unroll
            for (int i = 0; i < 4; ++i) oacc[i] = MFMA16(v0, p0[i], oacc[i]);
#pragma unroll
            for (int i = 0; i < 2; ++i) oacc[i + 2] = MFMA16(v1, p1[i], oacc[i + 2]);
        }
#pragma unroll
        for (int ib = 0; ib < 4; ++ib) {
            __builtin_amdgcn_sched_barrier(0);
            const f32x4 o = oacc[ib] * fast_exp2((float)(16 * ib + i16 + 1) * l2g);
            *(u32x2*)(Vh + (size_t)(c * RC + 16 * ib + i16) * ODD_MIX + 16 * wid + 4 * g) = pack4(o);
            const float s1 = red_fq(sum4(o)), s2 = red_fq(dot4(o));
            if (g == 0) *(LAS f32x2*)(tab + ((16 * ib + i16) * 8 + wid) * 2) = (f32x2){s1, s2};
        }
    }
    }
    lds_barrier();
    { int tid = tid0; asm volatile("" : "+v"(tid));
      if (tid < RC) { float s1 = 0.f, s2 = 0.f;
#pragma unroll
          for (int w = 0; w < 8; ++w) { const f32x2 v = *(const LAS f32x2*)(tab + (tid * 8 + w) * 2); s1 += v.x; s2 += v.y; }
          *(f32x2*)(gnh + (size_t)((SEQ / RC - 1) * RC + tid) * 32) = (f32x2){s1, s2}; } }
    lds_barrier();
}

enum { MAP_ID = 0, MAP_GU = 1, MAP_E1 = 2, MAP_S2Q = 3, MAP_S2KV = 4 };
template <int MAP> DI int map_src(int n, int& sel) {
    sel = 0;
    if (MAP == MAP_ID) return n;
    const int t = n >> 8, r = n & 255, bj = r >> 7, wc = (r & 127) >> 5, p = r & 31, fq = p >> 3, nn = (p >> 2) & 1, j = p & 3;
    const int rl = 16 * nn + 4 * fq + j;
    if (MAP == MAP_GU) { sel = bj; return t * 128 + (r & 127); }
    if (MAP == MAP_E1) {
        if (t < 4) return (bj ? CONV_DIM : 0) + t * 128 + (r & 127);
        if (t == 4) return 2 * CONV_DIM + r;
        if (r < 128) return 2 * CONV_DIM + QLORA + r;
        if (r < 160) return 2 * CONV_DIM + QLORA + KVLORA + rl;
        return -1;
    }
    const int ws = t * 4 + wc;
    if (MAP == MAP_S2Q) { if (ws < 8) return ws * 96 + 32 * bj + p; return (2 * (ws - 8) + bj) * 96 + 64 + rl; }
      if (ws < 8) return ws * 128 + 32 * bj + p; return (ws - 8) * 128 + 64 + 32 * bj + p;
}
template <int MAP> DI void cvt_matrix(const float* W0, const float* W1, int ldw, int krows, int koff, bf16_t* dst, int ldd, int nrows, const float* gain, float scale, int gw, int NGW, int lane, int& rot) {
    const int nkb = ldd >> 6, nitems = (nrows >> 6) * nkb;
    int first = (gw - rot % NGW + NGW) % NGW; rot += nitems;
    for (int it = first; it < nitems; it += NGW) {
        const int nb = it / nkb, kb = it - nb * nkb, n = nb * 64 + lane; int sel; const int src = map_src<MAP>(n, sel);
        const float* W = sel ? W1 : W0; bf16_t* drow = dst + (size_t)n * ldd + kb * 64;
        float v[64];
#pragma unroll
        for (int i = 0; i < 64; ++i) { const int k = kb * 64 + i - koff; const bool ok = (src >= 0) && (k >= 0) && (k < krows); const int kk = ok ? k : 0;
            const float wv = W[(size_t)kk * ldw + (src >= 0 ? src : 0)]; const float gv = gain ? gain[kk] : 1.0f; v[i] = ok ? wv * gv * scale : 0.f; }
#pragma unroll
        for (int kc = 0; kc < 8; ++kc) { u32x4 o; o.x = cvt_pk_bf16(v[8 * kc], v[8 * kc + 1]); o.y = cvt_pk_bf16(v[8 * kc + 2], v[8 * kc + 3]); o.z = cvt_pk_bf16(v[8 * kc + 4], v[8 * kc + 5]); o.w = cvt_pk_bf16(v[8 * kc + 6], v[8 * kc + 7]);
            *(u32x4*)(drow + kc * 8) = o; }
    }
}

struct Args { const float* in[38]; float* out; unsigned char* ws; };
struct Frame {
    LAS unsigned char* lds; int tid, lane, wave, vcu, G;
    int c, x, j, local; mutable int dir;
};

DI void p0_prologue(const Args& a, const Frame& F) {
    unsigned char* ws = a.ws;
    const int gw = F.vcu * 8 + F.wave, NGW = F.G * 8, lane = F.lane; int rot = 0;
    const size_t DD = (size_t)D * D, DF = (size_t)D * DFF;
    for (int l = 0; l < DEPTH; ++l) {
        bf16_t* wl = (bf16_t*)(ws + WS_W + l * W_LAYER);
        cvt_matrix<MAP_GU>(a.in[4] + l * DF, a.in[5] + l * DF, DFF, D, 0, (bf16_t*)((char*)wl + WO_GU1), D, 2 * DFF, a.in[3] + l * D, 1.0f, gw, NGW, lane, rot);
        cvt_matrix<MAP_ID>(a.in[6] + l * DF, nullptr, D, DFF, 0, (bf16_t*)((char*)wl + WO_D1), DFF, D, nullptr, 0.5f, gw, NGW, lane, rot);
        cvt_matrix<MAP_GU>(a.in[8] + l * DF, a.in[9] + l * DF, DFF, D, 0, (bf16_t*)((char*)wl + WO_GU2), D, 2 * DFF, a.in[7] + l * D, 1.0f, gw, NGW, lane, rot);
        cvt_matrix<MAP_ID>(a.in[10] + l * DF, nullptr, D, DFF, 0, (bf16_t*)((char*)wl + WO_D2), DFF, D, nullptr, 0.5f, gw, NGW, lane, rot);
        cvt_matrix<MAP_ID>(a.in[14] + l * DD, nullptr, D, D, 0, (bf16_t*)((char*)wl + WO_Q), D, D, a.in[12] + l * D, 1.0f, gw, NGW, lane, rot);
        cvt_matrix<MAP_ID>(a.in[17] + l * DD, nullptr, D, D, 0, (bf16_t*)((char*)wl + WO_O), D, D, nullptr, 1.0f, gw, NGW, lane, rot);
        cvt_matrix<MAP_ID>(a.in[15] + l * DD, nullptr, D, D, 0, (bf16_t*)(ws + WS_ACT + A_WK) + l * DD, D, D, a.in[13] + l * D, 1.0f, gw, NGW, lane, rot);
        cvt_matrix<MAP_ID>(a.in[16] + l * DD, nullptr, D, D, 0, (bf16_t*)(ws + WS_ACT + A_WV) + l * DD, D, D, a.in[13] + l * D, 1.0f, gw, NGW, lane, rot);
    }
    for (int e = 0; e < 2; ++e) {
        char* we = (char*)(ws + WS_WE + e * W_EVEN);
        cvt_matrix<MAP_E1>(a.in[20] + (size_t)e * D * EVEN_IN, nullptr, EVEN_IN, D, 0, (bf16_t*)(we + WE_IN), D, EVEN_INP, a.in[11] + (2 * e) * D, 1.0f, gw, NGW, lane, rot);
        cvt_matrix<MAP_S2Q>(a.in[26] + (size_t)e * QLORA * 768, nullptr, 768, QLORA, 0, (bf16_t*)(we + WE_S2), S2K, 768, a.in[25] + e * QLORA, 1.0f, gw, NGW, lane, rot);
        cvt_matrix<MAP_S2KV>(a.in[28] + (size_t)e * KVLORA * 1024, nullptr, 1024, KVLORA, QLORA, (bf16_t*)(we + WE_S2) + (size_t)768 * S2K, S2K, 1024, a.in[27] + e * KVLORA, 1.0f, gw, NGW, lane, rot);
        cvt_matrix<MAP_ID>(a.in[33] + (size_t)e * DD, nullptr, D, D, 0, (bf16_t*)(we + WE_OUT), D, D, nullptr, 1.0f, gw, NGW, lane, rot);
    }
    for (int o = 0; o < 2; ++o) {
        char* wo = (char*)(ws + WS_WO + o * W_ODD);
        cvt_matrix<MAP_ID>(a.in[34] + (size_t)o * D * ODD_IN, nullptr, ODD_IN, D, 0, (bf16_t*)(wo + WOD_IN), D, ODD_IN, a.in[11] + (2 * o + 1) * D, 1.0f, gw, NGW, lane, rot);
        cvt_matrix<MAP_ID>(a.in[37] + (size_t)o * ODD_MIX * D, nullptr, D, ODD_MIX, 0, (bf16_t*)(wo + WOD_OUT), ODD_MIX, D, nullptr, 1.0f, gw, NGW, lane, rot);
    }
    { const float* x = a.in[0]; bf16_t* xb = (bf16_t*)(ws + WS_XB); float* ssq = (float*)(ws + WS_SSQ);
      for (int m0 = gw * 4; m0 < M; m0 += NGW * 4) { f32x4 v[4][4];
#pragma unroll
          for (int r = 0; r < 4; ++r)
#pragma unroll
              for (int j = 0; j < 4; ++j) v[r][j] = ((const f32x4*)(x + (size_t)(m0 + r) * D) + lane)[64 * j];
#pragma unroll
          for (int r = 0; r < 4; ++r) { float s = 0.f;
#pragma unroll
              for (int j = 0; j < 4; ++j) { s += dot4(v[r][j]); *(u32x2*)(xb + (size_t)(m0 + r) * D + 256 * j + 4 * lane) = pack4(v[r][j]); }
              s = wave_sum(s); if (lane < 16) ssq[(size_t)(m0 + r) * 16 + lane] = lane == 0 ? s : 0.f; } } }
    { const float* x = a.in[1]; bf16_t* xb = (bf16_t*)(ws + WS_MEMB); float* rm = (float*)(ws + WS_RMEM);
      for (int m = gw; m < MM; m += NGW) { const f32x4* xr = (const f32x4*)(x + (size_t)m * D) + lane; float s = 0.f;
#pragma unroll
          for (int j = 0; j < 4; ++j) { const f32x4 v = xr[64 * j]; s += dot4(v); *(u32x2*)(xb + (size_t)m * D + 256 * j + 4 * lane) = pack4(v); }
          s = wave_sum(s); if (lane == 0) rm[m] = 1.0f / sqrtf(s * (1.0f / D) + EPS); } }
    if (gw == 0 && lane < 2) { const int e = lane; float mqn = 0.f, mkn = 0.f, mqr = 0.f, mkr = 0.f;
        for (int i = 0; i < QK_NOPE; ++i) { mqn = fmaxf(mqn, fabsf(a.in[29][e * QK_NOPE + i])); mkn = fmaxf(mkn, fabsf(a.in[30][e * QK_NOPE + i])); }
        for (int i = 0; i < QK_ROPE; ++i) { mqr = fmaxf(mqr, fabsf(a.in[31][e * QK_ROPE + i])); mkr = fmaxf(mkr, fabsf(a.in[32][e * QK_ROPE + i])); }
        const float bq = sqrtf(64.f * mqn * mqn + 32.f * mqr * mqr), bk = sqrtf(64.f * mkn * mkn + 32.f * mkr * mkr);
        ((float*)(ws + WS_CTL))[CW_SHE + e] = bq * bk * (LOG2E / sqrtf(96.0f)); }
}
DI void p2_finalize(const Args& a, const Frame& F) {
    unsigned char* ws = a.ws; bf16_t* kp = (bf16_t*)(ws + WS_KP); const float* kss = (const float*)(ws + WS_KSS); unsigned* kmax = (unsigned*)(ws + WS_CTL) + CW_KMAX;
    const int gw = F.vcu * 8 + F.wave, NGW = F.G * 8, lane = F.lane;
    for (int it = gw; it < DEPTH * MM * XH; it += NGW) { const int hh = it & 3, row = it >> 2;
        const float rk = rstd4(kss + (size_t)row * 16 + hh * 4, 1.0f / XHD);
        u32x2* p = (u32x2*)(kp + (size_t)row * D + hh * 256 + 4 * lane); const u32x2 w = *p;
        const u32x2 o = (u32x2){cvt_pk_bf16(bf_lo(w.x) * rk, bf_hi(w.x) * rk), cvt_pk_bf16(bf_lo(w.y) * rk, bf_hi(w.y) * rk)};
        *p = o;
        float s = bf_lo(o.x) * bf_lo(o.x) + bf_hi(o.x) * bf_hi(o.x) + bf_lo(o.y) * bf_lo(o.y) + bf_hi(o.y) * bf_hi(o.y);
        s = wave_sum(s);
        if (lane == 0) { const int l = row / MM, bb = (row % MM) / MEMLEN; __hip_atomic_fetch_max(kmax + l * 64 + bb * 4 + hh, __float_as_uint(sqrtf(s) * 1.0001f), __ATOMIC_RELAXED, __HIP_MEMORY_SCOPE_AGENT); } }
}

#define WSP(T, off) ((T*)(ws + (off)))
#define WS_LOCAL() GAS unsigned char* wsg_ = (GAS unsigned char*)ws_; asm volatile("" : "+s"(wsg_)); unsigned char* ws = (unsigned char*)wsg_
#ifndef SITE
#define SITE 0
#endif
#define SITE_ON(k) (SITE == 0 || SITE == (k))
using pg8::Cfg; using pg8::CfgStd; using pg8::CfgStdRev;
typedef CfgStd<M, 2 * DFF, D, D, D> CfgF1;
typedef CfgStd<M, D, DFF, DFF, DFF> CfgF2;
typedef CfgStd<M, D, D, D, D> CfgDD;
typedef CfgStd<M, EVEN_INP, D, D, D> CfgE1;
typedef CfgStd<M, S2N, S2K, S2K, S2K> CfgE2;
typedef CfgStd<M, 4096, D, D, D> CfgO1;
typedef CfgStd<M, ODD_MIX, D, D, D> CfgO3;
typedef CfgStd<M, D, ODD_MIX, ODD_MIX, ODD_MIX> CfgO4;
typedef Cfg<M / 256, XH, D, D, XHD, -1, 31, 256L * D, 0, 256, 4, 256L * D, 256> CfgXS;
typedef Cfg<NB * 4, XH, D, D, XHD, 3, 31, 256L * D, 0, 256, 2, 256L * D, 256> CfgVW;
typedef Cfg<M / 256, XH, D, D, D, -1, 31, 256L * D, 0, 0, 4, (long)D * D, 256L * D> CfgXF;
typedef Cfg<DEPTH * (MM / 256), XH, D, D, D, 15, 31, 256L * D, 0, 0, 4, (long)D * D, 256L * D> CfgMK;

constexpr size_t SLAB = 64 * MiB; constexpr int XROWS = M / 8;
#define ACTP(off, pitch) ((bf16_t*)(ws + WS_ACT + (size_t)F.x * SLAB + (off) / 8) - (size_t)F.x * XROWS * (pitch))
#define PBAR() do { if (__builtin_amdgcn_readfirstlane((int)bar.st[3])) xcd_local_barrier(bar); else xcd_barrier(bar); } while (0)

DI void ffn_block(const Args& a, const Frame& F, const XcdBarrier& bar, int l, int half, bool final) {
    unsigned char* ws_ = a.ws; const int c = F.c;
#define wgu ((const bf16_t*)(ws + WS_W + l * W_LAYER + (half ? WO_GU2 : WO_GU1)))
#define wd ((const bf16_t*)(ws + WS_W + l * W_LAYER + (half ? WO_D2 : WO_D1)))
    if (SITE_ON(1)) { WS_LOCAL(); pg8::Gemm g{WSP(const bf16_t, WS_XB), wgu};
      const int d = (F.dir ^= 1); constexpr bool tb = true;     auto hk = [&]() { row_tables(F.lds, WSP(const float, WS_SSQ), nullptr, F.x, F.j, d); };
      EpiSwiGLU E{ACTP(A_H, DFF), WSP(const float, WS_SSQ), tb ? (const LAS float*)(F.lds + RT_OFF) : nullptr}; pg8::gemm_phase<CfgF1>(F.lds, g, F.G, c, E, d, hk); }
    PBAR();
    if (SITE_ON(2)) { WS_LOCAL(); pg8::Gemm g{ACTP(A_H, DFF), wd};
      if (final) { EpiResid<true> E{WSP(bf16_t, WS_XB), WSP(float, WS_SSQ), a.out}; pg8::gemm_phase<CfgF2>(F.lds, g, F.G, c, E, (F.dir ^= 1)); }
      else { EpiResid<false> E{WSP(bf16_t, WS_XB), WSP(float, WS_SSQ), a.out}; pg8::gemm_phase<CfgF2>(F.lds, g, F.G, c, E, (F.dir ^= 1)); } }
    PBAR();
}
DI void even_block(const Args& a, const Frame& F, const XcdBarrier& bar, int l) {
    unsigned char* ws_ = a.ws; const int c = F.c, e = l >> 1;
#define pos ((const int*)INP(2))
#define we (ws + WS_WE + e * W_EVEN)
    if (SITE_ON(3)) { WS_LOCAL(); pg8::Gemm g{WSP(const bf16_t, WS_XB), (const bf16_t*)(we + WE_IN)};
      const int d = (F.dir ^= 1); constexpr bool tb = true;     auto hk = [&]() { row_tables(F.lds, WSP(const float, WS_SSQ), pos, F.x, F.j, d); };
      EpiEven1 E{ACTP(A_AB, CONV_DIM), ACTP(A_ZC, S2K), ACTP(A_KR, QK_ROPE), WSP(const float, WS_SSQ), WSP(float, WS_ZS), INP(32) + e * QK_ROPE, pos, tb ? (const LAS float*)(F.lds + RT_OFF) : nullptr, tb ? (const LAS float*)(F.lds + PT_OFF) : nullptr};
      pg8::gemm_phase<CfgE1>(F.lds, g, F.G, c, E, d, hk); }
    PBAR();
    if (SITE_ON(4)) { WS_LOCAL(); pg8::Gemm g{ACTP(A_ZC, S2K), (const bf16_t*)(we + WE_S2)};
      EpiEven2 E{ACTP(A_QH, 768), ACTP(A_KN, 512), ACTP(A_VB, 512), WSP(const float, WS_ZS), INP(29) + e * QK_NOPE, INP(31) + e * QK_ROPE, INP(30) + e * QK_NOPE, pos, LOG2E * 0.10206207261596575f};
      pg8::gemm_phase<CfgE2>(F.lds, g, F.G, c, E, (F.dir ^= 1)); }
    if (SITE_ON(5)) { WS_LOCAL(); for (int q = c; q < M / 32; q += F.G) { const int n = q >> 3;
        conv_tile(F.lds, ACTP(A_AB, CONV_DIM), ACTP(A_MIX, 1024), INP(21) + e * CONV_W * CONV_DIM, INP(22) + e * CONV_DIM, INP(23) + e * CONV_DIM, INP(24) + e * CONV_DIM, F.x * (M / 32 / 8) + n); } }
    PBAR();
    if (SITE_ON(6)) { WS_LOCAL(); const float shift = WSP(const float, WS_CTL)[CW_SHE + e];
      for (int q = c; q < NB * MLA_H * 8; q += F.G) { const int n = q >> 3, b = 2 * F.x + (n >> 6), h = (n >> 3) & 7, pr = n & 7;
          attn_unit(F.lds, ACTP(A_QH, 768), ACTP(A_KN, 512), ACTP(A_KR, QK_ROPE), ACTP(A_VB, 512), ACTP(A_MIX, 1024), b, h, pr, shift);
          attn_unit(F.lds, ACTP(A_QH, 768), ACTP(A_KN, 512), ACTP(A_KR, QK_ROPE), ACTP(A_VB, 512), ACTP(A_MIX, 1024), b, h, 15 - pr, shift); } }
    PBAR();
    if (SITE_ON(7)) { WS_LOCAL(); pg8::Gemm g{ACTP(A_MIX, 1024), (const bf16_t*)(we + WE_OUT)};
      EpiResid<false> E{WSP(bf16_t, WS_XB), WSP(float, WS_SSQ), a.out}; pg8::gemm_phase<CfgDD>(F.lds, g, F.G, c, E, (F.dir ^= 1)); }
    PBAR();
}
DI void odd_block(const Args& a, const Frame& F, const XcdBarrier& bar, int l) {
    unsigned char* ws_ = a.ws; const int c = F.c, o = l >> 1;
#define wo (ws + WS_WO + o * W_ODD)
    if (SITE_ON(8)) { WS_LOCAL(); pg8::Gemm g{WSP(const bf16_t, WS_XB), (const bf16_t*)(wo + WOD_IN)};
      const int d = (F.dir ^= 1); constexpr bool tb = true;     auto hk = [&]() { row_tables(F.lds, WSP(const float, WS_SSQ), pos, F.x, F.j, d); };
      EpiOdd1 E{ACTP(A_RQ, 1024), ACTP(A_RK, 1024), ACTP(A_RV, ODD_MIX), WSP(const float, WS_SSQ), pos, tb ? (const LAS float*)(F.lds + RT_OFF) : nullptr, tb ? (const LAS float*)(F.lds + PT_OFF) : nullptr}; pg8::gemm_phase<CfgO1>(F.lds, g, F.G, c, E, d, hk); }
    PBAR();
    if (SITE_ON(9)) { WS_LOCAL(); for (int q = c; q < NB * RET_H * 4; q += F.G) { const int n = q >> 3;
        retention_unit(F.lds, ACTP(A_RQ, 1024), ACTP(A_RK, 1024), ACTP(A_RV, ODD_MIX), WSP(float, WS_GNS), 2 * F.x + (n >> 4), (n >> 2) & 3, n & 3); } }
    PBAR();
    if (SITE_ON(10)) { WS_LOCAL(); pg8::Gemm g{WSP(const bf16_t, WS_XB), (const bf16_t*)(wo + WOD_IN) + (size_t)4096 * D};
      const int d = (F.dir ^= 1);
      auto hk = [&]() { { const int t = opaque_tid(); const int gcol = ((F.j >> 3) + 4 * (t >> 8)) * 256 + (t & 255); LAS float* gt = (LAS float*)(F.lds + PT_OFF);
                          gt[t] = (INP(35) + o * ODD_MIX)[gcol]; gt[512 + t] = (INP(36) + o * ODD_MIX)[gcol]; }
                        row_tables(F.lds, WSP(const float, WS_SSQ), nullptr, F.x, F.j, d); };
      EpiGate E{ACTP(A_RV, ODD_MIX), WSP(const float, WS_GNS), (const LAS float*)(F.lds + RT_OFF), (const LAS float*)(F.lds + PT_OFF)}; pg8::gemm_phase<CfgO3>(F.lds, g, F.G, c, E, d, hk); }
    PBAR();
    if (SITE_ON(11)) { WS_LOCAL(); pg8::Gemm g{ACTP(A_RV, ODD_MIX), (const bf16_t*)(wo + WOD_OUT)};
      EpiResid<false> E{WSP(bf16_t, WS_XB), WSP(float, WS_SSQ), a.out}; pg8::gemm_phase<CfgO4>(F.lds, g, F.G, c, E, (F.dir ^= 1)); }
    PBAR();
}
DI void xattn_block(const Args& a, const Frame& F, const XcdBarrier& bar, int l) {
    unsigned char* ws_ = a.ws; const int c = F.c;
#define wl (ws + WS_W + l * W_LAYER)
    if (SITE_ON(12)) { WS_LOCAL(); pg8::Gemm g{WSP(const bf16_t, WS_XB), (const bf16_t*)(wl + WO_Q)};
      const int d = (F.dir ^= 1); constexpr bool tb = true;     auto hk = [&]() { row_tables(F.lds, WSP(const float, WS_SSQ), nullptr, F.x, F.j, d); };
      EpiQraw E{ACTP(A_XQ, 1024), WSP(const float, WS_SSQ), WSP(float, WS_QSS), tb ? (const LAS float*)(F.lds + RT_OFF) : nullptr}; pg8::gemm_phase<CfgDD>(F.lds, g, F.G, c, E, d, hk); }
    if (SITE_ON(14)) { WS_LOCAL(); pg8::Gemm g{(const bf16_t*)(wl + WO_O), WSP(const bf16_t, WS_VT) + (size_t)l * MM * D};
      EpiVW E{WSP(bf16_t, WS_VW)}; pg8::gemm_phase<CfgVW>(F.lds, g, F.G, c, E, 0); }
    cu_local_seam();
    if (SITE_ON(13)) { WS_LOCAL(); pg8::Gemm g{ACTP(A_XQ, 1024), WSP(const bf16_t, WS_KP) + (size_t)l * MM * D};
      auto hk = [&]() { score_tables(F.lds, WSP(const float, WS_QSS), WSP(const unsigned, WS_CTL) + CW_KMAX + l * 64, F.x, F.j, F.dir); };
      EpiScoresN E{ACTP(A_XP, 1024), (const LAS float*)(F.lds + RT_OFF), (LAS float*)(F.lds + RING_BYTES)}; pg8::gemm_phase<CfgXS>(F.lds, g, F.G, c, E, F.dir, hk); }
    PBAR();
    if (SITE_ON(15)) { WS_LOCAL(); pg8::Gemm g{ACTP(A_XP, 1024), WSP(const bf16_t, WS_VW)};
      EpiResid<false> E{WSP(bf16_t, WS_XB), WSP(float, WS_SSQ), a.out}; pg8::gemm_phase<CfgXF>(F.lds, g, F.G, c, E, (F.dir ^= 1)); }
    PBAR();
}

__global__ void __launch_bounds__(512, 2) fwd_kernel(Args a) {
    extern __shared__ __attribute__((aligned(16))) unsigned char lds_raw[];
    Frame F; F.lds = (LAS unsigned char*)lds_raw; F.tid = threadIdx.x; F.lane = F.tid & 63; F.wave = __builtin_amdgcn_readfirstlane(F.tid >> 6);
    F.G = gridDim.x; { const int bx = blockIdx.x; F.vcu = (F.G % 8 == 0) ? (bx % 8) * (F.G / 8) + bx / 8 : bx; }
    F.c = blockIdx.x; F.x = 0; F.j = 0; F.local = 0; F.dir = 1;
    unsigned char* ws_ = a.ws; unsigned char* ws = ws_;
    if (F.tid < 64) ((LAS unsigned*)(F.lds + LDSCTL_OFF))[F.tid] = 0u;
    if (F.tid < 38) ((const float**)(ws + WS_CTL + CW_TAB * 4))[F.tid] = a.in[F.tid];
    __syncthreads();
    const XcdBarrier bar = xcd_barrier_post(WSP(unsigned, WS_CTL) + CW_BAR, (volatile LAS unsigned*)(F.lds + LDSCTL_OFF));
    if (SITE_ON(16)) p0_prologue(a, F);
    xcd_barrier(bar);
    if (SITE_ON(17)) { WS_LOCAL(); pg8::Gemm g{WSP(const bf16_t, WS_MEMB), WSP(const bf16_t, WS_ACT + A_WK)};
      EpiMemK E{WSP(bf16_t, WS_KP), WSP(const float, WS_RMEM), WSP(float, WS_KSS), INP(19), INP(18)}; pg8::gemm_phase<CfgMK>(F.lds, g, F.G, blockIdx.x, E); }
    if (SITE_ON(18)) { WS_LOCAL(); pg8::Gemm g{WSP(const bf16_t, WS_MEMB), WSP(const bf16_t, WS_ACT + A_WV)};
      EpiMemV E{WSP(bf16_t, WS_VT), WSP(const float, WS_RMEM)}; pg8::gemm_phase<CfgMK>(F.lds, g, F.G, blockIdx.x, E); }
    xcd_barrier(bar);
    if (SITE_ON(19)) p2_finalize(a, F);
    { volatile LAS unsigned* st = (volatile LAS unsigned*)(F.lds + LDSCTL_OFF);
      if (F.tid == 0) { unsigned ok = (F.G % 8 == 0) ? 1u : 0u; unsigned* bw = WSP(unsigned, WS_CTL) + CW_BAR;
#pragma unroll
          for (unsigned jx = 0; jx < 16; ++jx) { const unsigned cnt = xb_ld(&bw[XB_XCNT(jx)]); ok &= (jx < 8u) ? (cnt == (unsigned)F.G / 8u) : (cnt == 0u); }
          ok &= (xb_ld(&bw[XB_TMO]) == 0u) ? 1u : 0u;
          st[3] = ok; st[4] = 0u; }
      __syncthreads();
      if (st[3] != 0u) { F.local = 1; F.x = (int)bar.x; F.j = (int)st[2]; F.c = 8 * F.j + F.x; }
      else { F.local = 0; F.c = blockIdx.x; F.x = F.c & 7; F.j = F.c >> 3; }
      F.x = __builtin_amdgcn_readfirstlane(F.x); F.j = __builtin_amdgcn_readfirstlane(F.j); F.c = __builtin_amdgcn_readfirstlane(F.c); F.local = __builtin_amdgcn_readfirstlane(F.local); }
    xcd_barrier(bar);
    for (int l = 0; l < DEPTH; ++l) {
        ffn_block(a, F, bar, l, 0, false);
        if (l & 1) odd_block(a, F, bar, l); else even_block(a, F, bar, l);
        xattn_block(a, F, bar, l);
        ffn_block(a, F, bar, l, 1, l == DEPTH - 1);
    }
}

extern "C" void kernel_launch(void* const* d_in, const int* in_sizes, int n_in, void* d_out, int out_size, void* d_ws, size_t ws_size, hipStream_t stream) {
    static int grid = 0;
    if (grid == 0) {
        if (n_in != 38 || out_size != M * D || ws_size < WS_END) { fprintf(stderr, "kernel_launch: unexpected problem (n_in %d, out %d, ws %zu < %zu)\n", n_in, out_size, ws_size, (size_t)WS_END); grid = -1; return; }
        int dev = 0, cus = 0, per_cu = 0;
        if (hipGetDevice(&dev) != hipSuccess || hipDeviceGetAttribute(&cus, hipDeviceAttributeMultiprocessorCount, dev) != hipSuccess) { grid = -1; return; }
        if (cus != 256) { fprintf(stderr, "kernel_launch: this build needs 256 compute units (one workgroup each; the per-phase row tables assume it), found %d\n", cus); grid = -1; return; }
        if (hipFuncSetAttribute((const void*)fwd_kernel, hipFuncAttributeMaxDynamicSharedMemorySize, LDS_BYTES) != hipSuccess) { fprintf(stderr, "kernel_launch: hipFuncSetAttribute failed\n"); grid = -1; return; }
        if (hipOccupancyMaxActiveBlocksPerMultiprocessor(&per_cu, (const void*)fwd_kernel, 512, LDS_BYTES) != hipSuccess || per_cu < 1) fprintf(stderr, "kernel_launch: occupancy query reports %d blocks per CU\n", per_cu);
        (void)hipGetLastError();
        grid = cus;
    }
    if (grid < 0) return;
    if (hipMemsetAsync((char*)d_ws + WS_CTL, 0, CTL_ZERO_BYTES, stream) != hipSuccess) return;
    Args a{};
    for (int i = 0; i < 38; ++i) a.in[i] = (const float*)d_in[i];
    a.out = (float*)d_out; a.ws = (unsigned char*)d_ws;
    hipLaunchKernelGGL(fwd_kernel, dim3(grid), dim3(512), LDS_BYTES, stream, a);
}
```
